# Optimizing an MI355X kernel written in HIP

```python
import math
import jax, jax.numpy as jnp
from jax import lax
import numpy as np

D_MODEL = 2048
BATCH = 4
SEQ = 8192
DEPTH = 2
DEC_BATCH = 16
DEC_SEQ = 2048
PAST_LEN = 128

GRID_W = 64
HEAD_DIM = 64
MIX_WIDTH = 3072
Q_BLOCK = 128
EPS = 1e-6
ROPE_THETA = 500000.0
ROPE_DIMS = HEAD_DIM // 4
AXIAL_THETA = 10000.0
A_HEADS = 6
A_QK = 2 * HEAD_DIM
A_V = 2 * HEAD_DIM
B_HEADS = 12
B_PATTERNS = ((128, 1), (512, 4), (2048, 16))
C_HEADS = 6
C_DK = 64
C_DV = 128
C_RANK = 16
C_CHUNK = 64
C_GATE_NORM = 16.0
D_Q_HEADS = 12
D_KV_HEADS = 4
D_FF = 5632
IN_SPLITS = (A_HEADS * A_QK, A_HEADS * A_QK, A_HEADS * A_V,
             B_HEADS * HEAD_DIM, B_HEADS * HEAD_DIM, B_HEADS * HEAD_DIM,
             C_HEADS * C_DK, C_HEADS * C_DK, C_HEADS * C_DV, C_HEADS * C_DV, 2 * C_RANK,
             D_Q_HEADS * HEAD_DIM, D_KV_HEADS * HEAD_DIM, D_KV_HEADS * HEAD_DIM)
N_IN = 8224

kernel_name = 'hybrid_parallel_heads_bidir_encoder'


def _rms_norm(x, g):
    xf = x.astype(jnp.float32)
    y = xf * lax.rsqrt(jnp.mean(xf * xf, axis=-1, keepdims=True) + EPS)
    return (y * g.astype(jnp.float32)).astype(x.dtype)


def _swiglu(x, wg, wu, wd):
    return (jax.nn.silu(x @ wg) * (x @ wu)) @ wd


def _heads(t, n):
    b, l, _ = t.shape
    return t.reshape(b, l, n, -1).transpose(0, 2, 1, 3)


def _merge(t):
    b, h, l, d = t.shape
    return t.transpose(0, 2, 1, 3).reshape(b, l, h * d)


def _rope_cos_sin(pos, dims, theta):
    inv = theta ** (-jnp.arange(0, dims, 2, dtype=jnp.float32) / dims)
    ang = pos.astype(jnp.float32)[:, None] * inv[None, :]
    return jnp.cos(ang), jnp.sin(ang)


def _rotate(x, cos, sin):
    half = x.shape[-1] // 2
    x1 = x[..., :half].astype(jnp.float32)
    x2 = x[..., half:].astype(jnp.float32)
    return jnp.concatenate([x1 * cos - x2 * sin, x2 * cos + x1 * sin], axis=-1).astype(x.dtype)


def _partial_rope(x, cos, sin):
    return jnp.concatenate([_rotate(x[..., :ROPE_DIMS], cos, sin), x[..., ROPE_DIMS:]], axis=-1)


def _axial_rope(x, r_cos, r_sin, c_cos, c_sin):
    half = HEAD_DIM // 2
    return jnp.concatenate([_rotate(x[..., :half], r_cos, r_sin),
                            _rotate(x[..., half:], c_cos, c_sin)], axis=-1)


def _diff_attention(q, k, v, lam):
    b, h, L, _ = q.shape
    nb = L // Q_BLOCK
    scale = HEAD_DIM ** -0.5
    qs = jnp.stack([q[..., :HEAD_DIM], q[..., HEAD_DIM:]], 0)
    ks = jnp.stack([k[..., :HEAD_DIM], k[..., HEAD_DIM:]], 0)
    qs = qs.reshape(2, b, h, nb, Q_BLOCK, HEAD_DIM).transpose(3, 0, 1, 2, 4, 5)

    def block(qb):
        s = jnp.einsum('nbhqd,nbhkd->nbhqk', qb, ks).astype(jnp.float32) * scale
        p = jax.nn.softmax(s, axis=-1)
        a = p[0] - lam * p[1]
        return jnp.einsum('bhqk,bhkv->bhqv', a.astype(v.dtype), v)

    o = lax.map(block, qs)
    return o.transpose(1, 2, 0, 3, 4).reshape(b, h, L, v.shape[-1])


def _gqa_attention(q, k, v):
    b, hq, L, d = q.shape
    g = hq // D_KV_HEADS
    nb = L // Q_BLOCK
    scale = d ** -0.5
    qs = q.reshape(b, D_KV_HEADS, g, nb, Q_BLOCK, d).transpose(3, 0, 1, 2, 4, 5)

    def block(qb):
        s = jnp.einsum('bkgqd,bksd->bkgqs', qb, k).astype(jnp.float32) * scale
        p = jax.nn.softmax(s, axis=-1)
        return jnp.einsum('bkgqs,bksd->bkgqd', p.astype(v.dtype), v)

    o = lax.map(block, qs)
    return o.transpose(1, 2, 3, 0, 4, 5).reshape(b, hq, L, d)


def _banded_window_attention(q, k, v, n_side):
    lead = q.shape[:-2]
    N, d = q.shape[-2], q.shape[-1]
    blk = n_side
    nb = -(-N // blk)
    P = nb * blk
    nlead = len(lead)
    qp = jnp.pad(q, [(0, 0)] * nlead + [(0, P - N), (0, 0)]).reshape(*lead, nb, blk, d)
    kv_pad = [(0, 0)] * nlead + [(blk, P - N + blk), (0, 0)]
    kp = jnp.pad(k, kv_pad).reshape(*lead, nb + 2, blk, d)
    vp = jnp.pad(v, kv_pad).reshape(*lead, nb + 2, blk, d)
    kw = jnp.concatenate([kp[..., :-2, :, :], kp[..., 1:-1, :, :], kp[..., 2:, :, :]], axis=-2)
    vw = jnp.concatenate([vp[..., :-2, :, :], vp[..., 1:-1, :, :], vp[..., 2:, :, :]], axis=-2)
    s = jnp.einsum('...nqd,...nkd->...nqk', qp, kw).astype(jnp.float32) * (d ** -0.5)
    qpos = jnp.arange(nb)[:, None] * blk + jnp.arange(blk)[None, :]
    kpos = jnp.arange(nb)[:, None] * blk - blk + jnp.arange(3 * blk)[None, :]
    rel = kpos[:, None, :] - qpos[:, :, None]
    valid = (jnp.abs(rel) <= n_side) & (kpos[:, None, :] >= 0) & (kpos[:, None, :] < N)
    s = jnp.where(valid, s, -1e30)
    m = jnp.max(s, axis=-1, keepdims=True)
    e = jnp.exp(s - m)
    den = jnp.sum(e, axis=-1, keepdims=True)
    p = e / den
    lse = (m + jnp.log(den))[..., 0]
    o = jnp.einsum('...nqk,...nkd->...nqd', p.astype(v.dtype), vw)
    o = o.reshape(*lead, P, d)[..., :N, :]
    lse = lse.reshape(*lead, P)[..., :N]
    return o, lse


def _dilated_attention(q, k, v):
    b, h, L, d = q.shape
    outs, lses = [], []
    for window, dil in B_PATTERNS:
        n_side = window // (2 * dil)

        def to_sub(t):
            return t.reshape(b, h, L // dil, dil, d).swapaxes(2, 3)

        o, lse = _banded_window_attention(to_sub(q), to_sub(k), to_sub(v), n_side)
        outs.append(o.swapaxes(2, 3).reshape(b, h, L, d))
        lses.append(lse.swapaxes(2, 3).reshape(b, h, L))
    w = jax.nn.softmax(jnp.stack(lses, 0), axis=0)
    return jnp.einsum('gbhl,gbhld->bhld', w.astype(q.dtype), jnp.stack(outs, 0))


def _gla_scan(q, k, v, g):
    b, h, L, dk = q.shape
    dv = v.shape[-1]
    n = L // C_CHUNK
    q = q.reshape(b, h, n, C_CHUNK, dk)
    k = k.reshape(b, h, n, C_CHUNK, dk)
    v = v.reshape(b, h, n, C_CHUNK, dv)
    g = g.reshape(b, h, n, C_CHUNK, dk)
    cum = jnp.cumsum(g, axis=-2)
    last = cum[..., -1:, :]
    q_dec = q * jnp.exp(cum)
    att = jnp.einsum('bhncd,bhnsd->bhncs', q_dec, k * jnp.exp(-cum))
    att = jnp.where(jnp.tril(jnp.ones((C_CHUNK, C_CHUNK), dtype=bool)), att, 0.0)
    o_intra = jnp.einsum('bhncs,bhnse->bhnce', att, v)
    u = jnp.einsum('bhncd,bhnce->bhnde', k * jnp.exp(last - cum), v)
    decay = jnp.exp(last[..., 0, :])

    def step(state, inp):
        dec, uu = inp
        return dec[..., None] * state + uu, state

    _, s_in = lax.scan(step, jnp.zeros((b, h, dk, dv), jnp.float32),
                       (jnp.moveaxis(decay, 2, 0), jnp.moveaxis(u, 2, 0)))
    s_in = jnp.moveaxis(s_in, 0, 2)
    o_inter = jnp.einsum('bhncd,bhnde->bhnce', q_dec, s_in)
    return (o_intra + o_inter).reshape(b, h, L, dv)


def _bidir_gla(q, k, v, g_f, g_b):
    dt = v.dtype
    q = q.astype(jnp.float32) * (C_DK ** -0.5)
    k = k.astype(jnp.float32)
    v = v.astype(jnp.float32)
    fwd = _gla_scan(q, k, v, g_f)

    def flip(t):
        return jnp.flip(t, axis=2)

    bwd = flip(_gla_scan(flip(q), flip(k), flip(v), flip(g_b)))
    return (fwd + bwd).astype(dt)


def _trunk(x, ffn1_norm, ffn1_w_gate, ffn1_w_up, ffn1_w_down, mix_norm, w_in, w_out,
           diff_lambda_q1, diff_lambda_k1, diff_lambda_q2, diff_lambda_k2, diff_out_norm,
           gla_gate_up_f, gla_gate_bias_f, gla_gate_up_b, gla_gate_bias_b, gla_out_norm,
           gqa_q_norm, gqa_k_norm, ffn2_norm, ffn2_w_gate, ffn2_w_up, ffn2_w_down, final_norm):
    L = x.shape[1]
    rows = L // GRID_W
    t = jnp.arange(L, dtype=jnp.float32)
    p_cos, p_sin = _rope_cos_sin(t, ROPE_DIMS, ROPE_THETA)
    row_pos = jnp.repeat(jnp.arange(rows, dtype=jnp.float32), GRID_W)
    col_pos = jnp.tile(jnp.arange(GRID_W, dtype=jnp.float32), rows)
    r_cos, r_sin = _rope_cos_sin(row_pos, HEAD_DIM // 2, AXIAL_THETA)
    c_cos, c_sin = _rope_cos_sin(col_pos, HEAD_DIM // 2, AXIAL_THETA)
    split_points = np.cumsum(np.array(IN_SPLITS))[:-1].tolist()

    for l in range(DEPTH):
        x = x + 0.5 * _swiglu(_rms_norm(x, ffn1_norm[l]), ffn1_w_gate[l], ffn1_w_up[l], ffn1_w_down[l])

        h = _rms_norm(x, mix_norm[l])
        u = h @ w_in[l]
        (a_q, a_k, a_v, b_q, b_k, b_v, c_q, c_k, c_v, c_g, c_low,
         d_q, d_k, d_v) = jnp.split(u, split_points, axis=-1)

        aq = _heads(a_q, A_HEADS)
        ak = _heads(a_k, A_HEADS)
        av = _heads(a_v, A_HEADS)
        aq = jnp.concatenate([_partial_rope(aq[..., :HEAD_DIM], p_cos, p_sin),
                              _partial_rope(aq[..., HEAD_DIM:], p_cos, p_sin)], axis=-1)
        ak = jnp.concatenate([_partial_rope(ak[..., :HEAD_DIM], p_cos, p_sin),
                              _partial_rope(ak[..., HEAD_DIM:], p_cos, p_sin)], axis=-1)
        lam_init = 0.8 - 0.6 * math.exp(-0.3 * l)
        lam = (jnp.exp(jnp.sum(diff_lambda_q1[l].astype(jnp.float32) * diff_lambda_k1[l].astype(jnp.float32)))
               - jnp.exp(jnp.sum(diff_lambda_q2[l].astype(jnp.float32) * diff_lambda_k2[l].astype(jnp.float32)))
               + lam_init)
        o_a = _diff_attention(aq, ak, av, lam)
        o_a = _merge(_rms_norm(o_a, diff_out_norm[l]) * (1.0 - lam_init))

        bq = _partial_rope(_heads(b_q, B_HEADS), p_cos, p_sin)
        bk = _partial_rope(_heads(b_k, B_HEADS), p_cos, p_sin)
        bv = _heads(b_v, B_HEADS)
        o_b = _merge(_dilated_attention(bq, bk, bv))

        low_f = c_low[..., :C_RANK]
        low_b = c_low[..., C_RANK:]
        g_f = _heads(jax.nn.log_sigmoid((low_f @ gla_gate_up_f[l] + gla_gate_bias_f[l]).astype(jnp.float32)) / C_GATE_NORM, C_HEADS)
        g_b = _heads(jax.nn.log_sigmoid((low_b @ gla_gate_up_b[l] + gla_gate_bias_b[l]).astype(jnp.float32)) / C_GATE_NORM, C_HEADS)
        o_c = _bidir_gla(_heads(c_q, C_HEADS), _heads(c_k, C_HEADS), _heads(c_v, C_HEADS), g_f, g_b)
        o_c = _merge(_rms_norm(o_c, gla_out_norm[l]) * jax.nn.silu(_heads(c_g, C_HEADS)))

        dq = _axial_rope(_rms_norm(_heads(d_q, D_Q_HEADS), gqa_q_norm[l]), r_cos, r_sin, c_cos, c_sin)
        dk = _axial_rope(_rms_norm(_heads(d_k, D_KV_HEADS), gqa_k_norm[l]), r_cos, r_sin, c_cos, c_sin)
        dv = _heads(d_v, D_KV_HEADS)
        o_d = _merge(_gqa_attention(dq, dk, dv))

        x = x + jnp.concatenate([o_a, o_b, o_c, o_d], axis=-1) @ w_out[l]

        x = x + 0.5 * _swiglu(_rms_norm(x, ffn2_norm[l]), ffn2_w_gate[l], ffn2_w_up[l], ffn2_w_down[l])
    return _rms_norm(x, final_norm)


def setup_inputs(seed: int = 0) -> dict:
    key = jax.random.key(seed)
    ks = jax.random.split(key, 26)

    def nrm(k, shape, scale):
        return jax.random.normal(k, shape, jnp.float32) * scale

    def gain(k, shape):
        return 1.0 + 0.02 * jax.random.normal(k, shape, jnp.float32)

    return {
        'x_prompt': nrm(ks[0], (BATCH, SEQ, D_MODEL), 1.0),
        'x_sample': nrm(ks[1], (DEC_BATCH, DEC_SEQ, D_MODEL), 1.0),
        'ffn1_norm': gain(ks[2], (DEPTH, D_MODEL)),
        'ffn1_w_gate': nrm(ks[3], (DEPTH, D_MODEL, D_FF), D_MODEL ** -0.5),
        'ffn1_w_up': nrm(ks[4], (DEPTH, D_MODEL, D_FF), D_MODEL ** -0.5),
        'ffn1_w_down': nrm(ks[5], (DEPTH, D_FF, D_MODEL), D_FF ** -0.5),
        'mix_norm': gain(ks[6], (DEPTH, D_MODEL)),
        'w_in': nrm(ks[7], (DEPTH, D_MODEL, N_IN), D_MODEL ** -0.5),
        'w_out': nrm(ks[8], (DEPTH, MIX_WIDTH, D_MODEL), MIX_WIDTH ** -0.5),
        'diff_lambda_q1': nrm(ks[9], (DEPTH, HEAD_DIM), 0.1),
        'diff_lambda_k1': nrm(ks[10], (DEPTH, HEAD_DIM), 0.1),
        'diff_lambda_q2': nrm(ks[11], (DEPTH, HEAD_DIM), 0.1),
        'diff_lambda_k2': nrm(ks[12], (DEPTH, HEAD_DIM), 0.1),
        'diff_out_norm': gain(ks[13], (DEPTH, A_V)),
        'gla_gate_up_f': nrm(ks[14], (DEPTH, C_RANK, C_HEADS * C_DK), C_RANK ** -0.5),
        'gla_gate_bias_f': nrm(ks[15], (DEPTH, C_HEADS * C_DK), 0.1),
        'gla_gate_up_b': nrm(ks[16], (DEPTH, C_RANK, C_HEADS * C_DK), C_RANK ** -0.5),
        'gla_gate_bias_b': nrm(ks[17], (DEPTH, C_HEADS * C_DK), 0.1),
        'gla_out_norm': gain(ks[18], (DEPTH, C_DV)),
        'gqa_q_norm': gain(ks[19], (DEPTH, HEAD_DIM)),
        'gqa_k_norm': gain(ks[20], (DEPTH, HEAD_DIM)),
        'ffn2_norm': gain(ks[21], (DEPTH, D_MODEL)),
        'ffn2_w_gate': nrm(ks[22], (DEPTH, D_MODEL, D_FF), D_MODEL ** -0.5),
        'ffn2_w_up': nrm(ks[23], (DEPTH, D_MODEL, D_FF), D_MODEL ** -0.5),
        'ffn2_w_down': nrm(ks[24], (DEPTH, D_FF, D_MODEL), D_FF ** -0.5),
        'final_norm': gain(ks[25], (D_MODEL,)),
    }


def reference(x_prompt, x_sample, ffn1_norm, ffn1_w_gate, ffn1_w_up, ffn1_w_down, mix_norm, w_in, w_out,
              diff_lambda_q1, diff_lambda_k1, diff_lambda_q2, diff_lambda_k2, diff_out_norm,
              gla_gate_up_f, gla_gate_bias_f, gla_gate_up_b, gla_gate_bias_b, gla_out_norm,
              gqa_q_norm, gqa_k_norm, ffn2_norm, ffn2_w_gate, ffn2_w_up, ffn2_w_down, final_norm):
    y_prompt = _trunk(x_prompt, ffn1_norm, ffn1_w_gate, ffn1_w_up, ffn1_w_down, mix_norm, w_in, w_out,
                      diff_lambda_q1, diff_lambda_k1, diff_lambda_q2, diff_lambda_k2, diff_out_norm,
                      gla_gate_up_f, gla_gate_bias_f, gla_gate_up_b, gla_gate_bias_b, gla_out_norm,
                      gqa_q_norm, gqa_k_norm, ffn2_norm, ffn2_w_gate, ffn2_w_up, ffn2_w_down, final_norm)
    y_sample = _trunk(x_sample, ffn1_norm, ffn1_w_gate, ffn1_w_up, ffn1_w_down, mix_norm, w_in, w_out,
                      diff_lambda_q1, diff_lambda_k1, diff_lambda_q2, diff_lambda_k2, diff_out_norm,
                      gla_gate_up_f, gla_gate_bias_f, gla_gate_up_b, gla_gate_bias_b, gla_out_norm,
                      gqa_q_norm, gqa_k_norm, ffn2_norm, ffn2_w_gate, ffn2_w_up, ffn2_w_down, final_norm)
    return (y_prompt, y_sample)
```

```cpp
#include <hip/hip_runtime.h>
#include <hip/hip_bf16.h>
#include <cstdio>
#include <cstdint>
#include <cmath>
namespace pg8 {
#define PG8_LAS __attribute__((address_space(3)))
typedef unsigned short bf16_t;
typedef short bf16x8 __attribute__((ext_vector_type(8)));
typedef float f32x4 __attribute__((ext_vector_type(4)));
typedef unsigned u32x4 __attribute__((ext_vector_type(4)));
constexpr int BM = 256, BK = 64, HALF = 128, HTB = HALF * BK * 2  , STAGE_BYTES = 8 * HTB, NXCD = 8, WGM = 8;

__host__ __device__ __forceinline__ int lds_byte(int r, int c) { const int st = (r >> 4) * 2 + (c >> 5), rr = r & 15, cc = c & 31, ob = rr * 64 + cc * 2; return st * 1024 + (ob ^ (((ob >> 9) & 1) << 5)); }
__host__ __device__ __forceinline__ void stage_rc(int b, int& R, int& C) { const int st = b / 1024, sb = b % 1024, swz = sb ^ (((sb >> 9) & 1) << 5); R = (st >> 1) * 16 + swz / 64; C = (st & 1) * 32 + (swz % 64) / 2; }
__host__ __device__ __forceinline__ int perm32(int rho) { const int n = rho >> 4, i = rho & 15; return 8 * (i >> 2) + 4 * n + (i & 3); }

struct Unit { int pm, pn; };
struct Gemm { const bf16_t* A; const bf16_t* Bt; int M, N, K; };

struct StaticOrder {
    int nM, nN, nwg, G, c;
    __host__ __device__ void init(int M, int N, int G_, int c_) { nM = M / BM; nN = N / BM; nwg = nM * nN; G = G_; c = c_; }
    __host__ __device__ bool next(int i, Unit& u) const {
        const long L = (long)i * G + c; if (L >= nwg) return false;
        int wgid = (int)L; { const int q = nwg / NXCD, r = nwg % NXCD, xcd = wgid % NXCD, off = wgid / NXCD; wgid = (xcd < r ? xcd * (q + 1) : r * (q + 1) + (xcd - r) * q) + off; }
        const int nig = WGM * nN, gid = wgid / nig, fm = gid * WGM, gsz = (nM - fm) < WGM ? (nM - fm) : WGM;
        u.pm = fm + ((wgid % nig) % gsz); u.pn = (wgid % nig) / gsz; return true;
    }
    __device__ __forceinline__ void a_ready(const Unit&) const {}
    __device__ __forceinline__ void done(const Unit&) const {}
};

__device__ __forceinline__ unsigned cvt_pk_bf16(float lo, float hi) { unsigned r; asm volatile("v_cvt_pk_bf16_f32 %0, %1, %2" : "=v"(r) : "v"(lo), "v"(hi)); return r; }
typedef float f32x2 __attribute__((ext_vector_type(2)));
struct EpiPlain {
    static constexpr bool PERM = true, AFTER_DRAIN = false;
    bf16_t* O; int ldc;
    __device__ __forceinline__ void operator()(const f32x4 (&acc)[2][2][4][2], const Unit& u, int wr, int wc, int fr, int fq) const {
        const int row0 = u.pm * BM + wr * 64 + fr; const int col0 = u.pn * BM + wc * 32 + 8 * fq;
#pragma unroll
        for (int ai = 0; ai < 2; ++ai)
#pragma unroll
            for (int m = 0; m < 4; ++m) { bf16_t* rowp = O + (size_t)(row0 + ai * HALF + m * 16) * ldc + col0;
#pragma unroll
                for (int bj = 0; bj < 2; ++bj) { const f32x4 v0 = acc[ai][bj][m][0], v1 = acc[ai][bj][m][1];
                    u32x4 w; w.x = cvt_pk_bf16(v0[0], v0[1]); w.y = cvt_pk_bf16(v0[2], v0[3]); w.z = cvt_pk_bf16(v1[0], v1[1]); w.w = cvt_pk_bf16(v1[2], v1[3]);
                    *(u32x4*)(rowp + bj * HALF) = w; } }
    }
};
__device__ __forceinline__ float silu_f(float g) { return g * __builtin_amdgcn_rcpf(1.0f + __builtin_amdgcn_exp2f(-1.4426950408889634f * g)); }
struct EpiSwiglu {
    static constexpr bool PERM = true, AFTER_DRAIN = false;
    bf16_t* O; int ldc;
    __device__ __forceinline__ void operator()(const f32x4 (&acc)[2][2][4][2], const Unit& u, int wr, int wc, int fr, int fq) const {
        const int row0 = u.pm * BM + wr * 64 + fr; const int col0 = u.pn * HALF + wc * 32 + 8 * fq;
#pragma unroll
        for (int ai = 0; ai < 2; ++ai)
#pragma unroll
            for (int m = 0; m < 4; ++m) { bf16_t* rowp = O + (size_t)(row0 + ai * HALF + m * 16) * ldc + col0;
                const f32x4 g0 = acc[ai][0][m][0], g1 = acc[ai][0][m][1], u0 = acc[ai][1][m][0], u1 = acc[ai][1][m][1];
                float h[8];
#pragma unroll
                for (int e = 0; e < 4; ++e) { h[e] = silu_f(g0[e]) * u0[e]; h[4 + e] = silu_f(g1[e]) * u1[e]; }
                u32x4 w; w.x = cvt_pk_bf16(h[0], h[1]); w.y = cvt_pk_bf16(h[2], h[3]); w.z = cvt_pk_bf16(h[4], h[5]); w.w = cvt_pk_bf16(h[6], h[7]);
                *(u32x4*)rowp = w; }
    }
};
struct EpiResid {
    static constexpr bool PERM = false, AFTER_DRAIN = false;
    const float* base; float* out; int ldc; float alpha;
    __device__ __forceinline__ void operator()(const f32x4 (&acc)[2][2][4][2], const Unit& u, int wr, int wc, int fr, int fq) const {
        const int row0 = u.pm * BM + wr * 64 + fr; const int col0 = u.pn * BM + wc * 32 + 4 * fq;
#pragma unroll
        for (int ai = 0; ai < 2; ++ai)
#pragma unroll
            for (int m = 0; m < 4; ++m) { const size_t off = (size_t)(row0 + ai * HALF + m * 16) * ldc + col0;
#pragma unroll
                for (int bj = 0; bj < 2; ++bj)
#pragma unroll
                    for (int n = 0; n < 2; ++n) { const f32x4 bs = *(const f32x4*)(base + off + bj * HALF + n * 16); *(f32x4*)(out + off + bj * HALF + n * 16) = bs + acc[ai][bj][m][n] * alpha; }
                if (m & 1) asm volatile("" ::: "memory"); }
    }
};

template <class Epi, class Sched, bool ALIGN_EPI = false, bool SP2 = false>
__device__ __forceinline__ void gemm_phase(PG8_LAS unsigned char* lds, const Gemm g, const Sched& S, const Epi& E) {
    int tid_l = threadIdx.x; asm volatile("" : "+v"(tid_l));
    const int tid = tid_l, wid = __builtin_amdgcn_readfirstlane(tid >> 6), lane = tid & 63, wr = wid >> 2, wc = wid & 3, fr = lane & 15, fq = lane >> 4;
    const int K = g.K, nt = K / BK;
    unsigned voffA[2], voffB[2];
#pragma unroll
    for (int i = 0; i < 2; ++i) { int R, C; stage_rc(tid * 16 + i * 8192, R, C); const int Rb = Epi::PERM ? ((R & ~31) + perm32(R & 31)) : R;
        voffA[i] = (unsigned)(R * K + C) * 2u; voffB[i] = (unsigned)(Rb * K + C) * 2u; }
    const size_t kstep = (size_t)(BK * 2);
    const size_t hstep = (size_t)HALF * K * 2;
    const size_t tstep = 2 * hstep;
    const unsigned ldsw = (unsigned)wid * 1024u;
    const int aoff = lds_byte(wr * 64 + fr, fq * 8), boff = lds_byte(wc * 32 + fr, fq * 8);
#define PG8_SA(b, h) (((b) * 2 + (h)) * HTB)
#define PG8_SB(b, h) ((4 + (b) * 2 + (h)) * HTB)
#define PG8_STAGE(bufoff, gbase, voff) do { _Pragma("unroll") for (int _i = 0; _i < 2; ++_i) \
        __builtin_amdgcn_global_load_lds((const unsigned*)((const char*)(gbase) + (voff)[_i]), (PG8_LAS unsigned*)(lds + (bufoff) + ldsw + _i * 8192), 16, 0, 0); } while (0)
#define PG8_LDA(dst, b, h) do { _Pragma("unroll") for (int m = 0; m < 4; ++m) _Pragma("unroll") for (int k = 0; k < 2; ++k) dst[m][k] = *(const PG8_LAS bf16x8*)(lds + PG8_SA(b, h) + aoff + m * 2048 + k * 1024); } while (0)
#define PG8_LDB(dst, b, h) do { _Pragma("unroll") for (int n = 0; n < 2; ++n) _Pragma("unroll") for (int k = 0; k < 2; ++k) dst[n][k] = *(const PG8_LAS bf16x8*)(lds + PG8_SB(b, h) + boff + n * 2048 + k * 1024); } while (0)
#define PG8_MMA(ai, bj, At, Bt) do { __builtin_amdgcn_s_setprio(1); _Pragma("unroll") for (int m = 0; m < 4; ++m) _Pragma("unroll") for (int n = 0; n < 2; ++n) _Pragma("unroll") for (int k = 0; k < 2; ++k) \
        acc[ai][bj][m][n] = __builtin_amdgcn_mfma_f32_16x16x32_bf16(Bt[n][k], At[m][k], acc[ai][bj][m][n], 0, 0, 0); __builtin_amdgcn_s_setprio(0); } while (0)
#define PG8_WAIT_V(n) asm volatile("s_waitcnt vmcnt(" #n ")" ::: "memory")
#define PG8_WAIT_L(n) asm volatile("s_waitcnt lgkmcnt(" #n ")" ::: "memory")
#define PG8_BAR __builtin_amdgcn_s_barrier()
#define PG8_SCHED __builtin_amdgcn_sched_barrier(0)
    Unit cur, nxt; int ui = 0;
    if (!S.next(0, cur)) return;
    f32x4 acc[2][2][4][2];
#pragma unroll
    for (int a = 0; a < 2; ++a)
#pragma unroll
        for (int b = 0; b < 2; ++b)
#pragma unroll
            for (int m = 0; m < 4; ++m)
#pragma unroll
                for (int n = 0; n < 2; ++n) acc[a][b][m][n] = (f32x4){0.f, 0.f, 0.f, 0.f};
    bf16x8 At[4][2], B0[2][2], B1[2][2];
    const char* cA = (const char*)g.A + (size_t)cur.pm * tstep; const char* cB = (const char*)g.Bt + (size_t)cur.pn * tstep;
    S.a_ready(cur);
    if constexpr (SP2) {
        PG8_STAGE(PG8_SB(0, 0), cB, voffB); PG8_STAGE(PG8_SB(0, 1), cB + hstep, voffB); PG8_STAGE(PG8_SA(0, 0), cA, voffA); PG8_STAGE(PG8_SA(0, 1), cA + hstep, voffA);
        if (wr == 1) PG8_BAR;
        PG8_WAIT_V(2); PG8_BAR;
        PG8_STAGE(PG8_SB(1, 0), cB + kstep, voffB); PG8_STAGE(PG8_SA(1, 0), cA + kstep, voffA); PG8_STAGE(PG8_SB(1, 1), cB + hstep + kstep, voffB);
        PG8_WAIT_V(6); PG8_BAR;
    } else {
        PG8_STAGE(PG8_SB(0, 0), cB, voffB); PG8_STAGE(PG8_SA(0, 0), cA, voffA); PG8_STAGE(PG8_SB(0, 1), cB + hstep, voffB); PG8_STAGE(PG8_SA(0, 1), cA + hstep, voffA);
        if (wr == 1) PG8_BAR;
        PG8_WAIT_V(4); PG8_BAR;
        PG8_STAGE(PG8_SB(1, 0), cB + kstep, voffB); PG8_STAGE(PG8_SA(1, 0), cA + kstep, voffA); PG8_STAGE(PG8_SB(1, 1), cB + hstep + kstep, voffB);
        PG8_WAIT_V(6); PG8_BAR;
    }
    for (;;) {
        const bool has_next = S.next(ui + 1, nxt);
        const char* nA = has_next ? (const char*)g.A + (size_t)nxt.pm * tstep : cA; const char* nB = has_next ? (const char*)g.Bt + (size_t)nxt.pn * tstep : cB;
        for (int t = 0; t < nt; t += 2) {
            const bool last = (t == nt - 2);
            const char* a1 = cA + (size_t)(t + 1) * kstep;
            const char* a2 = last ? nA : cA + (size_t)(t + 2) * kstep; const char* b2 = last ? nB : cB + (size_t)(t + 2) * kstep;
            const char* a3 = a2 + kstep; const char* b3 = b2 + kstep;
            if (last && has_next) S.a_ready(nxt);
            if constexpr (SP2) {
            PG8_LDB(B0, 0, 0); PG8_LDB(B1, 0, 1); PG8_SCHED; PG8_LDA(At, 0, 0); PG8_STAGE(PG8_SA(1, 1), a1 + hstep, voffA);
            PG8_WAIT_V(8); PG8_WAIT_L(0); PG8_BAR; PG8_MMA(0, 0, At, B0); PG8_MMA(0, 1, At, B1); PG8_BAR; PG8_SCHED;
            PG8_LDA(At, 0, 1); PG8_STAGE(PG8_SB(0, 0), b2, voffB); PG8_STAGE(PG8_SB(0, 1), b2 + hstep, voffB); PG8_STAGE(PG8_SA(0, 0), a2, voffA);
            PG8_WAIT_V(8); PG8_WAIT_L(0); PG8_BAR; PG8_MMA(1, 0, At, B0); PG8_MMA(1, 1, At, B1); PG8_BAR; PG8_SCHED;
            PG8_LDB(B0, 1, 0); PG8_LDB(B1, 1, 1); PG8_SCHED; PG8_LDA(At, 1, 0); PG8_STAGE(PG8_SA(0, 1), a2 + hstep, voffA);
            PG8_WAIT_V(8); PG8_WAIT_L(0); PG8_BAR; PG8_MMA(0, 0, At, B0); PG8_MMA(0, 1, At, B1); PG8_BAR; PG8_SCHED;
            PG8_LDA(At, 1, 1); PG8_STAGE(PG8_SB(1, 0), b3, voffB); PG8_STAGE(PG8_SB(1, 1), b3 + hstep, voffB); PG8_STAGE(PG8_SA(1, 0), a3, voffA);
            PG8_WAIT_V(8); PG8_WAIT_L(0); PG8_BAR; PG8_MMA(1, 0, At, B0); PG8_MMA(1, 1, At, B1); PG8_BAR; PG8_SCHED;
            } else {
            PG8_LDB(B0, 0, 0); PG8_SCHED; PG8_LDA(At, 0, 0); PG8_STAGE(PG8_SA(1, 1), a1 + hstep, voffA);
            PG8_WAIT_L(8); PG8_BAR; PG8_WAIT_L(0); PG8_MMA(0, 0, At, B0); PG8_BAR; PG8_SCHED;
            PG8_LDB(B1, 0, 1); PG8_STAGE(PG8_SB(0, 0), b2, voffB);
            PG8_BAR; PG8_WAIT_L(0); PG8_MMA(0, 1, At, B1); PG8_BAR;
            PG8_LDA(At, 0, 1); PG8_STAGE(PG8_SA(0, 0), a2, voffA);
            PG8_BAR; PG8_WAIT_L(0); PG8_MMA(1, 0, At, B0); PG8_BAR; PG8_SCHED;
            PG8_STAGE(PG8_SB(0, 1), b2 + hstep, voffB);
            PG8_WAIT_V(6); PG8_BAR; PG8_MMA(1, 1, At, B1); PG8_BAR;
            PG8_LDB(B0, 1, 0); PG8_SCHED; PG8_LDA(At, 1, 0); PG8_STAGE(PG8_SA(0, 1), a2 + hstep, voffA);
            PG8_WAIT_L(8); PG8_BAR; PG8_WAIT_L(0); PG8_MMA(0, 0, At, B0); PG8_BAR; PG8_SCHED;
            PG8_LDB(B1, 1, 1); PG8_STAGE(PG8_SB(1, 0), b3, voffB);
            PG8_BAR; PG8_WAIT_L(0); PG8_MMA(0, 1, At, B1); PG8_BAR;
            PG8_LDA(At, 1, 1); PG8_STAGE(PG8_SA(1, 0), a3, voffA);
            PG8_BAR; PG8_WAIT_L(0); PG8_MMA(1, 0, At, B0); PG8_BAR; PG8_SCHED;
            PG8_STAGE(PG8_SB(1, 1), b3 + hstep, voffB);
            PG8_WAIT_V(6); PG8_BAR; PG8_MMA(1, 1, At, B1); PG8_BAR;
            }
        }
        if constexpr (ALIGN_EPI) { if (wr == 0) PG8_BAR; }
        if constexpr (!Epi::AFTER_DRAIN) { E(acc, cur, wr, wc, fr, fq); S.done(cur); }
        if (!has_next) break;
#pragma unroll
        for (int a = 0; a < 2; ++a)
#pragma unroll
            for (int b = 0; b < 2; ++b)
#pragma unroll
                for (int m = 0; m < 4; ++m)
#pragma unroll
                    for (int n = 0; n < 2; ++n) acc[a][b][m][n] = (f32x4){0.f, 0.f, 0.f, 0.f};
        cur = nxt; cA = nA; cB = nB; ++ui;
        if constexpr (ALIGN_EPI) { if (wr == 1) PG8_BAR; }
    }
    PG8_WAIT_V(0);
    if constexpr (!ALIGN_EPI) { if (wr == 0) PG8_BAR; }
    PG8_BAR;
    if constexpr (Epi::AFTER_DRAIN) { E.fused(acc, cur, wr, wc, fr, fq, lds, wid, lane); S.done(cur); }
#undef PG8_SA
#undef PG8_SB
#undef PG8_STAGE
#undef PG8_LDA
#undef PG8_LDB
#undef PG8_MMA
#undef PG8_WAIT_V
#undef PG8_WAIT_L
#undef PG8_BAR
#undef PG8_SCHED
}
}
#include <hip/hip_bf16.h>
#include <cmath>
namespace attn_body {
using bf16=__hip_bfloat16;
using bf16x8=__attribute__((ext_vector_type(8)))short;
using s16x4=__attribute__((ext_vector_type(4)))short;
using f32x16=__attribute__((ext_vector_type(16)))float;
using u32x4=__attribute__((ext_vector_type(4)))unsigned;
constexpr int D=64,PU=8960;
constexpr int NW=8,QBLK=32,QB=QBLK*NW,KVBLK=64;

__device__ __forceinline__ int crow(int r,int hi){return (r&3)+8*(r>>2)+4*hi;}
#define SBAR() __builtin_amdgcn_sched_barrier(0)


constexpr int NSLOT=3, SLOTB=8192;
constexpr int LDS_K=0, LDS_V=NSLOT*SLOTB, LDS_WS=2*NSLOT*SLOTB, LDS_OST=LDS_WS+NW*64*4, LDS_BYTES=LDS_OST+NW*4096;
constexpr float C2=0.125f*1.4426950408889634f;
__device__ __forceinline__ void glds16(const void*gsrc,unsigned lds_dst){unsigned keep;
  asm volatile("s_mov_b32 %0, m0\n\ts_mov_b32 m0, %2\n\ts_nop 0\n\tglobal_load_lds_dwordx4 %1, off\n\ts_mov_b32 m0, %0":"=&s"(keep):"v"(gsrc),"s"(lds_dst):"memory");}
__device__ __forceinline__ float max3f(float a,float b,float c){float r;asm("v_max3_f32 %0, %1, %2, %3":"=v"(r):"v"(a),"v"(b),"v"(c));return r;}
__device__ __forceinline__ float max2f(float a,float b){float r;asm("v_max_f32_e32 %0, %1, %2":"=v"(r):"v"(a),"v"(b));return r;}
__device__ __forceinline__ float fadd_s(float a,float b){float r;asm("v_add_f32_e32 %0, %1, %2":"=v"(r):"v"(a),"v"(b));return r;}
__device__ __forceinline__ float fsub_s(float a,float b){float r;asm("v_sub_f32_e32 %0, %1, %2":"=v"(r):"v"(a),"v"(b));return r;}
typedef float f32x2_t __attribute__((ext_vector_type(2))); typedef __bf16 bf16x2_t __attribute__((ext_vector_type(2)));
__device__ __forceinline__ unsigned cvtpk_s(float lo,float hi){f32x2_t v={lo,hi};bf16x2_t b=__builtin_convertvector(v,bf16x2_t);return __builtin_bit_cast(unsigned,b);}
#define WAIT_BAR(N) asm volatile("s_waitcnt vmcnt(" #N ") lgkmcnt(0)\n\ts_barrier":::"memory")

__device__ __forceinline__ void qkt(f32x16&p0,f32x16&p1,const char*Kslot,const bf16x8*qr,const f32x16&negm,int r32,int hi){
  const char*kb=Kslot+hi*1024+r32*16;
  #pragma unroll
  for(int d0=0;d0<4;++d0){
    const bf16x8 b0=*reinterpret_cast<const bf16x8*>(kb+d0*2048);
    const bf16x8 b1=*reinterpret_cast<const bf16x8*>(kb+d0*2048+512);
    if(d0==0){p0=__builtin_amdgcn_mfma_f32_32x32x16_bf16(b0,qr[0],negm,0,0,0);p1=__builtin_amdgcn_mfma_f32_32x32x16_bf16(b1,qr[0],negm,0,0,0);}
    else{p0=__builtin_amdgcn_mfma_f32_32x32x16_bf16(b0,qr[d0],p0,0,0,0);p1=__builtin_amdgcn_mfma_f32_32x32x16_bf16(b1,qr[d0],p1,0,0,0);}}
}
typedef __attribute__((address_space(3))) const char* lds_cptr;
typedef short v4i16_t __attribute__((ext_vector_type(4)));
__device__ __forceinline__ void kload8(bf16x8*kf,lds_cptr kp){
  kf[0]=*(const __attribute__((address_space(3))) bf16x8*)(kp);      kf[1]=*(const __attribute__((address_space(3))) bf16x8*)(kp+512);
  kf[2]=*(const __attribute__((address_space(3))) bf16x8*)(kp+2048); kf[3]=*(const __attribute__((address_space(3))) bf16x8*)(kp+2560);
  kf[4]=*(const __attribute__((address_space(3))) bf16x8*)(kp+4096); kf[5]=*(const __attribute__((address_space(3))) bf16x8*)(kp+4608);
  kf[6]=*(const __attribute__((address_space(3))) bf16x8*)(kp+6144); kf[7]=*(const __attribute__((address_space(3))) bf16x8*)(kp+6656);
}
__device__ __forceinline__ void kload2(bf16x8*kf,lds_cptr kp,int j){ kf[2*j]=*(const __attribute__((address_space(3))) bf16x8*)(kp+j*2048); kf[2*j+1]=*(const __attribute__((address_space(3))) bf16x8*)(kp+j*2048+512); }
__device__ __forceinline__ s16x4 vtr(lds_cptr p){ return __builtin_bit_cast(s16x4,__builtin_amdgcn_ds_read_tr16_b64_v4i16((__attribute__((address_space(3))) v4i16_t*)p)); }
__device__ __forceinline__ float rowmax(const f32x16&p0,const f32x16&p1){
  float a=max3f(p0[0],p0[1],p1[0]),b=max3f(p0[2],p0[3],p1[1]);a=max3f(a,p1[2],p1[3]);
  #pragma unroll
  for(int r=4;r<16;r+=4){a=max3f(a,p0[r],p0[r+1]);b=max3f(b,p0[r+2],p0[r+3]);a=max3f(a,p1[r],p1[r+1]);b=max3f(b,p1[r+2],p1[r+3]);}
  const float m=max2f(a,b);
  auto rr=__builtin_amdgcn_permlane32_swap(__float_as_uint(m),__float_as_uint(m),false,false);
  return max2f(__uint_as_float(rr[0]),__uint_as_float(rr[1]));
}
__device__ __forceinline__ void pv(f32x16*o,int vb,bf16x8 pa0,bf16x8 pa1,bf16x8 pa2,bf16x8 pa3){
  #pragma unroll
  for(int d0=0;d0<2;++d0){s16x4 lo[4],hi[4];
    #pragma unroll
    for(int ks=0;ks<4;++ks){
      asm volatile("ds_read_b64_tr_b16 %0,%1 offset:%c2":"=&v"(lo[ks]):"v"(vb),"i"(d0*4096+ks*1024):"memory");
      asm volatile("ds_read_b64_tr_b16 %0,%1 offset:%c2":"=&v"(hi[ks]):"v"(vb),"i"(d0*4096+ks*1024+512):"memory");}
    asm volatile("s_waitcnt lgkmcnt(0)":::"memory");SBAR();
    #define PK(k) (bf16x8){lo[k][0],lo[k][1],lo[k][2],lo[k][3],hi[k][0],hi[k][1],hi[k][2],hi[k][3]}
    o[d0]=__builtin_amdgcn_mfma_f32_32x32x16_bf16(pa0,PK(0),o[d0],0,0,0);
    o[d0]=__builtin_amdgcn_mfma_f32_32x32x16_bf16(pa1,PK(1),o[d0],0,0,0);
    o[d0]=__builtin_amdgcn_mfma_f32_32x32x16_bf16(pa2,PK(2),o[d0],0,0,0);
    o[d0]=__builtin_amdgcn_mfma_f32_32x32x16_bf16(pa3,PK(3),o[d0],0,0,0);
    #undef PK
  }
}

#ifndef ATTN_STORE16
#define ATTN_STORE16(p,v) (*(u32x4*)(p)=(v))
#endif
template<int THRL> __device__ __forceinline__ void attn_unit(const bf16*Qu,const bf16*__restrict__ Kh,const bf16*__restrict__ Vh,bf16*Ou,const long PO,const int NT,char*shm){
  int tid_l=threadIdx.x; asm volatile("":"+v"(tid_l)); const int tid=tid_l,lane=tid&63,r32=lane&31,hi=lane>>5; const int wid=__builtin_amdgcn_readfirstlane(tid>>6);

  const bf16*Qw=Qu+(long)(wid*QBLK)*PU;

  const unsigned lds0=(unsigned)(uintptr_t)shm;
  float*wsf=(float*)(shm+LDS_WS)+wid*64;
  const bf16*ksrc=Kh+(long)lane*PU+wid*8;
  const bf16*vsrc=Vh+(long)(16*(wid&3)+(lane>>2))*PU+(wid>>2)*32+(lane&3)*8;
  const unsigned kdst=lds0+LDS_K+wid*1024, vdst=lds0+LDS_V+wid*1024;
  #define DMA_K(t,slot) glds16(ksrc+(long)(t)*KVBLK*PU,(unsigned)__builtin_amdgcn_readfirstlane(kdst+(slot)))
  #define DMA_V(t,slot) glds16(vsrc+(long)(t)*KVBLK*PU,(unsigned)__builtin_amdgcn_readfirstlane(vdst+(slot)))
  const int vb0=(int)(lds0+LDS_V)+((lane>>4)&1)*32+(lane&3)*8+(4*hi+((lane&15)>>2))*64;
  const char*Kbase=shm+LDS_K; bf16x8 kf[8];
  const lds_cptr shm3=(lds_cptr)shm; const lds_cptr kp0=shm3+LDS_K+hi*1024+r32*16; const lds_cptr vp0=shm3+LDS_V+((lane>>4)&1)*32+(lane&3)*8+(4*hi+((lane&15)>>2))*64;

  DMA_K(0,0);DMA_V(0,0);DMA_K(1,SLOTB);
  bf16x8 qr[4];
  #pragma unroll
  for(int d0=0;d0<4;++d0)qr[d0]=*reinterpret_cast<const bf16x8*>(&Qw[(long)r32*PU+d0*16+hi*8]);
  float mhat=0.f,l_reg=0.f;f32x16 o[2];o[0]=f32x16{};o[1]=f32x16{};f32x16 negm=f32x16{};asm volatile("":"+v"(negm));

  #define CMASK(P0,P1,t) do{}while(0)
  bool resc=false;
  #define START(P0,P1) do{ const float rm=rowmax(P0,P1); resc=false; \
    { const float dl=rm; mhat=fadd_s(mhat,dl); \
      _Pragma("unroll") for(int r=0;r<16;++r){P0[r]=fsub_s(P0[r],dl);P1[r]=fsub_s(P1[r],dl);} \
      _Pragma("unroll") for(int r=0;r<16;++r)negm[r]=-mhat; asm volatile("":"+v"(negm)); } \
    _Pragma("unroll") for(int r=0;r<16;++r)P0[r]=__builtin_amdgcn_exp2f(P0[r]); }while(0)
  #define RESC() do{ if(resc){ asm volatile("s_waitcnt lgkmcnt(0)":::"memory"); \
      _Pragma("unroll") for(int d_=0;d_<2;++d_) _Pragma("unroll") for(int r=0;r<16;++r)o[d_][r]*=wsf[crow(r,hi)]; } }while(0)
  f32x16 pA0,pA1,pB0,pB1;
  int sl_prev=0,sl_cur=0,sl_next=SLOTB;
  #define ROT() do{sl_prev=sl_cur;sl_cur=sl_next;sl_next=(sl_next==(NSLOT-1)*SLOTB)?0:sl_next+SLOTB;}while(0)
  DMA_K(2,2*SLOTB);
  WAIT_BAR(3);
  qkt(pA0,pA1,Kbase,qr,negm,r32,hi);asm volatile("s_nop 15\n\ts_nop 7":"+v"(pA0),"+v"(pA1));CMASK(pA0,pA1,0);
  START(pA0,pA1);
  _Pragma("unroll") for(int r=0;r<16;++r)pA1[r]=__builtin_amdgcn_exp2f(pA1[r]);
  WAIT_BAR(0);
  DMA_K(3,0);DMA_V(1,SLOTB);
  ROT();
  kload8(kf,kp0+sl_cur);
  WAIT_BAR(2);
  s16x4 vlo[8],vhi[8]; u32x4 pw0,pw1,pw2,pw3;
  #define PKW(P,B) cvtpk_s(P[B],P[B+1])
  #define PAF(k) __builtin_bit_cast(bf16x8,pw##k)
  #define VFR(i) (bf16x8){vlo[i][0],vlo[i][1],vlo[i][2],vlo[i][3],vhi[i][0],vhi[i][1],vhi[i][2],vhi[i][3]}
  #define PIN(x) asm volatile("":"+v"(x))
  #define MX3(a,b,c) __builtin_fmaxf(__builtin_fmaxf((a),(b)),(c))
  #define GAPA(MF,A0,A1,A2,A3,W0,W1,PW) do{ MF; sacc+=A0; sacc+=A1; sacc+=A2; sacc+=A3; PIN(sacc); W0; W1; PIN(PW); SBAR(); }while(0)
  #define EX(v) __builtin_amdgcn_exp2f(v)
  #define GAPB(MF,X,B) do{ MF; X[B]=EX(X[B]); X[B+1]=EX(X[B+1]); X[B+2]=EX(X[B+2]); X[B+3]=EX(X[B+3]); PIN(X); SBAR(); }while(0)
  #define VRD(i) do{ vlo[i]=vtr(vp_+(((i)>>2)*4096+((i)&3)*1024)); vhi[i]=vtr(vp_+(((i)>>2)*4096+((i)&3)*1024+512)); }while(0)
  #define KRD(G,j) do{ if(G){ kload2(kf,kp0+sl_next,j); SBAR(); } }while(0)
  #define STEP(C0,C1,P0,P1,t,GK,GV,GL) do{ SBAR(); \
    const lds_cptr vp_=vp0+sl_prev; \
    VRD(0); SBAR(); float sacc=(P0[0]+P0[1]); \
    GAPA(C0=__builtin_amdgcn_mfma_f32_32x32x16_bf16(kf[0],qr[0],negm,0,0,0), P0[2],P0[3],P0[4],P0[5],     pw0[0]=PKW(P0,0), pw0[1]=PKW(P0,2), pw0); \
    VRD(4); SBAR(); GAPA(C1=__builtin_amdgcn_mfma_f32_32x32x16_bf16(kf[1],qr[0],negm,0,0,0), P0[6],P0[7],P0[8],P0[9],     pw0[2]=PKW(P0,4), pw0[3]=PKW(P0,6), pw0); \
    VRD(1); SBAR(); GAPA(C0=__builtin_amdgcn_mfma_f32_32x32x16_bf16(kf[2],qr[1],C0,0,0,0),   P0[10],P0[11],P0[12],P0[13], pw1[0]=PKW(P0,8), pw1[1]=PKW(P0,10), pw1); \
    VRD(5); SBAR(); GAPA(C1=__builtin_amdgcn_mfma_f32_32x32x16_bf16(kf[3],qr[1],C1,0,0,0),   P0[14],P0[15],P1[0],P1[1],   pw1[2]=PKW(P0,12),pw1[3]=PKW(P0,14), pw1); \
    VRD(2); SBAR(); GAPA(C0=__builtin_amdgcn_mfma_f32_32x32x16_bf16(kf[4],qr[2],C0,0,0,0),   P1[2],P1[3],P1[4],P1[5],     pw2[0]=PKW(P1,0), pw2[1]=PKW(P1,2), pw2); \
    VRD(6); SBAR(); GAPA(C1=__builtin_amdgcn_mfma_f32_32x32x16_bf16(kf[5],qr[2],C1,0,0,0),   P1[6],P1[7],P1[8],P1[9],     pw2[2]=PKW(P1,4), pw2[3]=PKW(P1,6), pw2); \
    VRD(3); SBAR(); GAPA(C0=__builtin_amdgcn_mfma_f32_32x32x16_bf16(kf[6],qr[3],C0,0,0,0),   P1[10],P1[11],P1[12],P1[13], pw3[0]=PKW(P1,8), pw3[1]=PKW(P1,10), pw3); \
    VRD(7); SBAR(); GAPA(C1=__builtin_amdgcn_mfma_f32_32x32x16_bf16(kf[7],qr[3],C1,0,0,0),   P1[14],P1[15],0.f,0.f,       pw3[2]=PKW(P1,12),pw3[3]=PKW(P1,14), pw3); \
    l_reg+=sacc; \
    if(GK){DMA_K((t)+3,sl_cur);} if(GV){DMA_V((t)+1,sl_next);} \
    CMASK(C0,C1,t); \
    { float a=MX3(C0[0],C0[1],C1[0]),b=MX3(C0[2],C0[3],C1[1]); a=MX3(a,C1[2],C1[3]); \
      _Pragma("unroll") for(int r=4;r<16;r+=4){a=MX3(a,C0[r],C0[r+1]);b=MX3(b,C0[r+2],C0[r+3]);a=MX3(a,C1[r],C1[r+1]);b=MX3(b,C1[r+2],C1[r+3]);} \
      float rm=__builtin_fmaxf(a,b); { auto rr=__builtin_amdgcn_permlane32_swap(__float_as_uint(rm),__float_as_uint(rm),false,false); rm=__builtin_fmaxf(__uint_as_float(rr[0]),__uint_as_float(rr[1])); } \
      resc=false; \
      if(__builtin_expect(__any(rm>(float)THRL),0)){ const float dl=__builtin_fmaxf(rm,0.f); mhat+=dl; \
        _Pragma("unroll") for(int r=0;r<16;++r){C0[r]-=dl;C1[r]-=dl;} \
        _Pragma("unroll") for(int r=0;r<16;++r)negm[r]=-mhat; asm volatile("":"+v"(negm)); \
        const float f=__builtin_amdgcn_exp2f(-dl); l_reg*=f; if(hi==0)wsf[r32]=f; resc=true; } } \
    SBAR(); \
    GAPB(o[0]=__builtin_amdgcn_mfma_f32_32x32x16_bf16(PAF(0),VFR(0),o[0],0,0,0), C0,0); \
    GAPB(o[1]=__builtin_amdgcn_mfma_f32_32x32x16_bf16(PAF(0),VFR(4),o[1],0,0,0), C0,4); \
    KRD(GL,0); GAPB(o[0]=__builtin_amdgcn_mfma_f32_32x32x16_bf16(PAF(1),VFR(1),o[0],0,0,0), C0,8); \
    KRD(GL,1); GAPB(o[1]=__builtin_amdgcn_mfma_f32_32x32x16_bf16(PAF(1),VFR(5),o[1],0,0,0), C0,12); \
    KRD(GL,2); GAPB(o[0]=__builtin_amdgcn_mfma_f32_32x32x16_bf16(PAF(2),VFR(2),o[0],0,0,0), C1,0); \
    KRD(GL,3); GAPB(o[1]=__builtin_amdgcn_mfma_f32_32x32x16_bf16(PAF(2),VFR(6),o[1],0,0,0), C1,4); \
    GAPB(o[0]=__builtin_amdgcn_mfma_f32_32x32x16_bf16(PAF(3),VFR(3),o[0],0,0,0), C1,8); \
    GAPB(o[1]=__builtin_amdgcn_mfma_f32_32x32x16_bf16(PAF(3),VFR(7),o[1],0,0,0), C1,12); \
    }while(0)
  int t=1;
  #undef CMASK
  #define CMASK(P0,P1,t) do{}while(0)
  for(;t+5<NT;t+=2){
    STEP(pB0,pB1,pA0,pA1,t,true,true,true);     WAIT_BAR(2); RESC(); ROT();
    STEP(pA0,pA1,pB0,pB1,t+1,true,true,true);   WAIT_BAR(2); RESC(); ROT();
  }
  #undef CMASK
  #define CMASK(P0,P1,t) do{}while(0)
  #define ENDW(tt) do{ if((tt)+3<NT){WAIT_BAR(2);} else if((tt)+2<NT){WAIT_BAR(1);} else {WAIT_BAR(0);} }while(0)
  for(;t+1<NT;t+=2){
    STEP(pB0,pB1,pA0,pA1,t,(t+3<NT),(t+1<NT),(t+1<NT));       ENDW(t);   RESC(); ROT();
    STEP(pA0,pA1,pB0,pB1,t+1,(t+4<NT),(t+2<NT),(t+2<NT));     ENDW(t+1); RESC(); ROT();
  }
  STEP(pB0,pB1,pA0,pA1,NT-1,false,false,false); RESC();
  { float sacc=pB0[0]+pB0[1]; _Pragma("unroll") for(int r=2;r<16;++r)sacc+=pB0[r]; _Pragma("unroll") for(int r=0;r<16;++r)sacc+=pB1[r]; l_reg+=sacc;
    pw0=(u32x4){PKW(pB0,0),PKW(pB0,2),PKW(pB0,4),PKW(pB0,6)};pw1=(u32x4){PKW(pB0,8),PKW(pB0,10),PKW(pB0,12),PKW(pB0,14)};pw2=(u32x4){PKW(pB1,0),PKW(pB1,2),PKW(pB1,4),PKW(pB1,6)};pw3=(u32x4){PKW(pB1,8),PKW(pB1,10),PKW(pB1,12),PKW(pB1,14)};
    SBAR(); pv(o,vb0+sl_cur,PAF(0),PAF(1),PAF(2),PAF(3)); }
  #undef PKW
  #undef PAF
  #undef VFR
  #undef PIN
  #undef MX3
  #undef GAPA
  #undef GAPB
  #undef EX
  #undef VRD
  #undef KRD
  #undef STEP
  #undef ENDW
  {auto rr=__builtin_amdgcn_permlane32_swap(__float_as_uint(l_reg),__float_as_uint(l_reg),false,false);l_reg=__uint_as_float(rr[0])+__uint_as_float(rr[1]);}
  if(hi==0)wsf[32+r32]=l_reg;asm volatile("s_waitcnt lgkmcnt(0)":::"memory");
  float rli[16];
  #pragma unroll
  for(int r=0;r<16;++r)rli[r]=__builtin_amdgcn_rcpf(wsf[32+crow(r,hi)]);
  bf16*Ow=Ou+(long)(wid*QBLK)*PO;
  { bf16*stg=(bf16*)(shm+LDS_OST)+wid*2048;
    #pragma unroll
    for(int r=0;r<16;++r){const int orow=crow(r,hi);
      #pragma unroll
      for(int d0=0;d0<2;++d0)stg[orow*64+d0*32+r32]=__float2bfloat16(o[d0][r]*rli[r]);}
    asm volatile("s_waitcnt lgkmcnt(0)":::"memory");
    #pragma unroll
    for(int i=0;i<4;++i){const int row=i*8+(lane>>3),ch=lane&7; const u32x4 v=*(const u32x4*)(stg+row*64+ch*8); ATTN_STORE16(Ow+(long)row*PO+ch*8,v);} }
  asm volatile("s_waitcnt lgkmcnt(0)\n\ts_barrier":::"memory");
  #undef DMA_K
  #undef DMA_V
  #undef CMASK
  #undef START
  #undef RESC
  #undef ROT
}
constexpr int ATTN_LDS_BYTES=LDS_BYTES;
#undef SBAR
#undef WAIT_BAR
}
constexpr int NWAVES = 8;
constexpr int DM = 2048, DFF = 5632, NU = 8960, NMIX = 3072, DEPTH = 2;
constexpr int NTOK = 65536, CH = 16384, NCHUNK = 4;
constexpr int NIN_SRC = 8224;
constexpr float EPS = 1e-6f;
constexpr float C2 = 0.18033688011112042f;
constexpr int U_AQ = 0, U_AK = 768, U_AV = 1536, U_BQ = 2304, U_BK = 3072, U_BV = 3840, U_CQ = 4608, U_CK = 4992, U_CV = 5376, U_CG = 6144, U_GF = 6912, U_GB = 7296, U_DQ = 7680, U_DK = 8448, U_DV = 8704;

constexpr size_t MiB = 1u << 20;
constexpr size_t WS_CTL = 0, CTL_ZERO_BYTES = 1 * MiB;
constexpr size_t WS_TAB = 1 * MiB;
constexpr size_t WS_TAB_AX = WS_TAB + 8192 * 8 * 8;
constexpr size_t WS_W = 2 * MiB;
constexpr size_t W_GU1 = 0, W_D1 = 44 * MiB, W_IN = 66 * MiB, W_OUT = 101 * MiB, W_GU2 = 113 * MiB, W_D2 = 157 * MiB, W_LAYER = 179 * MiB;
constexpr size_t WS_XN = WS_W + 2 * W_LAYER;
constexpr size_t WS_U = WS_XN + 64 * MiB;
constexpr size_t WS_MIX = WS_U + 280 * MiB;
constexpr size_t WS_OA = WS_MIX + 96 * MiB;
constexpr size_t WS_BO = WS_OA + 48 * MiB;
constexpr size_t WS_BL = WS_BO + 72 * MiB;
constexpr size_t WS_OC = WS_BL + 3 * MiB;
constexpr size_t WS_END = WS_OC + 96 * MiB;
constexpr int CW_BAR = 4096;
constexpr int CW_Q = 16384;
constexpr int CW_LAM = 32768;

constexpr int RING_BYTES = 131072;
constexpr int MISC_OFF = RING_BYTES + 320;
constexpr int LDS_BYTES = 147456;

#define GAS __attribute__((address_space(1)))
#define LAS __attribute__((address_space(3)))
#define DI __device__ __forceinline__
typedef unsigned short bfu;
typedef unsigned u32x4 __attribute__((ext_vector_type(4)));
typedef unsigned u32x2 __attribute__((ext_vector_type(2)));
typedef float f32x4 __attribute__((ext_vector_type(4)));
typedef float f32x2 __attribute__((ext_vector_type(2)));
typedef float f32x16 __attribute__((ext_vector_type(16)));
typedef short bf16x8 __attribute__((ext_vector_type(8)));
typedef short s16x4 __attribute__((ext_vector_type(4)));
typedef GAS unsigned gu32;
#define RLX_AGENT __ATOMIC_RELAXED, __HIP_MEMORY_SCOPE_AGENT
#define LDS_WAIT() asm volatile("s_waitcnt lgkmcnt(0)" ::: "memory")
#define VM_WAIT() asm volatile("s_waitcnt vmcnt(0)" ::: "memory")
DI unsigned f2bf(float f) { unsigned u = __builtin_bit_cast(unsigned, f); return (u + 0x7fffu + ((u >> 16) & 1u)) >> 16; }
DI unsigned pk2(float lo, float hi) { typedef __bf16 bf2_t __attribute__((ext_vector_type(2))); f32x2 v = {lo, hi}; bf2_t b = __builtin_convertvector(v, bf2_t); return __builtin_bit_cast(unsigned, b); }
DI float bflo(unsigned w) { return __builtin_bit_cast(float, w << 16); }
DI float bfhi(unsigned w) { return __builtin_bit_cast(float, w & 0xffff0000u); }
DI float bf2f(bfu b) { return __builtin_bit_cast(float, (unsigned)b << 16); }
DI float wave_sum(float v) {
#pragma unroll
    for (int o = 1; o < 64; o <<= 1) v += __shfl_xor(v, o);
    return v;
}
DI int crow(int r, int hi) { return (r & 3) + 8 * (r >> 2) + 4 * hi; }
DI bf16x8 pack8(const f32x16& x, int s) { u32x4 p; p.x = pk2(x[8 * s], x[8 * s + 1]); p.y = pk2(x[8 * s + 2], x[8 * s + 3]); p.z = pk2(x[8 * s + 4], x[8 * s + 5]); p.w = pk2(x[8 * s + 6], x[8 * s + 7]); return __builtin_bit_cast(bf16x8, p); }
typedef short v4i16_t __attribute__((ext_vector_type(4)));
DI s16x4 vtr(const LAS bfu* p) { return __builtin_bit_cast(s16x4, __builtin_amdgcn_ds_read_tr16_b64_v4i16((LAS v4i16_t*)p)); }
DI bf16x8 cat8(s16x4 lo, s16x4 hi) { return (bf16x8){lo[0], lo[1], lo[2], lo[3], hi[0], hi[1], hi[2], hi[3]}; }
#define MFMA32(a, b, c) __builtin_amdgcn_mfma_f32_32x32x16_bf16((a), (b), (c), 0, 0, 0)

#define XB_TMO      128
#define XB_XCNT(j)  (256  + 64 * (j))
#define XB_XSUB(j)  (1280 + 64 * (j))
#define XB_XGEN(j)  (2304 + 64 * (j))
#define XB_TOP      3328
#define XB_TOPGEN   3392
#define XCD_BAR_WORDS 3456
#define XB_SPIN_CAP (1u << 18)

__device__ __forceinline__ unsigned xb_ld(unsigned* p)              { return __hip_atomic_load(p, __ATOMIC_RELAXED, __HIP_MEMORY_SCOPE_AGENT); }
__device__ __forceinline__ unsigned xb_add(unsigned* p, unsigned v) { return __hip_atomic_fetch_add(p, v, __ATOMIC_RELAXED, __HIP_MEMORY_SCOPE_AGENT); }
__device__ __forceinline__ unsigned xb_xcc_id() { return (unsigned)__builtin_amdgcn_s_getreg((3 << 11) | 20) & 0xFu; }
#define XB_SPIN(cond, bar) do { unsigned _sp = 0; while (cond) { __builtin_amdgcn_s_sleep(1); \
    if ((++_sp & 255u) == 0u) { if (xb_ld(&(bar)[XB_TMO])) break; if (_sp > XB_SPIN_CAP) { atomicAdd(&(bar)[XB_TMO], 1u); break; } } } } while (0)

struct XcdBarrier {
    unsigned* bar; unsigned x;
    volatile LAS unsigned* st;
};

__device__ __forceinline__ XcdBarrier xcd_barrier_post(unsigned* bar, volatile LAS unsigned* st) {
    XcdBarrier b; b.bar = bar; b.x = xb_xcc_id(); b.st = st;
    if (threadIdx.x == 0) (void)xb_add(&bar[XB_XCNT(b.x)], 1u);
    return b;
}
__device__ __forceinline__ void xcd_barrier_complete(unsigned* bar, unsigned x, unsigned& nloc, unsigned& nx) {
    const unsigned G = gridDim.x * gridDim.y * gridDim.z;
    unsigned sum, cnt, mine, sp = 0u;
    for (;;) {
        sum = 0u; cnt = 0u; mine = 0u;
#pragma unroll
        for (unsigned j = 0; j < 16; ++j) { const unsigned c = xb_ld(&bar[XB_XCNT(j)]); sum += c; cnt += (c > 0u) ? 1u : 0u; mine = (j == x) ? c : mine; }
        if (sum == G) break;
        __builtin_amdgcn_s_sleep(1);
        if ((++sp & 255u) == 0u) { if (xb_ld(&bar[XB_TMO])) break; if (sp > XB_SPIN_CAP) { atomicAdd(&bar[XB_TMO], 1u); break; } }
    }
    nloc = mine > 0u ? mine : 1u; nx = cnt > 0u ? cnt : 1u;
}

__device__ __forceinline__ void xcd_barrier(const XcdBarrier& b) {
    asm volatile("s_waitcnt vmcnt(0)" ::: "memory");
    __syncthreads();
    if (threadIdx.x == 0) {
        GAS unsigned* gbar_ = (GAS unsigned*)b.bar; asm volatile("" : "+s"(gbar_)); unsigned* bar = (unsigned*)gbar_; unsigned bx_ = b.x; asm volatile("" : "+s"(bx_));
        __builtin_amdgcn_s_waitcnt(0);
        unsigned nloc = b.st[0], nx = b.st[1];
        if (nloc == 0u) { xcd_barrier_complete(bar, bx_, nloc, nx); b.st[0] = nloc; b.st[1] = nx; }
        const unsigned old = xb_add(&bar[XB_XSUB(bx_)], 1u);
        const unsigned gen = old / nloc;
        if (old + 1u == (gen + 1u) * nloc) {
            __builtin_amdgcn_fence(__ATOMIC_RELEASE, "agent");
            asm volatile("s_waitcnt vmcnt(0)" ::: "memory");
            const unsigned og = xb_add(&bar[XB_TOP], 1u);
            const unsigned tg = og / nx;
            if (og + 1u == (tg + 1u) * nx) xb_add(&bar[XB_TOPGEN], 1u);
            else XB_SPIN(xb_ld(&bar[XB_TOPGEN]) == tg, bar);
            __builtin_amdgcn_fence(__ATOMIC_ACQUIRE, "agent");
            xb_add(&bar[XB_XGEN(bx_)], 1u);
            asm volatile("s_waitcnt vmcnt(0)" ::: "memory");
        } else {
            XB_SPIN(xb_ld(&bar[XB_XGEN(bx_)]) == gen, bar);
            __builtin_amdgcn_fence(__ATOMIC_ACQUIRE, "agent");
            asm volatile("s_waitcnt vmcnt(0)" ::: "memory");
        }
    }
    __syncthreads();
}
struct Frame {
    LAS unsigned char* lds;
    volatile LAS unsigned* MISC;
    gu32* ctl;
    int tid, lane, wave;
    int vcu, G;
};
struct Args { const float* in[28]; };

DI void tr_item(const float* W, size_t ldw, int k0, int nsrc0, bfu* WT, size_t Kd, int dstrow0, float scale, LAS float* scr, int lane) {
#pragma unroll 8
    for (int i = 0; i < 32; ++i) { const int kk = 2 * i + (lane >> 5); scr[kk * 33 + (lane & 31)] = W[(size_t)(k0 + kk) * ldw + nsrc0 + (lane & 31)] * scale; }
    LDS_WAIT(); asm volatile("" ::: "memory");
    const int c = lane & 7;
#pragma unroll
    for (int j = 0; j < 4; ++j) { const int n = (lane >> 3) + 8 * j; const LAS float* s = scr + (8 * c) * 33 + n;
        u32x4 o; o.x = pk2(s[0 * 33], s[1 * 33]); o.y = pk2(s[2 * 33], s[3 * 33]); o.z = pk2(s[4 * 33], s[5 * 33]); o.w = pk2(s[6 * 33], s[7 * 33]);
        *(GAS u32x4*)(WT + (size_t)(dstrow0 + n) * Kd + k0 + 8 * c) = o; }
    LDS_WAIT(); asm volatile("" ::: "memory");
}
DI void conv_gu(const float* Wg, const float* Wu, bfu* WT, int r, LAS float* scr, int lane) {
    const int which = r / 5632, it = r % 5632, kb = it / 176, nb = it % 176, n0 = 32 * nb;
    tr_item(which ? Wu : Wg, DFF, 64 * kb, n0, WT, DM, 256 * (n0 / 128) + 128 * which + (n0 % 128), 1.0f, scr, lane);
}
DI void conv_down(const float* Wd, bfu* WT, int it, LAS float* scr, int lane) {
    const int kb = it / 64, nb = it % 64;
    tr_item(Wd, DM, 64 * kb, 32 * nb, WT, DFF, 32 * nb, 1.0f, scr, lane);
}
DI void conv_in(const float* Wi, bfu* WT, int it, LAS float* scr, int lane) {
    const int kb = it / 257, nb = it % 257, n0 = 32 * nb;
    if (n0 == 6912) return;
    const int dst = n0 < 6912 ? n0 : n0 + 736;
    const float sc = (n0 < 768 || (n0 >= 2304 && n0 < 3072)) ? C2 : 1.0f;
    tr_item(Wi, NIN_SRC, 64 * kb, n0, WT, DM, dst, sc, scr, lane);
}
DI void conv_out(const float* Wo, bfu* WT, int it, LAS float* scr, int lane) {
    const int kb = it / 64, nb = it % 64;
    tr_item(Wo, DM, 64 * kb, 32 * nb, WT, NMIX, 32 * nb, 1.0f, scr, lane);
}
DI void conv_gate(const float* Wi, const float* Gf, const float* Gb, bfu* WT, int it) {
    const int kc = it & 255, n = (it >> 8) % 384, dir = it / (256 * 384);
    const float* G = dir ? Gb : Gf; float g[16];
#pragma unroll
    for (int r = 0; r < 16; ++r) g[r] = G[r * 384 + n];
    float o[8];
#pragma unroll
    for (int k = 0; k < 8; ++k) { const float* w = Wi + (size_t)(8 * kc + k) * NIN_SRC + 6912 + 16 * dir; float s = 0.f;
#pragma unroll
        for (int r = 0; r < 16; ++r) s += w[r] * g[r];
        o[k] = s; }
    u32x4 v; v.x = pk2(o[0], o[1]); v.y = pk2(o[2], o[3]); v.z = pk2(o[4], o[5]); v.w = pk2(o[6], o[7]);
    *(GAS u32x4*)(WT + (size_t)(6912 + 384 * dir + n) * DM + 8 * kc) = v;
}
DI void sincos_d(double a, float& c, float& s) {
    const double k = rint(a * 0.15915494309189535);
    double r = fma(-k, 6.283185307179586, a); r = fma(-k, 2.4492935982947064e-16, r);
    const double r2 = r * r; double sv = 1.0, cv = 1.0;
#pragma unroll
    for (int n = 14; n >= 1; --n) { sv = 1.0 - sv * r2 * (1.0 / (double)((2 * n) * (2 * n + 1))); cv = 1.0 - cv * r2 * (1.0 / (double)((2 * n - 1) * (2 * n))); }
    s = (float)(sv * r); c = (float)cv;
}
__device__ const double INV_P[8] = {1.0, 0.19392274474868576, 0.03760603093086393, 0.007292664737217109, 0.001414213562373095, 0.0002742481756762073, 5.318295896944988e-05, 1.031338537721246e-05};
__device__ const double INV_AX[16] = {1.0, 0.5623413251903491, 0.31622776601683794, 0.1778279410038923, 0.1, 0.05623413251903491, 0.03162277660168379, 0.01778279410038923, 0.01, 0.005623413251903491, 0.0031622776601683794, 0.0017782794100389228, 0.001, 0.0005623413251903491, 0.00031622776601683794, 0.00017782794100389227};

DI void p0_prologue(Frame& F0, const Args& A) {
    Frame F = F0; asm volatile("" : "+v"(F.tid), "+v"(F.lane), "+s"(F.wave), "+s"(F.vcu), "+s"(F.G));
    LAS float* scr = (LAS float*)(F.lds + F.wave * 16384);
    const int gw = F.vcu * NWAVES + F.wave, NGW = F.G * NWAVES;
    constexpr int I_GU = 2 * 5632, I_D = 5632, I_IN = 8224, I_OUT = 3072, I_LAYER = 2 * I_GU + 2 * I_D + I_IN + I_OUT;
    for (int it = gw; it < DEPTH * I_LAYER; it += NGW) {
        const int l = it / I_LAYER; int r = it % I_LAYER;
        bfu* wl = (bfu*)(((unsigned char*)A.in[27]) + WS_W + (size_t)l * W_LAYER);
        if (r < I_GU) { conv_gu(A.in[3] + (size_t)l * DM * DFF, A.in[4] + (size_t)l * DM * DFF, wl + W_GU1 / 2, r, scr, F.lane); continue; } r -= I_GU;
        if (r < I_D) { conv_down(A.in[5] + (size_t)l * DM * DFF, wl + W_D1 / 2, r, scr, F.lane); continue; } r -= I_D;
        if (r < I_IN) { conv_in(A.in[7] + (size_t)l * DM * NIN_SRC, wl + W_IN / 2, r, scr, F.lane); continue; } r -= I_IN;
        if (r < I_OUT) { conv_out(A.in[8] + (size_t)l * NMIX * DM, wl + W_OUT / 2, r, scr, F.lane); continue; } r -= I_OUT;
        if (r < I_GU) { conv_gu(A.in[22] + (size_t)l * DM * DFF, A.in[23] + (size_t)l * DM * DFF, wl + W_GU2 / 2, r, scr, F.lane); continue; } r -= I_GU;
        conv_down(A.in[24] + (size_t)l * DM * DFF, wl + W_D2 / 2, r, scr, F.lane);
    }
    const int gt = F.vcu * (NWAVES * 64) + F.tid, NGT = F.G * NWAVES * 64;
    for (int it = gt; it < DEPTH * 2 * 384 * 256; it += NGT) { const int l = it / (2 * 384 * 256), r = it % (2 * 384 * 256);
        conv_gate(A.in[7] + (size_t)l * DM * NIN_SRC, A.in[14] + (size_t)l * 16 * 384, A.in[16] + (size_t)l * 16 * 384, (bfu*)(((unsigned char*)A.in[27]) + WS_W + (size_t)l * W_LAYER + W_IN), r); }
    f32x2* pcs = (f32x2*)(((unsigned char*)A.in[27]) + WS_TAB); f32x2* axcs = (f32x2*)(((unsigned char*)A.in[27]) + WS_TAB_AX);
    for (int it = gt; it < 8192 * 8 + 128 * 16; it += NGT) {
        float c, s;
        if (it < 8192 * 8) { sincos_d((double)(it >> 3) * INV_P[it & 7], c, s); pcs[it] = (f32x2){c, s}; }
        else { const int j = it - 8192 * 8; sincos_d((double)(j >> 4) * INV_AX[j & 15], c, s); axcs[j] = (f32x2){c, s}; }
    }
    if (blockIdx.x == 0 && F.wave == 0) {
#pragma unroll
        for (int l = 0; l < DEPTH; ++l) {
            const float a = wave_sum(A.in[9][l * 64 + F.lane] * A.in[10][l * 64 + F.lane]), b = wave_sum(A.in[11][l * 64 + F.lane] * A.in[12][l * 64 + F.lane]);
            const float lam_init = 0.8f - 0.6f * expf(-0.3f * (float)l);
            if (F.lane == 0) F.ctl[CW_LAM + l] = __builtin_bit_cast(unsigned, expf(a) - expf(b) + lam_init);
        }
    }
}

DI void norm_rows(Frame& F0, const float* x, bfu* xn, const float* gain) {
    Frame F = F0; asm volatile("" : "+v"(F.tid), "+v"(F.lane), "+s"(F.wave), "+s"(F.vcu), "+s"(F.G));
    const int gw = F.vcu * NWAVES + F.wave, NGW = F.G * NWAVES;
    f32x4 g[8];
#pragma unroll
    for (int j = 0; j < 8; ++j) g[j] = ((const f32x4*)gain)[F.lane + 64 * j];
    for (int m = gw; m < CH; m += NGW) {
        const f32x4* xr = (const f32x4*)(x + (size_t)m * DM) + F.lane;
        f32x4 v[8]; float s = 0.f;
#pragma unroll
        for (int j = 0; j < 8; ++j) { v[j] = xr[64 * j]; s += (v[j].x * v[j].x + v[j].y * v[j].y) + (v[j].z * v[j].z + v[j].w * v[j].w); }
        const float rstd = 1.0f / sqrtf(wave_sum(s) * (1.f / DM) + EPS);
        u32x2* o8 = (u32x2*)(xn + (size_t)m * DM) + F.lane;
#pragma unroll
        for (int j = 0; j < 8; ++j) { u32x2 w; w.x = pk2(v[j].x * rstd * g[j].x, v[j].y * rstd * g[j].y); w.y = pk2(v[j].z * rstd * g[j].z, v[j].w * rstd * g[j].w); o8[64 * j] = w; }
    }
}
DI void final_norm_rows(Frame& F0, float* x, const float* gain) {
    Frame F = F0; asm volatile("" : "+v"(F.tid), "+v"(F.lane), "+s"(F.wave), "+s"(F.vcu), "+s"(F.G));
    const int gw = F.vcu * NWAVES + F.wave, NGW = F.G * NWAVES;
    f32x4 g[8];
#pragma unroll
    for (int j = 0; j < 8; ++j) g[j] = ((const f32x4*)gain)[F.lane + 64 * j];
    for (int m = gw; m < NTOK; m += NGW) {
        f32x4* xr = (f32x4*)(x + (size_t)m * DM) + F.lane;
        f32x4 v[8]; float s = 0.f;
#pragma unroll
        for (int j = 0; j < 8; ++j) { v[j] = xr[64 * j]; s += (v[j].x * v[j].x + v[j].y * v[j].y) + (v[j].z * v[j].z + v[j].w * v[j].w); }
        const float rstd = 1.0f / sqrtf(wave_sum(s) * (1.f / DM) + EPS);
#pragma unroll
        for (int j = 0; j < 8; ++j) xr[64 * j] = v[j] * rstd * g[j];
    }
}

DI void prep_rows(Frame& F0, bfu* U, int L, const f32x2* pcs, const f32x2* axcs, const float* gq, const float* gk) {
    Frame F = F0; asm volatile("" : "+v"(F.tid), "+v"(F.lane), "+s"(F.wave), "+s"(F.vcu), "+s"(F.G));
    const int gt = F.vcu * (NWAVES * 64) + F.tid, NGT = F.G * NWAVES * 64;
    for (int it = gt; it < CH * 64; it += NGT) {
        const int row = it >> 6, slot = it & 63, t = row & (L - 1);
        if (slot < 48) {
            const int seg = slot / 12, h = slot % 12;
            const int col = (seg == 0 ? U_AQ : seg == 1 ? U_AK : seg == 2 ? U_BQ : U_BK) + h * 64;
            u32x4* p = (u32x4*)(U + (size_t)row * NU + col);
            const u32x4 a = p[0], b = p[1];
            const f32x4* cs = (const f32x4*)(pcs + t * 8);
            u32x4 oa, ob;
#pragma unroll
            for (int w = 0; w < 4; ++w) { const f32x4 q = cs[w]; const float x1l = bflo(a[w]), x1h = bfhi(a[w]), x2l = bflo(b[w]), x2h = bfhi(b[w]);
                oa[w] = pk2(x1l * q.x - x2l * q.y, x1h * q.z - x2h * q.w); ob[w] = pk2(x2l * q.x + x1l * q.y, x2h * q.z + x1h * q.w); }
            p[0] = oa; p[1] = ob;
        } else {
            const int sl = slot - 48; const bool isq = sl < 12;
            const int col = isq ? U_DQ + sl * 64 : U_DK + (sl - 12) * 64;
            const float* gain = isq ? gq : gk;
            u32x4* p = (u32x4*)(U + (size_t)row * NU + col);
            float x[64]; float ss = 0.f;
#pragma unroll
            for (int w = 0; w < 8; ++w) { const u32x4 v = p[w];
#pragma unroll
                for (int e = 0; e < 4; ++e) { x[8 * w + 2 * e] = bflo(v[e]); x[8 * w + 2 * e + 1] = bfhi(v[e]); } }
#pragma unroll
            for (int i = 0; i < 64; ++i) ss += x[i] * x[i];
            const float rstd = (1.0f / sqrtf(ss * (1.f / 64.f) + EPS)) * (isq ? C2 : 1.0f);
#pragma unroll
            for (int i = 0; i < 64; ++i) x[i] = x[i] * rstd * gain[i];
            const f32x2* cr = axcs + (t >> 6) * 16; const f32x2* cc = axcs + (t & 63) * 16;
#pragma unroll
            for (int i = 0; i < 16; ++i) { const f32x2 q = cr[i]; const float x1 = x[i], x2 = x[16 + i]; x[i] = x1 * q.x - x2 * q.y; x[16 + i] = x2 * q.x + x1 * q.y; }
#pragma unroll
            for (int i = 0; i < 16; ++i) { const f32x2 q = cc[i]; const float x1 = x[32 + i], x2 = x[48 + i]; x[32 + i] = x1 * q.x - x2 * q.y; x[48 + i] = x2 * q.x + x1 * q.y; }
#pragma unroll
            for (int w = 0; w < 8; ++w) { u32x4 v;
#pragma unroll
                for (int e = 0; e < 4; ++e) v[e] = pk2(x[8 * w + 2 * e], x[8 * w + 2 * e + 1]);
                p[w] = v; }
        }
    }
}

DI void bwin_task(const bfu* U, int seqrow0, int L, int hb, int dil, int idx, bfu* Bo, float* Bl, LAS unsigned char* wl, int lane) {
    asm volatile("" : "+v"(lane));
    const int N = L / dil, qb = idx / dil, rr = idx % dil;
    const int r32 = lane & 31, hi = lane >> 5, q4 = (lane & 15) >> 2, g16 = (lane >> 4) & 1, p4 = lane & 3;
    const bfu* Qc = U + U_BQ + hb * 64; const bfu* Kc = U + U_BK + hb * 64; const bfu* Vc = U + U_BV + hb * 64;
    LAS bfu* vt = (LAS bfu*)wl; LAS float* lsc = (LAS float*)(wl + 9216);
    const int kbase = 64 * (qb - 1);
#define B_ROW(sub) ((size_t)(seqrow0 + (sub) * dil + rr))
    bf16x8 qf[2][4];
#pragma unroll
    for (int tb = 0; tb < 2; ++tb) { const bfu* qp = Qc + B_ROW(64 * qb + 32 * tb + r32) * NU + 8 * hi;
#pragma unroll
        for (int st = 0; st < 4; ++st) qf[tb][st] = *(const bf16x8*)(qp + 16 * st); }
#pragma unroll
    for (int tb = 0; tb < 2; ++tb) {
        f32x16 sc[5];
#pragma unroll
        for (int kbi = 0; kbi < 5; ++kbi) {
            const int kb = tb + kbi;
            int kp = kbase + 32 * kb + r32; kp = kp < 0 ? 0 : (kp > N - 1 ? N - 1 : kp);
            const bfu* kr = Kc + B_ROW(kp) * NU + 8 * hi;
            const bf16x8 k0 = *(const bf16x8*)(kr), k1 = *(const bf16x8*)(kr + 16), k2 = *(const bf16x8*)(kr + 32), k3 = *(const bf16x8*)(kr + 48);
            f32x16 a = {};
            a = MFMA32(k0, qf[tb][0], a); a = MFMA32(k1, qf[tb][1], a); a = MFMA32(k2, qf[tb][2], a); a = MFMA32(k3, qf[tb][3], a);
            if (kbi == 0) {
#pragma unroll
                for (int i = 0; i < 16; ++i) a[i] = (crow(i, hi) >= r32) ? a[i] : -1e30f; }
            if (kbi == 4) {
#pragma unroll
                for (int i = 0; i < 16; ++i) a[i] = (crow(i, hi) <= r32) ? a[i] : -1e30f; }
            const int kb0 = kbase + 32 * kb;
            if (kb0 < 0 || kb0 >= N) {
#pragma unroll
                for (int i = 0; i < 16; ++i) a[i] = -1e30f; }
            sc[kbi] = a;
        }
        float m = sc[0][0];
#pragma unroll
        for (int kbi = 0; kbi < 5; ++kbi)
#pragma unroll
            for (int i = 0; i < 16; ++i) m = fmaxf(m, sc[kbi][i]);
        m = fmaxf(m, __shfl_xor(m, 32));
        float l = 0.f;
#pragma unroll
        for (int kbi = 0; kbi < 5; ++kbi)
#pragma unroll
            for (int i = 0; i < 16; ++i) { const float p = __builtin_amdgcn_exp2f(sc[kbi][i] - m); sc[kbi][i] = p; l += p; }
        l += __shfl_xor(l, 32);
        bf16x8 pf[5][2];
#pragma unroll
        for (int kbi = 0; kbi < 5; ++kbi) { pf[kbi][0] = pack8(sc[kbi], 0); pf[kbi][1] = pack8(sc[kbi], 1); }
        f32x16 o[2] = {{}, {}};
#pragma unroll
        for (int g = 0; g < 3; ++g) {
#pragma unroll
            for (int i = 0; i < 8; ++i) { const int kl = (lane >> 3) + 8 * i; int kp = kbase + 64 * g + kl; kp = kp < 0 ? 0 : (kp > N - 1 ? N - 1 : kp);
                const u32x4 v = *(const u32x4*)(Vc + B_ROW(kp) * NU + 8 * (lane & 7));
                *(LAS u32x4*)(vt + kl * 72 + 8 * (lane & 7)) = v; }
            LDS_WAIT();
#pragma unroll
            for (int kbl = 0; kbl < 2; ++kbl) { const int kbi = 2 * g + kbl - tb;
                if (kbi >= 0 && kbi <= 4) {
#pragma unroll
                    for (int s2 = 0; s2 < 2; ++s2)
#pragma unroll
                        for (int db = 0; db < 2; ++db) { const LAS bfu* vp = vt + (32 * kbl + 16 * s2 + 4 * hi + q4) * 72 + 32 * db + 16 * g16 + 4 * p4;
                            const bf16x8 vf = cat8(vtr(vp), vtr(vp + 8 * 72));
                            o[db] = MFMA32(pf[kbi][s2 < 1 ? 0 : 1], vf, o[db]); }
                } }
            LDS_WAIT();
        }
        if (hi == 0) lsc[r32] = l;
        LDS_WAIT();
        if (hi == 0) Bl[B_ROW(64 * qb + 32 * tb + r32) * 12 + hb] = m + __builtin_amdgcn_logf(l);
#pragma unroll
        for (int i = 0; i < 16; ++i) { const int ql = crow(i, hi); const float inv = __builtin_amdgcn_rcpf(lsc[ql]);
            bfu* op = Bo + B_ROW(64 * qb + 32 * tb + ql) * 768 + hb * 64 + r32;
            op[0] = (bfu)f2bf(o[0][i] * inv); op[32] = (bfu)f2bf(o[1][i] * inv); }
        LDS_WAIT();
    }
#undef B_ROW
}

DI float logsig16(float x) { const float e = __builtin_amdgcn_exp2f(-1.4426950408889634f * fabsf(x)); return (fminf(x, 0.f) - 0.6931471805599453f * __builtin_amdgcn_logf(1.0f + e)) * 0.0625f; }
DI void gla_task(const bfu* U, int seqrow0, int L, int hc, int dir, int half, const float* gbias, float* Oc, LAS unsigned char* wl, int lane) {
    asm volatile("" : "+v"(lane));
    const int r32 = lane & 31, hi = lane >> 5, q4 = (lane & 15) >> 2, g16 = (lane >> 4) & 1, p4 = lane & 3, il = lane >> 3, dc = lane & 7;
    LAS bfu* qd = (LAS bfu*)wl; LAS bfu* ki = (LAS bfu*)(wl + 9216); LAS bfu* vv = (LAS bfu*)(wl + 18432); LAS float* decl = (LAS float*)(wl + 27648);
    const bfu* Qc = U + U_CQ + hc * 64 + 8 * dc; const bfu* Kc = U + U_CK + hc * 64 + 8 * dc; const bfu* Vc = U + U_CV + hc * 128 + half * 64 + 8 * dc;
    const bfu* Gc = U + (dir ? U_GB : U_GF) + hc * 64 + 8 * dc;
    const f32x4* gb4 = (const f32x4*)(gbias + hc * 64 + 8 * dc);
    f32x16 S[2][2] = {{{}, {}}, {{}, {}}};
    const int NC = L >> 6;
#define G_ROW(p) ((size_t)(seqrow0 + (dir ? (L - 1 - (p)) : (p))))
    u32x4 nq, nk, nv, ng;
    { const size_t rw = G_ROW(il) * NU; nq = *(const u32x4*)(Qc + rw); nk = *(const u32x4*)(Kc + rw); nv = *(const u32x4*)(Vc + rw); ng = *(const u32x4*)(Gc + rw); }
    for (int c = 0; c < NC; ++c) {
        float carry[8];
#pragma unroll
        for (int e = 0; e < 8; ++e) carry[e] = 0.f;
#pragma unroll 1
        for (int bt = 0; bt < 8; ++bt) {
            const u32x4 cq = nq, ck = nk, cv = nv, cg = ng;
            const int pn = 64 * c + 8 * (bt + 1) + il;
            if (pn < L) { const size_t rw = G_ROW(pn) * NU; nq = *(const u32x4*)(Qc + rw); nk = *(const u32x4*)(Kc + rw); nv = *(const u32x4*)(Vc + rw); ng = *(const u32x4*)(Gc + rw); }
            float cum[8];
            { const f32x4 b0 = gb4[0], b1 = gb4[1]; const float bias8[8] = {b0.x, b0.y, b0.z, b0.w, b1.x, b1.y, b1.z, b1.w};
#pragma unroll
            for (int w = 0; w < 4; ++w) { cum[2 * w] = logsig16(bflo(cg[w]) + bias8[2 * w]); cum[2 * w + 1] = logsig16(bfhi(cg[w]) + bias8[2 * w + 1]); } }
#pragma unroll
            for (int e = 0; e < 8; ++e) { float t = cum[e]; float y = __shfl_up(t, 8); if (il >= 1) t += y; y = __shfl_up(t, 16); if (il >= 2) t += y; y = __shfl_up(t, 32); if (il >= 4) t += y; cum[e] = carry[e] + t; }
#pragma unroll
            for (int e = 0; e < 8; ++e) carry[e] = __shfl(cum[e], 56 + dc);
            u32x4 oq, ok;
#pragma unroll
            for (int w = 0; w < 4; ++w) {
                const float e0 = __builtin_amdgcn_exp2f(1.4426950408889634f * cum[2 * w]), e1 = __builtin_amdgcn_exp2f(1.4426950408889634f * cum[2 * w + 1]);
                oq[w] = pk2(bflo(cq[w]) * (0.125f * e0), bfhi(cq[w]) * (0.125f * e1));
                ok[w] = pk2(bflo(ck[w]) * __builtin_amdgcn_rcpf(e0), bfhi(ck[w]) * __builtin_amdgcn_rcpf(e1)); }
            const int i = 8 * bt + il;
            *(LAS u32x4*)(qd + i * 72 + 8 * dc) = oq; *(LAS u32x4*)(ki + i * 72 + 8 * dc) = ok; *(LAS u32x4*)(vv + i * 72 + 8 * dc) = cv;
        }
        if (il == 0) {
#pragma unroll
            for (int e = 0; e < 8; ++e) decl[8 * dc + e] = __builtin_amdgcn_exp2f(1.4426950408889634f * carry[e]); }
        LDS_WAIT();
        bf16x8 xf[3][2];
#pragma unroll
        for (int blk = 0; blk < 3; ++blk) { const int sb = blk == 2 ? 1 : 0, tb = blk >= 1 ? 1 : 0;
            f32x16 a = {};
#pragma unroll
            for (int st = 0; st < 4; ++st) { const bf16x8 af = *(const LAS bf16x8*)(ki + (32 * sb + r32) * 72 + 16 * st + 8 * hi); const bf16x8 bf = *(const LAS bf16x8*)(qd + (32 * tb + r32) * 72 + 16 * st + 8 * hi);
                a = MFMA32(af, bf, a); }
            if (sb == tb) {
#pragma unroll
                for (int i = 0; i < 16; ++i) a[i] = (crow(i, hi) <= r32) ? a[i] : 0.f; }
            xf[blk][0] = pack8(a, 0); xf[blk][1] = pack8(a, 1); }
#pragma unroll
        for (int tb = 0; tb < 2; ++tb)
#pragma unroll
            for (int eb = 0; eb < 2; ++eb) {
                f32x16 o = {};
#pragma unroll
                for (int sb = 0; sb < 2; ++sb) { if (sb <= tb) { const int blk = sb == 0 ? tb : 2;
#pragma unroll
                    for (int s2 = 0; s2 < 2; ++s2) { const LAS bfu* vp = vv + (32 * sb + 16 * s2 + 4 * hi + q4) * 72 + 32 * eb + 16 * g16 + 4 * p4;
                        o = MFMA32(xf[blk][s2], cat8(vtr(vp), vtr(vp + 8 * 72)), o); } } }
#pragma unroll
                for (int db = 0; db < 2; ++db)
#pragma unroll
                    for (int s2 = 0; s2 < 2; ++s2) { const LAS bfu* qp = qd + (32 * tb + r32) * 72 + 32 * db + 16 * s2 + 4 * hi;
                        const bf16x8 af = cat8(*(const LAS s16x4*)qp, *(const LAS s16x4*)(qp + 8));
                        o = MFMA32(af, pack8(S[db][eb], s2), o); }
#pragma unroll
                for (int i = 0; i < 16; ++i) Oc[G_ROW(64 * c + 32 * tb + crow(i, hi)) * 768 + hc * 128 + half * 64 + 32 * eb + r32] = o[i];
            }
#pragma unroll
        for (int db = 0; db < 2; ++db)
#pragma unroll
            for (int eb = 0; eb < 2; ++eb) {
#pragma unroll
                for (int st = 0; st < 4; ++st) { const LAS bfu* kp = ki + (16 * st + 8 * hi + q4) * 72 + 32 * db + 16 * g16 + 4 * p4; const LAS bfu* vp = vv + (16 * st + 8 * hi + q4) * 72 + 32 * eb + 16 * g16 + 4 * p4;
                    S[db][eb] = MFMA32(cat8(vtr(kp), vtr(kp + 4 * 72)), cat8(vtr(vp), vtr(vp + 4 * 72)), S[db][eb]); }
#pragma unroll
                for (int i = 0; i < 16; ++i) S[db][eb][i] *= decl[32 * db + crow(i, hi)];
            }
        LDS_WAIT();
    }
#undef G_ROW
}

DI void finalize_rows(Frame& F0, const float* gain_a, const float* gain_c, int l, const bfu* U, const bfu* OA, const bfu* BO, const float* BL, const float* OC, bfu* MIX) {
    Frame F = F0; asm volatile("" : "+v"(F.tid), "+v"(F.lane), "+s"(F.wave), "+s"(F.vcu), "+s"(F.G));
    const int lane = F.lane;
    const int gw = F.vcu * NWAVES + F.wave, NGW = F.G * NWAVES;
    const float lam = __builtin_bit_cast(float, (unsigned)F.ctl[CW_LAM + l]);
    const float lam_init = 0.8f - 0.6f * expf(-0.3f * (float)l);
    const f32x2 ga = ((const f32x2*)gain_a)[lane], gc = ((const f32x2*)gain_c)[lane];
    for (int m = gw; m < CH; m += NGW) {
#pragma unroll
        for (int a = 0; a < 6; ++a) { const bfu* p = OA + (size_t)m * 1536 + a * 256;
            const unsigned w1 = *(const unsigned*)(p + 2 * lane), w2 = *(const unsigned*)(p + 128 + 2 * lane);
            const float d0 = bflo(w1) - lam * bflo(w2), d1 = bfhi(w1) - lam * bfhi(w2);
            const float rstd = (1.0f / sqrtf(wave_sum(d0 * d0 + d1 * d1) * (1.f / 128.f) + EPS)) * (1.0f - lam_init);
            *(unsigned*)(MIX + (size_t)m * NMIX + a * 128 + 2 * lane) = pk2(d0 * rstd * ga.x, d1 * rstd * ga.y); }
#pragma unroll
        for (int h = 0; h < 6; ++h) { const f32x2 f = *(const f32x2*)(OC + (size_t)m * 768 + h * 128 + 2 * lane), b = *(const f32x2*)(OC + (size_t)CH * 768 + (size_t)m * 768 + h * 128 + 2 * lane);
            const float y0 = f.x + b.x, y1 = f.y + b.y;
            const float rstd = 1.0f / sqrtf(wave_sum(y0 * y0 + y1 * y1) * (1.f / 128.f) + EPS);
            const unsigned gw2 = *(const unsigned*)(U + (size_t)m * NU + U_CG + h * 128 + 2 * lane);
            *(unsigned*)(MIX + (size_t)m * NMIX + 1536 + h * 128 + 2 * lane) = pk2(y0 * rstd * gc.x * pg8::silu_f(bflo(gw2)), y1 * rstd * gc.y * pg8::silu_f(bfhi(gw2))); }
#pragma unroll
        for (int h = 0; h < 12; ++h) { const float l0 = BL[(size_t)m * 12 + h], l1 = BL[(size_t)CH * 12 + (size_t)m * 12 + h], l2 = BL[(size_t)2 * CH * 12 + (size_t)m * 12 + h];
            const float mx = fmaxf(l0, fmaxf(l1, l2)); const float w0 = __builtin_amdgcn_exp2f(l0 - mx), w1 = __builtin_amdgcn_exp2f(l1 - mx), w2 = __builtin_amdgcn_exp2f(l2 - mx);
            const float inv = 1.0f / (w0 + w1 + w2);
            const float o = (w0 * bf2f(BO[(size_t)m * 768 + h * 64 + lane]) + w1 * bf2f(BO[(size_t)CH * 768 + (size_t)m * 768 + h * 64 + lane]) + w2 * bf2f(BO[(size_t)2 * CH * 768 + (size_t)m * 768 + h * 64 + lane])) * inv;
            MIX[(size_t)m * NMIX + 768 + h * 64 + lane] = (bfu)f2bf(o); }
    }
}

__global__ void __launch_bounds__(NWAVES * 64, 2) hybrid_fwd(Args args) {
    extern __shared__ __attribute__((aligned(16))) unsigned char lds[];
    Frame F;
    F.lds = (LAS unsigned char*)lds;
    F.MISC = (volatile LAS unsigned*)(F.lds + MISC_OFF);
    F.tid = threadIdx.x; F.lane = F.tid & 63; F.wave = __builtin_amdgcn_readfirstlane(F.tid >> 6);
    F.G = gridDim.x; { const int bx = blockIdx.x; F.vcu = (F.G % 8 == 0) ? (bx % 8) * (F.G / 8) + bx / 8 : bx; }
    GAS unsigned char* ws = (GAS unsigned char*)args.in[27];
    F.ctl = (gu32*)(ws + WS_CTL);
    for (int u = F.tid; u < (LDS_BYTES - RING_BYTES) / 4; u += NWAVES * 64) ((LAS unsigned*)(F.lds + RING_BYTES))[u] = 0u;
    __syncthreads();
    XcdBarrier bar = xcd_barrier_post((unsigned*)(F.ctl + CW_BAR), F.MISC + 8);
    int zz = 0;
#define AIN(i) (args.in[(i) + zz])
#define GRID_BAR() do { xcd_barrier(bar); asm volatile("" : "+s"(ws), "+s"(l), "+s"(c), "+s"(zz)); } while (0)

#define XN ((bfu*)(ws + WS_XN))
#define U ((bfu*)(ws + WS_U))
#define HID ((bfu*)(ws + WS_U))
#define MIX ((bfu*)(ws + WS_MIX))
#define OA ((bfu*)(ws + WS_OA))
#define BO ((bfu*)(ws + WS_BO))
#define BL ((float*)(ws + WS_BL))
#define OC ((float*)(ws + WS_OC))
#define pcs ((const f32x2*)(ws + WS_TAB))
#define axcs ((const f32x2*)(ws + WS_TAB_AX))
#define WL ((const bfu*)(ws + WS_W + (size_t)l * W_LAYER))
#define xout ((float*)AIN(26) + (size_t)c * CH * DM)
#define xin ((l == 0) ? ((c < 2) ? AIN(0) + (size_t)c * CH * DM : AIN(1) + (size_t)(c - 2) * CH * DM) : xout)
#define L ((c < 2) ? 8192 : 2048)
#define nseq (CH / L)

#ifndef NO_PRO
    p0_prologue(F, args);
#endif
    xcd_barrier(bar);

    for (int l = 0; l < DEPTH; ++l) {
        for (int c = 0; c < NCHUNK; ++c) {

            norm_rows(F, xin, XN, AIN(2) + l * DM);
            GRID_BAR();
            { pg8::Gemm g{XN, WL + W_GU1 / 2, CH, 2 * DFF, DM}; pg8::StaticOrder S; S.init(CH, 2 * DFF, F.G, (int)blockIdx.x);
              pg8::EpiSwiglu E{HID, DFF};
              pg8::gemm_phase<pg8::EpiSwiglu, pg8::StaticOrder, true, true>(F.lds, g, S, E); }
            GRID_BAR();
            { pg8::Gemm g{HID, WL + W_D1 / 2, CH, DM, DFF}; pg8::StaticOrder S; S.init(CH, DM, F.G, (int)blockIdx.x);
              pg8::EpiResid E{xin, xout, DM, 0.5f};
              pg8::gemm_phase<pg8::EpiResid, pg8::StaticOrder, true, true>(F.lds, g, S, E); }
            GRID_BAR();

            norm_rows(F, xout, XN, AIN(6) + l * DM);
            GRID_BAR();
            { pg8::Gemm g{XN, WL + W_IN / 2, CH, NU, DM}; pg8::StaticOrder S; S.init(CH, NU, F.G, (int)blockIdx.x);
              pg8::EpiPlain E{U, NU};
              pg8::gemm_phase<pg8::EpiPlain, pg8::StaticOrder, true, true>(F.lds, g, S, E); }
            GRID_BAR();
#ifndef NO_PREP
            prep_rows(F, U, L, pcs, axcs, AIN(19) + l * 64, AIN(20) + l * 64);
#endif
            GRID_BAR();

            {
                gu32* qh = F.ctl + CW_Q + 64 * ((l * NCHUNK + c) * 3);
#define DEQUEUE(kind, var) do { if (F.tid == 0) F.MISC[0] = __hip_atomic_fetch_add(qh + 64 * (kind), 1u, RLX_AGENT); __syncthreads(); var = (int)F.MISC[0]; __syncthreads(); } while (0)
                const int n_gla = nseq * 24 / 4;
                for (;;) { int un; DEQUEUE(0, un); if (un >= n_gla) break;
                    if (F.wave < 4) { const int task = un * 4 + F.wave, half = task & 1, dir = (task >> 1) & 1, hc = (task >> 2) % 6, sq = task / 24;
#ifndef NO_GLA
                        gla_task(U, sq * L, L, hc, dir, half, (dir ? AIN(17) : AIN(15)) + l * 384, OC + (size_t)dir * CH * 768, F.lds + F.wave * 28672, F.lane);
#endif
 }
                }
                const int nqb = L / 256, n_att = nseq * 36 * nqb;
                for (;;) { int un; DEQUEUE(1, un); if (un >= n_att) break;
                    const int sq = un / (36 * nqb), rem = un % (36 * nqb), vh = rem / nqb, qb = rem % nqb;
                    int qc, kc, vc; bfu* Ob; long PO;
                    if (vh < 24) { const int a = vh >> 2, cmp = (vh >> 1) & 1, vhalf = vh & 1; qc = U_AQ + a * 128 + cmp * 64; kc = U_AK + a * 128 + cmp * 64; vc = U_AV + a * 128 + vhalf * 64; Ob = OA + vh * 64; PO = 1536; }
                    else { const int hq = vh - 24; qc = U_DQ + hq * 64; kc = U_DK + (hq / 3) * 64; vc = U_DV + (hq / 3) * 64; Ob = MIX + 2304 + hq * 64; PO = NMIX; }
                    const size_t r0 = (size_t)sq * L;
#ifndef NO_ATT
                    attn_body::attn_unit<8>((const attn_body::bf16*)(U + (r0 + (size_t)qb * 256) * NU + qc), (const attn_body::bf16*)(U + r0 * NU + kc), (const attn_body::bf16*)(U + r0 * NU + vc),
                                            (attn_body::bf16*)(Ob + (r0 + (size_t)qb * 256) * PO), PO, L / 64, (char*)lds);
#endif
                }
                const int tps = L / 64, n_b = nseq * 36 * tps / 8;
                for (;;) { int un; DEQUEUE(2, un); if (un >= n_b) break;
                    const int task = un * 8 + F.wave, idx = task % tps, pat = (task / tps) % 3, hb = (task / (3 * tps)) % 12, sq = task / (36 * tps);
#ifndef NO_B
                    bwin_task(U, sq * L, L, hb, pat == 0 ? 1 : (pat == 1 ? 4 : 16), idx, BO + (size_t)pat * CH * 768, BL + (size_t)pat * CH * 12, F.lds + F.wave * 10240, F.lane);
#endif
                }
#undef DEQUEUE
            }
            GRID_BAR();
#ifndef NO_FIN
            finalize_rows(F, AIN(13) + l * 128, AIN(18) + l * 128, l, U, OA, BO, BL, OC, MIX);
#endif
            GRID_BAR();
            { pg8::Gemm g{MIX, WL + W_OUT / 2, CH, DM, NMIX}; pg8::StaticOrder S; S.init(CH, DM, F.G, (int)blockIdx.x);
              pg8::EpiResid E{xout, xout, DM, 1.0f};
              pg8::gemm_phase<pg8::EpiResid, pg8::StaticOrder, true, true>(F.lds, g, S, E); }
            GRID_BAR();

            norm_rows(F, xout, XN, AIN(21) + l * DM);
            GRID_BAR();
            { pg8::Gemm g{XN, WL + W_GU2 / 2, CH, 2 * DFF, DM}; pg8::StaticOrder S; S.init(CH, 2 * DFF, F.G, (int)blockIdx.x);
              pg8::EpiSwiglu E{HID, DFF};
              pg8::gemm_phase<pg8::EpiSwiglu, pg8::StaticOrder, true, true>(F.lds, g, S, E); }
            GRID_BAR();
            { pg8::Gemm g{HID, WL + W_D2 / 2, CH, DM, DFF}; pg8::StaticOrder S; S.init(CH, DM, F.G, (int)blockIdx.x);
              pg8::EpiResid E{xout, xout, DM, 0.5f};
              pg8::gemm_phase<pg8::EpiResid, pg8::StaticOrder, true, true>(F.lds, g, S, E); }
            GRID_BAR();
        }
    }
    final_norm_rows(F, (float*)args.in[26], args.in[25]);
}
#undef AIN
#undef XN
#undef U
#undef HID
#undef MIX
#undef OA
#undef BO
#undef BL
#undef OC
#undef pcs
#undef axcs
#undef WL
#undef xout
#undef xin
#undef L
#undef nseq

extern "C" void kernel_launch(void* const* d_in, const int* in_sizes, int n_in, void* d_out, int out_size, void* d_ws, size_t ws_size, hipStream_t stream) {
    static int grid = 0;
    if (grid == 0) {
        if (n_in != 26 || out_size != NTOK * DM || ws_size < WS_END) { fprintf(stderr, "kernel_launch: built for 26 inputs, %d outputs, >= %zu bytes of workspace; got n_in %d, out %d, ws %zu; nothing launched\n", NTOK * DM, (size_t)WS_END, n_in, out_size, ws_size); grid = -1; return; }
        int dev = 0, cus = 0, per_cu = 0;
        if (hipGetDevice(&dev) != hipSuccess || hipDeviceGetAttribute(&cus, hipDeviceAttributeMultiprocessorCount, dev) != hipSuccess) { fprintf(stderr, "kernel_launch: device query failed\n"); grid = -1; return; }
        if (hipFuncSetAttribute((const void*)hybrid_fwd, hipFuncAttributeMaxDynamicSharedMemorySize, LDS_BYTES) != hipSuccess) { fprintf(stderr, "kernel_launch: hipFuncSetAttribute failed\n"); grid = -1; return; }
        if (hipOccupancyMaxActiveBlocksPerMultiprocessor(&per_cu, (const void*)hybrid_fwd, NWAVES * 64, LDS_BYTES) != hipSuccess || per_cu < 1)
            fprintf(stderr, "kernel_launch: note: occupancy query reports %d workgroups per CU\n", per_cu);
        (void)hipGetLastError();
        grid = cus;
    }
    if (grid < 0) return;
    if (hipMemsetAsync((char*)d_ws + WS_CTL, 0, CTL_ZERO_BYTES, stream) != hipSuccess) { fprintf(stderr, "kernel_launch: hipMemsetAsync failed\n"); return; }
    Args a{};
    for (int i = 0; i < 26; ++i) a.in[i] = (const float*)d_in[i];
    a.in[26] = (const float*)d_out; a.in[27] = (const float*)d_ws;
    hipLaunchKernelGGL(hybrid_fwd, dim3(grid), dim3(NWAVES * 64), LDS_BYTES, stream, a);
    const hipError_t le = hipPeekAtLastError();
    if (le != hipSuccess) fprintf(stderr, "kernel_launch: launch failed: %s\n", hipGetErrorName(le));
}
```

```cpp
#include <hip/hip_runtime.h>
#include <hip/hip_bf16.h>
#include <cstdio>
#include <cstdint>
#include <cmath>
namespace pg8 {
#define PG8_LAS __attribute__((address_space(3)))
typedef unsigned short bf16_t;
typedef short bf16x8 __attribute__((ext_vector_type(8)));
typedef float f32x4 __attribute__((ext_vector_type(4)));
typedef unsigned u32x4 __attribute__((ext_vector_type(4)));
constexpr int BM = 256, BK = 64, HALF = 128, HTB = HALF * BK * 2  , STAGE_BYTES = 8 * HTB, NXCD = 8, WGM = 8;

__host__ __device__ __forceinline__ int lds_byte(int r, int c) { const int st = (r >> 4) * 2 + (c >> 5), rr = r & 15, cc = c & 31, ob = rr * 64 + cc * 2; return st * 1024 + (ob ^ (((ob >> 9) & 1) << 5)); }
__host__ __device__ __forceinline__ void stage_rc(int b, int& R, int& C) { const int st = b / 1024, sb = b % 1024, swz = sb ^ (((sb >> 9) & 1) << 5); R = (st >> 1) * 16 + swz / 64; C = (st & 1) * 32 + (swz % 64) / 2; }
__host__ __device__ __forceinline__ int perm32(int rho) { const int n = rho >> 4, i = rho & 15; return 8 * (i >> 2) + 4 * n + (i & 3); }

struct Unit { int pm, pn; };
struct Gemm { const bf16_t* A; const bf16_t* Bt; int M, N, K; };

struct StaticOrder {
    int nM, nN, nwg, G, c;
    __host__ __device__ void init(int M, int N, int G_, int c_) { nM = M / BM; nN = N / BM; nwg = nM * nN; G = G_; c = c_; }
    __host__ __device__ bool next(int i, Unit& u) const {
        const long L = (long)i * G + c; if (L >= nwg) return false;
        int wgid = (int)L; { const int q = nwg / NXCD, r = nwg % NXCD, xcd = wgid % NXCD, off = wgid / NXCD; wgid = (xcd < r ? xcd * (q + 1) : r * (q + 1) + (xcd - r) * q) + off; }
        const int nig = WGM * nN, gid = wgid / nig, fm = gid * WGM, gsz = (nM - fm) < WGM ? (nM - fm) : WGM;
        u.pm = fm + ((wgid % nig) % gsz); u.pn = (wgid % nig) / gsz; return true;
    }
    __device__ __forceinline__ void a_ready(const Unit&) const {}
    __device__ __forceinline__ void done(const Unit&) const {}
};

struct SkipOrder {
    StaticOrder S;
    __device__ bool next(int i, Unit& u) const { const bool ok = S.next(i, u); if (ok && u.pn >= 27) u.pn += 3; return ok; }
    __device__ __forceinline__ void a_ready(const Unit&) const {}
    __device__ __forceinline__ void done(const Unit&) const {}
};

__device__ __forceinline__ unsigned cvt_pk_bf16(float lo, float hi) { unsigned r; asm volatile("v_cvt_pk_bf16_f32 %0, %1, %2" : "=v"(r) : "v"(lo), "v"(hi)); return r; }
typedef float f32x2 __attribute__((ext_vector_type(2)));
__device__ __forceinline__ float silu_f(float g) { return g * __builtin_amdgcn_rcpf(1.0f + __builtin_amdgcn_exp2f(-1.4426950408889634f * g)); }

__device__ __forceinline__ float xlane(float v, int src_lane) { return __builtin_bit_cast(float, __builtin_amdgcn_ds_bpermute(src_lane << 2, __builtin_bit_cast(int, v))); }
__device__ __forceinline__ void rss_pre_load(const unsigned long long* rss, const Unit& u, int wr, int lane, unsigned long long (&raw)[2]) {
#pragma unroll
    for (int s = 0; s < 2; ++s) raw[s] = __hip_atomic_load((const __attribute__((address_space(1))) unsigned long long*)(rss + u.pm * BM + s * HALF + wr * 64 + lane), __ATOMIC_RELAXED, __HIP_MEMORY_SCOPE_AGENT);
}
__device__ __forceinline__ void row_rstd(const unsigned long long (&raw)[2], int fr, float (&rs)[2][4]) {
    float r[2];
#pragma unroll
    for (int s = 0; s < 2; ++s) r[s] = 1.0f / sqrtf((float)raw[s] * (1.0f / 16777216.0f) * (1.0f / 2048.0f) + 1e-6f);
#pragma unroll
    for (int ai = 0; ai < 2; ++ai)
#pragma unroll
        for (int m = 0; m < 4; ++m) rs[ai][m] = xlane(r[ai], m * 16 + fr);
}
struct EpiPrepN {
    static constexpr bool PERM = true, AFTER_DRAIN = false, PRE = true;
    bf16_t* O; int ldc; const unsigned long long* rss; int Lmask; const float* pcs; const float* axcs; const float* gq; const float* gk; PG8_LAS float* scr; PG8_LAS unsigned char* tab;
    __device__ __forceinline__ void pre_load(const Unit& u, int wr, int lane, unsigned long long (&raw)[2]) const {
        __builtin_amdgcn_s_barrier();
        rss_pre_load(rss, u, wr, lane, raw);
        int tid_o = threadIdx.x; asm volatile("" : "+v"(tid_o));
        const int pn = u.pn, wid = __builtin_amdgcn_readfirstlane(tid_o >> 6), T0 = (u.pm * BM) & Lmask; lane = tid_o & 63;
        if (pn < 6 || (pn >= 9 && pn < 15)) {
            const char* src = (const char*)(pcs + (size_t)T0 * 16) + lane * 16;
#pragma unroll
            for (int h = 0; h < 2; ++h) __builtin_amdgcn_global_load_lds((const unsigned*)(src + (wid + 8 * h) * 1024), (PG8_LAS unsigned*)(tab + (wid + 8 * h) * 1024), 16, 0, 0);
        } else if (pn >= 30 && pn < 34) {
            __builtin_amdgcn_global_load_lds((const unsigned*)((const char*)axcs + wid * 1024 + lane * 16), (PG8_LAS unsigned*)(tab + wid * 1024), 16, 0, 0);
            if (wid == 0) __builtin_amdgcn_global_load_lds((const unsigned*)((const char*)axcs + (T0 >> 6) * 128 + (lane & 31) * 16), (PG8_LAS unsigned*)(tab + 8192), 16, 0, 0);
        }
    }
    static __device__ __forceinline__ u32x4 pack8(const f32x4& v0, const f32x4& v1) { u32x4 w; w.x = cvt_pk_bf16(v0[0], v0[1]); w.y = cvt_pk_bf16(v0[2], v0[3]); w.z = cvt_pk_bf16(v1[0], v1[1]); w.w = cvt_pk_bf16(v1[2], v1[3]); return w; }
    typedef unsigned u32x2_ __attribute__((ext_vector_type(2)));
    static __device__ __forceinline__ void rot_store(const f32x4& x1, const f32x4& x2, const f32x4& q0, const f32x4& q1, bf16_t* p1, bf16_t* p2) {
        const f32x4 c = {q0[0], q0[2], q1[0], q1[2]}, sn = {q0[1], q0[3], q1[1], q1[3]};
        const f32x4 o1 = x1 * c - x2 * sn, o2 = x2 * c + x1 * sn;
        u32x2_ w1, w2; w1.x = cvt_pk_bf16(o1[0], o1[1]); w1.y = cvt_pk_bf16(o1[2], o1[3]); w2.x = cvt_pk_bf16(o2[0], o2[1]); w2.y = cvt_pk_bf16(o2[2], o2[3]);
        *(u32x2_*)p1 = w1; *(u32x2_*)p2 = w2;
    }
    __device__ __forceinline__ void operator()(const f32x4 (&acc)[2][2][4][2], const Unit& u, int wr, int wc, int fr, int fq, const unsigned long long (&raw)[2]) const {
        asm volatile("" : "+v"(fr), "+v"(fq));
        const int row0 = u.pm * BM + wr * 64 + fr; const int col0 = u.pn * BM + wc * 32 + 8 * fq; const int lane = fq * 16 + fr;
        float rs[2][4]; row_rstd(raw, fr, rs);
        const int pn = u.pn;
        const int mode = (pn < 6 || (pn >= 9 && pn < 15)) ? (((wc & 1) == 0) ? 1 : 0) : ((pn >= 30 && pn < 34) ? 2 : 0);
        if (mode == 0) {
#pragma unroll
            for (int ai = 0; ai < 2; ++ai)
#pragma unroll
                for (int m = 0; m < 4; ++m) { bf16_t* rowp = O + (size_t)(row0 + ai * HALF + m * 16) * ldc + col0; const float r = rs[ai][m];
#pragma unroll
                    for (int bj = 0; bj < 2; ++bj) *(u32x4*)(rowp + bj * HALF) = pack8(acc[ai][bj][m][0] * r, acc[ai][bj][m][1] * r); }
        } else if (mode == 1) {
            const bool rot = fq < 2;
#pragma unroll
            for (int ai = 0; ai < 2; ++ai)
#pragma unroll
                for (int m = 0; m < 4; ++m) { const int row = row0 + ai * HALF + m * 16; bf16_t* rowp = O + (size_t)row * ldc + col0; const float r = rs[ai][m];
                    const PG8_LAS f32x4* cs = (const PG8_LAS f32x4*)(tab + (ai * HALF + wr * 64 + m * 16 + fr) * 64 + 32 * (fq & 1)); const f32x4 q0 = cs[0], q1 = cs[1];
#pragma unroll
                    for (int bj = 0; bj < 2; ++bj) { const f32x4 v0 = acc[ai][bj][m][0] * r, v1 = acc[ai][bj][m][1] * r;
                        if (rot) rot_store(v0, v1, q0, q1, rowp + bj * HALF - 4 * fq, rowp + bj * HALF - 4 * fq + 8);
                        else *(u32x4*)(rowp + bj * HALF) = pack8(v0, v1); }
                    if (m & 1) asm volatile("" ::: "memory"); }
        } else {
#pragma unroll
            for (int ai = 0; ai < 2; ++ai)
#pragma unroll
                for (int m = 0; m < 4; ++m) { const float r = rs[ai][m];
#pragma unroll
                    for (int bj = 0; bj < 2; ++bj) { const f32x4 v0 = acc[ai][bj][m][0] * r, v1 = acc[ai][bj][m][1] * r;
                        float ss = (v0[0] * v0[0] + v0[1] * v0[1]) + (v0[2] * v0[2] + v0[3] * v0[3]) + (v1[0] * v1[0] + v1[1] * v1[1]) + (v1[2] * v1[2] + v1[3] * v1[3]);
                        ss += xlane(ss, lane ^ 16); ss += xlane(ss, lane ^ 32);
                        if (fq == 0) scr[(ai * HALF + wr * 64 + m * 16 + fr) * 8 + bj * 4 + wc] = ss; } }
            asm volatile("s_waitcnt lgkmcnt(0)\n\ts_barrier" ::: "memory");
            const bool isk = pn == 33; const float* gain = (isk ? gk : gq) + 32 * (wc & 1) + 4 * fq; const float qs = isk ? 1.0f : 0.18033688011112042f;
            const f32x4 g0 = *(const f32x4*)gain, g1 = *(const f32x4*)(gain + 16);
#pragma unroll
            for (int ai = 0; ai < 2; ++ai)
#pragma unroll
                for (int m = 0; m < 4; ++m) { const int row = row0 + ai * HALF + m * 16; bf16_t* rowp = O + (size_t)row * ldc + col0 - 4 * fq; const float r = rs[ai][m];
                    const int tl = ai * HALF + wr * 64 + m * 16 + fr;
                    const PG8_LAS f32x4* cs = (const PG8_LAS f32x4*)(tab + ((wc & 1) ? (tl & 63) * 128 : 8192 + (tl >> 6) * 128) + 32 * fq); const f32x4 q0 = cs[0], q1 = cs[1];
#pragma unroll
                    for (int bj = 0; bj < 2; ++bj) { const f32x2 so = *(const PG8_LAS f32x2*)(scr + (ai * HALF + wr * 64 + m * 16 + fr) * 8 + bj * 4 + (wc & 2));
                        const float rh = r * qs / sqrtf((so[0] + so[1]) * (1.0f / 64.0f) + 1e-6f);
                        rot_store(acc[ai][bj][m][0] * rh * g0, acc[ai][bj][m][1] * rh * g1, q0, q1, rowp + bj * HALF, rowp + bj * HALF + 16); }
                    if (m & 1) asm volatile("" ::: "memory"); }
        }
    }
};
struct EpiSwigluN {
    static constexpr bool PERM = true, AFTER_DRAIN = false, PRE = true;
    bf16_t* O; int ldc; const unsigned long long* rss;
    __device__ __forceinline__ void pre_load(const Unit& u, int wr, int lane, unsigned long long (&raw)[2]) const { rss_pre_load(rss, u, wr, lane, raw); }
    static __device__ __forceinline__ unsigned swiglu2(f32x2 ag, f32x2 au, float nr, float r2) {
        const f32x2 t = ag * nr; f32x2 e = {__builtin_amdgcn_exp2f(t[0]), __builtin_amdgcn_exp2f(t[1])};
        e = e + 1.0f; const f32x2 rc = {__builtin_amdgcn_rcpf(e[0]), __builtin_amdgcn_rcpf(e[1])};
        const f32x2 h = (ag * au) * (rc * r2); return cvt_pk_bf16(h[0], h[1]);
    }
    __device__ __forceinline__ void operator()(const f32x4 (&acc)[2][2][4][2], const Unit& u, int wr, int wc, int fr, int fq, const unsigned long long (&raw)[2]) const {
        const int row0 = u.pm * BM + wr * 64 + fr; const int col0 = u.pn * HALF + wc * 32 + 8 * fq;
        float rs[2][4]; row_rstd(raw, fr, rs);
#pragma unroll
        for (int ai = 0; ai < 2; ++ai)
#pragma unroll
            for (int m = 0; m < 4; ++m) { bf16_t* rowp = O + (size_t)(row0 + ai * HALF + m * 16) * ldc + col0; const float r = rs[ai][m], nr = -1.4426950408889634f * r, r2 = r * r;
                const f32x4 g0 = acc[ai][0][m][0], g1 = acc[ai][0][m][1], u0 = acc[ai][1][m][0], u1 = acc[ai][1][m][1];
                u32x4 w; w.x = swiglu2((f32x2){g0[0], g0[1]}, (f32x2){u0[0], u0[1]}, nr, r2); w.y = swiglu2((f32x2){g0[2], g0[3]}, (f32x2){u0[2], u0[3]}, nr, r2);
                w.z = swiglu2((f32x2){g1[0], g1[1]}, (f32x2){u1[0], u1[1]}, nr, r2); w.w = swiglu2((f32x2){g1[2], g1[3]}, (f32x2){u1[2], u1[3]}, nr, r2);
                *(u32x4*)rowp = w; }
    }
};
__device__ __forceinline__ float bf_lo(unsigned w) { return __builtin_bit_cast(float, w << 16); }
__device__ __forceinline__ float bf_hi(unsigned w) { return __builtin_bit_cast(float, w & 0xffff0000u); }
template <bool HALF_STEP> struct EpiResidN {
    static constexpr bool PERM = true, AFTER_DRAIN = false, PRE = false; static constexpr float alpha = HALF_STEP ? 0.5f : 1.0f;
    bf16_t* xb; int ldc; unsigned long long* rss;
    __device__ __forceinline__ void operator()(const f32x4 (&acc)[2][2][4][2], const Unit& u, int wr, int wc, int fr, int fq) const {
        asm volatile("" : "+v"(fr), "+v"(fq));
        const int row0 = u.pm * BM + wr * 64 + fr; const int col0 = u.pn * BM + wc * 32 + 8 * fq; const int lane = fq * 16 + fr;
        u32x4 b[2][4][2];
#pragma unroll
        for (int ai = 0; ai < 2; ++ai)
#pragma unroll
            for (int m = 0; m < 4; ++m)
#pragma unroll
                for (int bj = 0; bj < 2; ++bj) b[ai][m][bj] = *(const u32x4*)(xb + (size_t)(row0 + ai * HALF + m * 16) * ldc + col0 + bj * HALF);
        asm volatile("" ::: "memory");
#pragma unroll
        for (int ai = 0; ai < 2; ++ai) {
#pragma unroll
            for (int m = 0; m < 4; ++m) { const int row = row0 + ai * HALF + m * 16; const size_t off = (size_t)row * ldc + col0; float ss = 0.f;
#pragma unroll
                for (int bj = 0; bj < 2; ++bj) { const u32x4 bb = b[ai][m][bj];
                    const f32x4 b0 = {bf_lo(bb.x), bf_hi(bb.x), bf_lo(bb.y), bf_hi(bb.y)}, b1 = {bf_lo(bb.z), bf_hi(bb.z), bf_lo(bb.w), bf_hi(bb.w)};
                    const f32x4 o0 = b0 + acc[ai][bj][m][0] * alpha, o1 = b1 + acc[ai][bj][m][1] * alpha;
                    u32x4 w; w.x = cvt_pk_bf16(o0[0], o0[1]); w.y = cvt_pk_bf16(o0[2], o0[3]); w.z = cvt_pk_bf16(o1[0], o1[1]); w.w = cvt_pk_bf16(o1[2], o1[3]);
                    *(u32x4*)(xb + off + bj * HALF) = w;
                    ss += (o0[0] * o0[0] + o0[1] * o0[1]) + (o0[2] * o0[2] + o0[3] * o0[3]) + (o1[0] * o1[0] + o1[1] * o1[1]) + (o1[2] * o1[2] + o1[3] * o1[3]); }
                ss += xlane(ss, lane ^ 16); ss += xlane(ss, lane ^ 32);
                if (fq == 0) __hip_atomic_fetch_add((__attribute__((address_space(1))) unsigned long long*)(rss + row), (unsigned long long)(ss * 16777216.0f), __ATOMIC_RELAXED, __HIP_MEMORY_SCOPE_AGENT);
            }
        }
    }
};

template <class Epi, class Sched, bool ALIGN_EPI = false, bool SP2 = false>
__device__ __forceinline__ void gemm_phase(PG8_LAS unsigned char* lds, const Gemm g, const Sched& S, const Epi& E) {
    int tid_l = threadIdx.x; asm volatile("" : "+v"(tid_l));
    const int tid = tid_l, wid = __builtin_amdgcn_readfirstlane(tid >> 6), lane = tid & 63, wr = wid >> 2, wc = wid & 3, fr = lane & 15, fq = lane >> 4;
    const int K = g.K, nt = K / BK;
    unsigned voffA[2], voffB[2];
#pragma unroll
    for (int i = 0; i < 2; ++i) { int R, C; stage_rc(tid * 16 + i * 8192, R, C); const int Rb = Epi::PERM ? ((R & ~31) + perm32(R & 31)) : R;
        voffA[i] = (unsigned)(R * K + C) * 2u; voffB[i] = (unsigned)(Rb * K + C) * 2u; }
    const size_t kstep = (size_t)(BK * 2);
    const size_t hstep = (size_t)HALF * K * 2;
    const size_t tstep = 2 * hstep;
    const unsigned ldsw = (unsigned)wid * 1024u;
    const int aoff = lds_byte(wr * 64 + fr, fq * 8), boff = lds_byte(wc * 32 + fr, fq * 8);
#define PG8_SA(b, h) (((b) * 2 + (h)) * HTB)
#define PG8_SB(b, h) ((4 + (b) * 2 + (h)) * HTB)
#define PG8_STAGE(bufoff, gbase, voff) do { _Pragma("unroll") for (int _i = 0; _i < 2; ++_i) \
        __builtin_amdgcn_global_load_lds((const unsigned*)((const char*)(gbase) + (voff)[_i]), (PG8_LAS unsigned*)(lds + (bufoff) + ldsw + _i * 8192), 16, 0, 0); } while (0)
#define PG8_LDA(dst, b, h) do { _Pragma("unroll") for (int m = 0; m < 4; ++m) _Pragma("unroll") for (int k = 0; k < 2; ++k) dst[m][k] = *(const PG8_LAS bf16x8*)(lds + PG8_SA(b, h) + aoff + m * 2048 + k * 1024); } while (0)
#define PG8_LDB(dst, b, h) do { _Pragma("unroll") for (int n = 0; n < 2; ++n) _Pragma("unroll") for (int k = 0; k < 2; ++k) dst[n][k] = *(const PG8_LAS bf16x8*)(lds + PG8_SB(b, h) + boff + n * 2048 + k * 1024); } while (0)
#define PG8_MMA(ai, bj, At, Bt) do { __builtin_amdgcn_s_setprio(1); _Pragma("unroll") for (int m = 0; m < 4; ++m) _Pragma("unroll") for (int n = 0; n < 2; ++n) _Pragma("unroll") for (int k = 0; k < 2; ++k) \
        acc[ai][bj][m][n] = __builtin_amdgcn_mfma_f32_16x16x32_bf16(Bt[n][k], At[m][k], acc[ai][bj][m][n], 0, 0, 0); __builtin_amdgcn_s_setprio(0); } while (0)
#define PG8_WAIT_V(n) asm volatile("s_waitcnt vmcnt(" #n ")" ::: "memory")
#define PG8_WAIT_L(n) asm volatile("s_waitcnt lgkmcnt(" #n ")" ::: "memory")
#define PG8_BAR __builtin_amdgcn_s_barrier()
#define PG8_SCHED __builtin_amdgcn_sched_barrier(0)
    Unit cur, nxt; int ui = 0;
    if (!S.next(0, cur)) return;
    f32x4 acc[2][2][4][2];
#pragma unroll
    for (int a = 0; a < 2; ++a)
#pragma unroll
        for (int b = 0; b < 2; ++b)
#pragma unroll
            for (int m = 0; m < 4; ++m)
#pragma unroll
                for (int n = 0; n < 2; ++n) acc[a][b][m][n] = (f32x4){0.f, 0.f, 0.f, 0.f};
    bf16x8 At[4][2], B0[2][2], B1[2][2];
    const char* cA = (const char*)g.A + (size_t)cur.pm * tstep; const char* cB = (const char*)g.Bt + (size_t)cur.pn * tstep;
    S.a_ready(cur);
    unsigned long long praw[2] = {0ull, 0ull};
    if constexpr (Epi::PRE) E.pre_load(cur, wr, lane, praw);
    if constexpr (SP2) {
        PG8_STAGE(PG8_SB(0, 0), cB, voffB); PG8_STAGE(PG8_SB(0, 1), cB + hstep, voffB); PG8_STAGE(PG8_SA(0, 0), cA, voffA); PG8_STAGE(PG8_SA(0, 1), cA + hstep, voffA);
        if (wr == 1) PG8_BAR;
        PG8_WAIT_V(2); PG8_BAR;
        PG8_STAGE(PG8_SB(1, 0), cB + kstep, voffB); PG8_STAGE(PG8_SA(1, 0), cA + kstep, voffA); PG8_STAGE(PG8_SB(1, 1), cB + hstep + kstep, voffB);
        PG8_WAIT_V(6); PG8_BAR;
    } else {
        PG8_STAGE(PG8_SB(0, 0), cB, voffB); PG8_STAGE(PG8_SA(0, 0), cA, voffA); PG8_STAGE(PG8_SB(0, 1), cB + hstep, voffB); PG8_STAGE(PG8_SA(0, 1), cA + hstep, voffA);
        if (wr == 1) PG8_BAR;
        PG8_WAIT_V(4); PG8_BAR;
        PG8_STAGE(PG8_SB(1, 0), cB + kstep, voffB); PG8_STAGE(PG8_SA(1, 0), cA + kstep, voffA); PG8_STAGE(PG8_SB(1, 1), cB + hstep + kstep, voffB);
        PG8_WAIT_V(6); PG8_BAR;
    }
    for (;;) {
        const bool has_next = S.next(ui + 1, nxt);
        const char* nA = has_next ? (const char*)g.A + (size_t)nxt.pm * tstep : cA; const char* nB = has_next ? (const char*)g.Bt + (size_t)nxt.pn * tstep : cB;
        for (int t = 0; t < nt; t += 2) {
            const bool last = (t == nt - 2);
            const char* a1 = cA + (size_t)(t + 1) * kstep;
            const char* a2 = last ? nA : cA + (size_t)(t + 2) * kstep; const char* b2 = last ? nB : cB + (size_t)(t + 2) * kstep;
            const char* a3 = a2 + kstep; const char* b3 = b2 + kstep;
            if (last && has_next) S.a_ready(nxt);
            if constexpr (SP2) {
            PG8_LDB(B0, 0, 0); PG8_LDB(B1, 0, 1); PG8_SCHED; PG8_LDA(At, 0, 0); PG8_STAGE(PG8_SA(1, 1), a1 + hstep, voffA);
            PG8_WAIT_V(8); PG8_WAIT_L(0); PG8_BAR; PG8_MMA(0, 0, At, B0); PG8_MMA(0, 1, At, B1); PG8_BAR; PG8_SCHED;
            PG8_LDA(At, 0, 1); PG8_STAGE(PG8_SB(0, 0), b2, voffB); PG8_STAGE(PG8_SB(0, 1), b2 + hstep, voffB); PG8_STAGE(PG8_SA(0, 0), a2, voffA);
            PG8_WAIT_V(8); PG8_WAIT_L(0); PG8_BAR; PG8_MMA(1, 0, At, B0); PG8_MMA(1, 1, At, B1); PG8_BAR; PG8_SCHED;
            PG8_LDB(B0, 1, 0); PG8_LDB(B1, 1, 1); PG8_SCHED; PG8_LDA(At, 1, 0); PG8_STAGE(PG8_SA(0, 1), a2 + hstep, voffA);
            PG8_WAIT_V(8); PG8_WAIT_L(0); PG8_BAR; PG8_MMA(0, 0, At, B0); PG8_MMA(0, 1, At, B1); PG8_BAR; PG8_SCHED;
            PG8_LDA(At, 1, 1); PG8_STAGE(PG8_SB(1, 0), b3, voffB); PG8_STAGE(PG8_SB(1, 1), b3 + hstep, voffB); PG8_STAGE(PG8_SA(1, 0), a3, voffA);
            PG8_WAIT_V(8); PG8_WAIT_L(0); PG8_BAR; PG8_MMA(1, 0, At, B0); PG8_MMA(1, 1, At, B1); PG8_BAR; PG8_SCHED;
            } else {
            PG8_LDB(B0, 0, 0); PG8_SCHED; PG8_LDA(At, 0, 0); PG8_STAGE(PG8_SA(1, 1), a1 + hstep, voffA);
            PG8_WAIT_L(8); PG8_BAR; PG8_WAIT_L(0); PG8_MMA(0, 0, At, B0); PG8_BAR; PG8_SCHED;
            PG8_LDB(B1, 0, 1); PG8_STAGE(PG8_SB(0, 0), b2, voffB);
            PG8_BAR; PG8_WAIT_L(0); PG8_MMA(0, 1, At, B1); PG8_BAR;
            PG8_LDA(At, 0, 1); PG8_STAGE(PG8_SA(0, 0), a2, voffA);
            PG8_BAR; PG8_WAIT_L(0); PG8_MMA(1, 0, At, B0); PG8_BAR; PG8_SCHED;
            PG8_STAGE(PG8_SB(0, 1), b2 + hstep, voffB);
            PG8_WAIT_V(6); PG8_BAR; PG8_MMA(1, 1, At, B1); PG8_BAR;
            PG8_LDB(B0, 1, 0); PG8_SCHED; PG8_LDA(At, 1, 0); PG8_STAGE(PG8_SA(0, 1), a2 + hstep, voffA);
            PG8_WAIT_L(8); PG8_BAR; PG8_WAIT_L(0); PG8_MMA(0, 0, At, B0); PG8_BAR; PG8_SCHED;
            PG8_LDB(B1, 1, 1); PG8_STAGE(PG8_SB(1, 0), b3, voffB);
            PG8_BAR; PG8_WAIT_L(0); PG8_MMA(0, 1, At, B1); PG8_BAR;
            PG8_LDA(At, 1, 1); PG8_STAGE(PG8_SA(1, 0), a3, voffA);
            PG8_BAR; PG8_WAIT_L(0); PG8_MMA(1, 0, At, B0); PG8_BAR; PG8_SCHED;
            PG8_STAGE(PG8_SB(1, 1), b3 + hstep, voffB);
            PG8_WAIT_V(6); PG8_BAR; PG8_MMA(1, 1, At, B1); PG8_BAR;
            }
        }
        if constexpr (ALIGN_EPI) { if (wr == 0) PG8_BAR; }
        if constexpr (!Epi::AFTER_DRAIN) { if constexpr (Epi::PRE) E(acc, cur, wr, wc, fr, fq, praw); else E(acc, cur, wr, wc, fr, fq); S.done(cur); }
        if (!has_next) break;
#pragma unroll
        for (int a = 0; a < 2; ++a)
#pragma unroll
            for (int b = 0; b < 2; ++b)
#pragma unroll
                for (int m = 0; m < 4; ++m)
#pragma unroll
                    for (int n = 0; n < 2; ++n) acc[a][b][m][n] = (f32x4){0.f, 0.f, 0.f, 0.f};
        cur = nxt; cA = nA; cB = nB; ++ui;
        if constexpr (Epi::PRE) E.pre_load(cur, wr, lane, praw);
        if constexpr (ALIGN_EPI) { if (wr == 1) PG8_BAR; }
    }
    PG8_WAIT_V(0);
    if constexpr (!ALIGN_EPI) { if (wr == 0) PG8_BAR; }
    PG8_BAR;
    if constexpr (Epi::AFTER_DRAIN) { E.fused(acc, cur, wr, wc, fr, fq, lds, wid, lane); S.done(cur); }
#undef PG8_SA
#undef PG8_SB
#undef PG8_STAGE
#undef PG8_LDA
#undef PG8_LDB
#undef PG8_MMA
#undef PG8_WAIT_V
#undef PG8_WAIT_L
#undef PG8_BAR
#undef PG8_SCHED
}
}
#include <hip/hip_bf16.h>
#include <cmath>
namespace attn_body {
using bf16=__hip_bfloat16;
using bf16x8=__attribute__((ext_vector_type(8)))short;
using s16x4=__attribute__((ext_vector_type(4)))short;
using f32x16=__attribute__((ext_vector_type(16)))float;
using u32x4=__attribute__((ext_vector_type(4)))unsigned;
constexpr int D=64,PU=8960;
constexpr int NW=8,QBLK=32,QB=QBLK*NW,KVBLK=64;

__device__ __forceinline__ int crow(int r,int hi){return (r&3)+8*(r>>2)+4*hi;}
#define SBAR() __builtin_amdgcn_sched_barrier(0)


constexpr int NSLOT=3, SLOTB=8192;
constexpr int LDS_K=0, LDS_V=NSLOT*SLOTB, LDS_WS=2*NSLOT*SLOTB, LDS_OST=LDS_WS+NW*64*4, LDS_BYTES=LDS_OST+NW*4096;
constexpr float C2=0.125f*1.4426950408889634f;
__device__ __forceinline__ void glds16(const void*gsrc,unsigned lds_dst){unsigned keep;
  asm volatile("s_mov_b32 %0, m0\n\ts_mov_b32 m0, %2\n\ts_nop 0\n\tglobal_load_lds_dwordx4 %1, off\n\ts_mov_b32 m0, %0":"=&s"(keep):"v"(gsrc),"s"(lds_dst):"memory");}
__device__ __forceinline__ float max3f(float a,float b,float c){float r;asm("v_max3_f32 %0, %1, %2, %3":"=v"(r):"v"(a),"v"(b),"v"(c));return r;}
__device__ __forceinline__ float max2f(float a,float b){float r;asm("v_max_f32_e32 %0, %1, %2":"=v"(r):"v"(a),"v"(b));return r;}
__device__ __forceinline__ float fadd_s(float a,float b){float r;asm("v_add_f32_e32 %0, %1, %2":"=v"(r):"v"(a),"v"(b));return r;}
__device__ __forceinline__ float fsub_s(float a,float b){float r;asm("v_sub_f32_e32 %0, %1, %2":"=v"(r):"v"(a),"v"(b));return r;}
typedef float f32x2_t __attribute__((ext_vector_type(2))); typedef __bf16 bf16x2_t __attribute__((ext_vector_type(2)));
__device__ __forceinline__ unsigned cvtpk_s(float lo,float hi){f32x2_t v={lo,hi};bf16x2_t b=__builtin_convertvector(v,bf16x2_t);return __builtin_bit_cast(unsigned,b);}
#define WAIT_BAR(N) asm volatile("s_waitcnt vmcnt(" #N ") lgkmcnt(0)\n\ts_barrier":::"memory")

__device__ __forceinline__ void qkt(f32x16&p0,f32x16&p1,const char*Kslot,const bf16x8*qr,const f32x16&negm,int r32,int hi){
  const char*kb=Kslot+hi*1024+r32*16;
  #pragma unroll
  for(int d0=0;d0<4;++d0){
    const bf16x8 b0=*reinterpret_cast<const bf16x8*>(kb+d0*2048);
    const bf16x8 b1=*reinterpret_cast<const bf16x8*>(kb+d0*2048+512);
    if(d0==0){p0=__builtin_amdgcn_mfma_f32_32x32x16_bf16(b0,qr[0],negm,0,0,0);p1=__builtin_amdgcn_mfma_f32_32x32x16_bf16(b1,qr[0],negm,0,0,0);}
    else{p0=__builtin_amdgcn_mfma_f32_32x32x16_bf16(b0,qr[d0],p0,0,0,0);p1=__builtin_amdgcn_mfma_f32_32x32x16_bf16(b1,qr[d0],p1,0,0,0);}}
}
typedef __attribute__((address_space(3))) const char* lds_cptr;
typedef short v4i16_t __attribute__((ext_vector_type(4)));
__device__ __forceinline__ void kload8(bf16x8*kf,lds_cptr kp){
  kf[0]=*(const __attribute__((address_space(3))) bf16x8*)(kp);      kf[1]=*(const __attribute__((address_space(3))) bf16x8*)(kp+512);
  kf[2]=*(const __attribute__((address_space(3))) bf16x8*)(kp+2048); kf[3]=*(const __attribute__((address_space(3))) bf16x8*)(kp+2560);
  kf[4]=*(const __attribute__((address_space(3))) bf16x8*)(kp+4096); kf[5]=*(const __attribute__((address_space(3))) bf16x8*)(kp+4608);
  kf[6]=*(const __attribute__((address_space(3))) bf16x8*)(kp+6144); kf[7]=*(const __attribute__((address_space(3))) bf16x8*)(kp+6656);
}
__device__ __forceinline__ void kload2(bf16x8*kf,lds_cptr kp,int j){ kf[2*j]=*(const __attribute__((address_space(3))) bf16x8*)(kp+j*2048); kf[2*j+1]=*(const __attribute__((address_space(3))) bf16x8*)(kp+j*2048+512); }
__device__ __forceinline__ s16x4 vtr(lds_cptr p){ return __builtin_bit_cast(s16x4,__builtin_amdgcn_ds_read_tr16_b64_v4i16((__attribute__((address_space(3))) v4i16_t*)p)); }
__device__ __forceinline__ float rowmax(const f32x16&p0,const f32x16&p1){
  float a=max3f(p0[0],p0[1],p1[0]),b=max3f(p0[2],p0[3],p1[1]);a=max3f(a,p1[2],p1[3]);
  #pragma unroll
  for(int r=4;r<16;r+=4){a=max3f(a,p0[r],p0[r+1]);b=max3f(b,p0[r+2],p0[r+3]);a=max3f(a,p1[r],p1[r+1]);b=max3f(b,p1[r+2],p1[r+3]);}
  const float m=max2f(a,b);
  auto rr=__builtin_amdgcn_permlane32_swap(__float_as_uint(m),__float_as_uint(m),false,false);
  return max2f(__uint_as_float(rr[0]),__uint_as_float(rr[1]));
}
__device__ __forceinline__ void pv(f32x16*o,int vb,bf16x8 pa0,bf16x8 pa1,bf16x8 pa2,bf16x8 pa3){
  #pragma unroll
  for(int d0=0;d0<2;++d0){s16x4 lo[4],hi[4];
    #pragma unroll
    for(int ks=0;ks<4;++ks){
      asm volatile("ds_read_b64_tr_b16 %0,%1 offset:%c2":"=&v"(lo[ks]):"v"(vb),"i"(d0*4096+ks*1024):"memory");
      asm volatile("ds_read_b64_tr_b16 %0,%1 offset:%c2":"=&v"(hi[ks]):"v"(vb),"i"(d0*4096+ks*1024+512):"memory");}
    asm volatile("s_waitcnt lgkmcnt(0)":::"memory");SBAR();
    #define PK(k) (bf16x8){lo[k][0],lo[k][1],lo[k][2],lo[k][3],hi[k][0],hi[k][1],hi[k][2],hi[k][3]}
    o[d0]=__builtin_amdgcn_mfma_f32_32x32x16_bf16(pa0,PK(0),o[d0],0,0,0);
    o[d0]=__builtin_amdgcn_mfma_f32_32x32x16_bf16(pa1,PK(1),o[d0],0,0,0);
    o[d0]=__builtin_amdgcn_mfma_f32_32x32x16_bf16(pa2,PK(2),o[d0],0,0,0);
    o[d0]=__builtin_amdgcn_mfma_f32_32x32x16_bf16(pa3,PK(3),o[d0],0,0,0);
    #undef PK
  }
}

#ifndef ATTN_STORE16
#define ATTN_STORE16(p,v) (*(u32x4*)(p)=(v))
#endif
template<int THRL> __device__ __forceinline__ void attn_unit(const bf16*Qu,const bf16*__restrict__ Kh,const bf16*__restrict__ Vh,bf16*Ou,const long PO,const int NT,char*shm){
  int tid_l=threadIdx.x; asm volatile("":"+v"(tid_l)); const int tid=tid_l,lane=tid&63,r32=lane&31,hi=lane>>5; const int wid=__builtin_amdgcn_readfirstlane(tid>>6);

  const bf16*Qw=Qu+(long)(wid*QBLK)*PU;

  const unsigned lds0=(unsigned)(uintptr_t)shm;
  float*wsf=(float*)(shm+LDS_WS)+wid*64;
  const bf16*ksrc=Kh+(long)lane*PU+wid*8;
  const bf16*vsrc=Vh+(long)(16*(wid&3)+(lane>>2))*PU+(wid>>2)*32+(lane&3)*8;
  const unsigned kdst=lds0+LDS_K+wid*1024, vdst=lds0+LDS_V+wid*1024;
  #define DMA_K(t,slot) glds16(ksrc+(long)(t)*KVBLK*PU,(unsigned)__builtin_amdgcn_readfirstlane(kdst+(slot)))
  #define DMA_V(t,slot) glds16(vsrc+(long)(t)*KVBLK*PU,(unsigned)__builtin_amdgcn_readfirstlane(vdst+(slot)))
  const int vb0=(int)(lds0+LDS_V)+((lane>>4)&1)*32+(lane&3)*8+(4*hi+((lane&15)>>2))*64;
  const char*Kbase=shm+LDS_K; bf16x8 kf[8];
  const lds_cptr shm3=(lds_cptr)shm; const lds_cptr kp0=shm3+LDS_K+hi*1024+r32*16; const lds_cptr vp0=shm3+LDS_V+((lane>>4)&1)*32+(lane&3)*8+(4*hi+((lane&15)>>2))*64;

  DMA_K(0,0);DMA_V(0,0);DMA_K(1,SLOTB);
  bf16x8 qr[4];
  #pragma unroll
  for(int d0=0;d0<4;++d0)qr[d0]=*reinterpret_cast<const bf16x8*>(&Qw[(long)r32*PU+d0*16+hi*8]);
  float mhat=0.f,l_reg=0.f;f32x16 o[2];o[0]=f32x16{};o[1]=f32x16{};f32x16 negm=f32x16{};asm volatile("":"+v"(negm));

  #define CMASK(P0,P1,t) do{}while(0)
  bool resc=false;
  #define START(P0,P1) do{ const float rm=rowmax(P0,P1); resc=false; \
    { const float dl=rm; mhat=fadd_s(mhat,dl); \
      _Pragma("unroll") for(int r=0;r<16;++r){P0[r]=fsub_s(P0[r],dl);P1[r]=fsub_s(P1[r],dl);} \
      _Pragma("unroll") for(int r=0;r<16;++r)negm[r]=-mhat; asm volatile("":"+v"(negm)); } \
    _Pragma("unroll") for(int r=0;r<16;++r)P0[r]=__builtin_amdgcn_exp2f(P0[r]); }while(0)
  #define RESC() do{ if(resc){ asm volatile("s_waitcnt lgkmcnt(0)":::"memory"); \
      _Pragma("unroll") for(int d_=0;d_<2;++d_) _Pragma("unroll") for(int r=0;r<16;++r)o[d_][r]*=wsf[crow(r,hi)]; } }while(0)
  f32x16 pA0,pA1,pB0,pB1;
  int sl_prev=0,sl_cur=0,sl_next=SLOTB;
  #define ROT() do{sl_prev=sl_cur;sl_cur=sl_next;sl_next=(sl_next==(NSLOT-1)*SLOTB)?0:sl_next+SLOTB;}while(0)
  DMA_K(2,2*SLOTB);
  WAIT_BAR(3);
  qkt(pA0,pA1,Kbase,qr,negm,r32,hi);asm volatile("s_nop 15\n\ts_nop 7":"+v"(pA0),"+v"(pA1));CMASK(pA0,pA1,0);
  START(pA0,pA1);
  _Pragma("unroll") for(int r=0;r<16;++r)pA1[r]=__builtin_amdgcn_exp2f(pA1[r]);
  WAIT_BAR(0);
  DMA_K(3,0);DMA_V(1,SLOTB);
  ROT();
  kload8(kf,kp0+sl_cur);
  WAIT_BAR(2);
  s16x4 vlo[8],vhi[8]; u32x4 pw0,pw1,pw2,pw3;
  #define PKW(P,B) cvtpk_s(P[B],P[B+1])
  #define PAF(k) __builtin_bit_cast(bf16x8,pw##k)
  #define VFR(i) (bf16x8){vlo[i][0],vlo[i][1],vlo[i][2],vlo[i][3],vhi[i][0],vhi[i][1],vhi[i][2],vhi[i][3]}
  #define PIN(x) asm volatile("":"+v"(x))
  #define MX3(a,b,c) __builtin_fmaxf(__builtin_fmaxf((a),(b)),(c))
  #define GAPA(MF,A0,A1,A2,A3,W0,W1,PW) do{ MF; sacc+=A0; sacc+=A1; sacc+=A2; sacc+=A3; PIN(sacc); W0; W1; PIN(PW); SBAR(); }while(0)
  #define EX(v) __builtin_amdgcn_exp2f(v)
  #define GAPB(MF,X,B) do{ MF; X[B]=EX(X[B]); X[B+1]=EX(X[B+1]); X[B+2]=EX(X[B+2]); X[B+3]=EX(X[B+3]); PIN(X); SBAR(); }while(0)
  #define VRD(i) do{ vlo[i]=vtr(vp_+(((i)>>2)*4096+((i)&3)*1024)); vhi[i]=vtr(vp_+(((i)>>2)*4096+((i)&3)*1024+512)); }while(0)
  #define KRD(G,j) do{ if(G){ kload2(kf,kp0+sl_next,j); SBAR(); } }while(0)
  #define STEP(C0,C1,P0,P1,t,GK,GV,GL) do{ SBAR(); \
    const lds_cptr vp_=vp0+sl_prev; \
    VRD(0); SBAR(); float sacc=(P0[0]+P0[1]); \
    GAPA(C0=__builtin_amdgcn_mfma_f32_32x32x16_bf16(kf[0],qr[0],negm,0,0,0), P0[2],P0[3],P0[4],P0[5],     pw0[0]=PKW(P0,0), pw0[1]=PKW(P0,2), pw0); \
    VRD(4); SBAR(); GAPA(C1=__builtin_amdgcn_mfma_f32_32x32x16_bf16(kf[1],qr[0],negm,0,0,0), P0[6],P0[7],P0[8],P0[9],     pw0[2]=PKW(P0,4), pw0[3]=PKW(P0,6), pw0); \
    VRD(1); SBAR(); GAPA(C0=__builtin_amdgcn_mfma_f32_32x32x16_bf16(kf[2],qr[1],C0,0,0,0),   P0[10],P0[11],P0[12],P0[13], pw1[0]=PKW(P0,8), pw1[1]=PKW(P0,10), pw1); \
    VRD(5); SBAR(); GAPA(C1=__builtin_amdgcn_mfma_f32_32x32x16_bf16(kf[3],qr[1],C1,0,0,0),   P0[14],P0[15],P1[0],P1[1],   pw1[2]=PKW(P0,12),pw1[3]=PKW(P0,14), pw1); \
    VRD(2); SBAR(); GAPA(C0=__builtin_amdgcn_mfma_f32_32x32x16_bf16(kf[4],qr[2],C0,0,0,0),   P1[2],P1[3],P1[4],P1[5],     pw2[0]=PKW(P1,0), pw2[1]=PKW(P1,2), pw2); \
    VRD(6); SBAR(); GAPA(C1=__builtin_amdgcn_mfma_f32_32x32x16_bf16(kf[5],qr[2],C1,0,0,0),   P1[6],P1[7],P1[8],P1[9],     pw2[2]=PKW(P1,4), pw2[3]=PKW(P1,6), pw2); \
    VRD(3); SBAR(); GAPA(C0=__builtin_amdgcn_mfma_f32_32x32x16_bf16(kf[6],qr[3],C0,0,0,0),   P1[10],P1[11],P1[12],P1[13], pw3[0]=PKW(P1,8), pw3[1]=PKW(P1,10), pw3); \
    VRD(7); SBAR(); GAPA(C1=__builtin_amdgcn_mfma_f32_32x32x16_bf16(kf[7],qr[3],C1,0,0,0),   P1[14],P1[15],0.f,0.f,       pw3[2]=PKW(P1,12),pw3[3]=PKW(P1,14), pw3); \
    l_reg+=sacc; \
    if(GK){DMA_K((t)+3,sl_cur);} if(GV){DMA_V((t)+1,sl_next);} \
    CMASK(C0,C1,t); \
    { float a=MX3(C0[0],C0[1],C1[0]),b=MX3(C0[2],C0[3],C1[1]); a=MX3(a,C1[2],C1[3]); \
      _Pragma("unroll") for(int r=4;r<16;r+=4){a=MX3(a,C0[r],C0[r+1]);b=MX3(b,C0[r+2],C0[r+3]);a=MX3(a,C1[r],C1[r+1]);b=MX3(b,C1[r+2],C1[r+3]);} \
      float rm=__builtin_fmaxf(a,b); { auto rr=__builtin_amdgcn_permlane32_swap(__float_as_uint(rm),__float_as_uint(rm),false,false); rm=__builtin_fmaxf(__uint_as_float(rr[0]),__uint_as_float(rr[1])); } \
      resc=false; \
      if(__builtin_expect(__any(rm>(float)THRL),0)){ const float dl=__builtin_fmaxf(rm,0.f); mhat+=dl; \
        _Pragma("unroll") for(int r=0;r<16;++r){C0[r]-=dl;C1[r]-=dl;} \
        _Pragma("unroll") for(int r=0;r<16;++r)negm[r]=-mhat; asm volatile("":"+v"(negm)); \
        const float f=__builtin_amdgcn_exp2f(-dl); l_reg*=f; if(hi==0)wsf[r32]=f; resc=true; } } \
    SBAR(); \
    GAPB(o[0]=__builtin_amdgcn_mfma_f32_32x32x16_bf16(PAF(0),VFR(0),o[0],0,0,0), C0,0); \
    GAPB(o[1]=__builtin_amdgcn_mfma_f32_32x32x16_bf16(PAF(0),VFR(4),o[1],0,0,0), C0,4); \
    KRD(GL,0); GAPB(o[0]=__builtin_amdgcn_mfma_f32_32x32x16_bf16(PAF(1),VFR(1),o[0],0,0,0), C0,8); \
    KRD(GL,1); GAPB(o[1]=__builtin_amdgcn_mfma_f32_32x32x16_bf16(PAF(1),VFR(5),o[1],0,0,0), C0,12); \
    KRD(GL,2); GAPB(o[0]=__builtin_amdgcn_mfma_f32_32x32x16_bf16(PAF(2),VFR(2),o[0],0,0,0), C1,0); \
    KRD(GL,3); GAPB(o[1]=__builtin_amdgcn_mfma_f32_32x32x16_bf16(PAF(2),VFR(6),o[1],0,0,0), C1,4); \
    GAPB(o[0]=__builtin_amdgcn_mfma_f32_32x32x16_bf16(PAF(3),VFR(3),o[0],0,0,0), C1,8); \
    GAPB(o[1]=__builtin_amdgcn_mfma_f32_32x32x16_bf16(PAF(3),VFR(7),o[1],0,0,0), C1,12); \
    }while(0)
  int t=1;
  #undef CMASK
  #define CMASK(P0,P1,t) do{}while(0)
  for(;t+5<NT;t+=2){
    STEP(pB0,pB1,pA0,pA1,t,true,true,true);     WAIT_BAR(2); RESC(); ROT();
    STEP(pA0,pA1,pB0,pB1,t+1,true,true,true);   WAIT_BAR(2); RESC(); ROT();
  }
  #undef CMASK
  #define CMASK(P0,P1,t) do{}while(0)
  #define ENDW(tt) do{ if((tt)+3<NT){WAIT_BAR(2);} else if((tt)+2<NT){WAIT_BAR(1);} else {WAIT_BAR(0);} }while(0)
  for(;t+1<NT;t+=2){
    STEP(pB0,pB1,pA0,pA1,t,(t+3<NT),(t+1<NT),(t+1<NT));       ENDW(t);   RESC(); ROT();
    STEP(pA0,pA1,pB0,pB1,t+1,(t+4<NT),(t+2<NT),(t+2<NT));     ENDW(t+1); RESC(); ROT();
  }
  STEP(pB0,pB1,pA0,pA1,NT-1,false,false,false); RESC();
  { float sacc=pB0[0]+pB0[1]; _Pragma("unroll") for(int r=2;r<16;++r)sacc+=pB0[r]; _Pragma("unroll") for(int r=0;r<16;++r)sacc+=pB1[r]; l_reg+=sacc;
    pw0=(u32x4){PKW(pB0,0),PKW(pB0,2),PKW(pB0,4),PKW(pB0,6)};pw1=(u32x4){PKW(pB0,8),PKW(pB0,10),PKW(pB0,12),PKW(pB0,14)};pw2=(u32x4){PKW(pB1,0),PKW(pB1,2),PKW(pB1,4),PKW(pB1,6)};pw3=(u32x4){PKW(pB1,8),PKW(pB1,10),PKW(pB1,12),PKW(pB1,14)};
    SBAR(); pv(o,vb0+sl_cur,PAF(0),PAF(1),PAF(2),PAF(3)); }
  #undef PKW
  #undef PAF
  #undef VFR
  #undef PIN
  #undef MX3
  #undef GAPA
  #undef GAPB
  #undef EX
  #undef VRD
  #undef KRD
  #undef STEP
  #undef ENDW
  {auto rr=__builtin_amdgcn_permlane32_swap(__float_as_uint(l_reg),__float_as_uint(l_reg),false,false);l_reg=__uint_as_float(rr[0])+__uint_as_float(rr[1]);}
  if(hi==0)wsf[32+r32]=l_reg;asm volatile("s_waitcnt lgkmcnt(0)":::"memory");
  float rli[16];
  #pragma unroll
  for(int r=0;r<16;++r)rli[r]=__builtin_amdgcn_rcpf(wsf[32+crow(r,hi)]);
  bf16*Ow=Ou+(long)(wid*QBLK)*PO;
  { bf16*stg=(bf16*)(shm+LDS_OST)+wid*2048;
    #pragma unroll
    for(int r=0;r<16;++r){const int orow=crow(r,hi);
      #pragma unroll
      for(int d0=0;d0<2;++d0)stg[orow*64+d0*32+r32]=__float2bfloat16(o[d0][r]*rli[r]);}
    asm volatile("s_waitcnt lgkmcnt(0)":::"memory");
    #pragma unroll
    for(int i=0;i<4;++i){const int row=i*8+(lane>>3),ch=lane&7; const u32x4 v=*(const u32x4*)(stg+row*64+ch*8); ATTN_STORE16(Ow+(long)row*PO+ch*8,v);} }
  asm volatile("s_waitcnt lgkmcnt(0)\n\ts_barrier":::"memory");
  #undef DMA_K
  #undef DMA_V
  #undef CMASK
  #undef START
  #undef RESC
  #undef ROT
}
constexpr int ATTN_LDS_BYTES=LDS_BYTES;
#undef SBAR
#undef WAIT_BAR
}
namespace attn_av {
using namespace attn_body;
#define SBAR() __builtin_amdgcn_sched_barrier(0)
#define WAIT_BAR(N) asm volatile("s_waitcnt vmcnt(" #N ") lgkmcnt(0)\n\ts_barrier":::"memory")
constexpr int KSLOT=8192, VSLOT=16384;
constexpr int AV_K=0, AV_V=NSLOT*KSLOT, AV_WS=AV_V+NSLOT*VSLOT, AV_ST=AV_WS+NW*64*4, AV_LDS_BYTES=AV_ST+NW*8192;
__device__ __forceinline__ void pv4(f32x16*o,int vb,bf16x8 pa0,bf16x8 pa1,bf16x8 pa2,bf16x8 pa3){
  #pragma unroll
  for(int d0=0;d0<4;++d0){s16x4 lo[4],hi[4];
    #pragma unroll
    for(int ks=0;ks<4;++ks){
      asm volatile("ds_read_b64_tr_b16 %0,%1 offset:%c2":"=&v"(lo[ks]):"v"(vb),"i"(d0*4096+ks*1024):"memory");
      asm volatile("ds_read_b64_tr_b16 %0,%1 offset:%c2":"=&v"(hi[ks]):"v"(vb),"i"(d0*4096+ks*1024+512):"memory");}
    asm volatile("s_waitcnt lgkmcnt(0)":::"memory");SBAR();
    #define PK(k) (bf16x8){lo[k][0],lo[k][1],lo[k][2],lo[k][3],hi[k][0],hi[k][1],hi[k][2],hi[k][3]}
    o[d0]=__builtin_amdgcn_mfma_f32_32x32x16_bf16(pa0,PK(0),o[d0],0,0,0);
    o[d0]=__builtin_amdgcn_mfma_f32_32x32x16_bf16(pa1,PK(1),o[d0],0,0,0);
    o[d0]=__builtin_amdgcn_mfma_f32_32x32x16_bf16(pa2,PK(2),o[d0],0,0,0);
    o[d0]=__builtin_amdgcn_mfma_f32_32x32x16_bf16(pa3,PK(3),o[d0],0,0,0);
    #undef PK
  }
}
template<int THRL,int EPI> __device__ __forceinline__ void attn_unit_v(const bf16*Qu,const bf16*__restrict__ Kh,const bf16*__restrict__ Vh,bf16*Ou,const long PO,const int NT,char*shm,const float lam,const float*__restrict__ gain,const float scale){
  int tid_l=threadIdx.x; asm volatile("":"+v"(tid_l)); const int tid=tid_l,lane=tid&63,r32=lane&31,hi=lane>>5; const int wid=__builtin_amdgcn_readfirstlane(tid>>6);
  const bf16*Qw=Qu+(long)(wid*QBLK)*PU;
  const unsigned lds0=(unsigned)(uintptr_t)shm;
  float*wsf=(float*)(shm+AV_WS)+wid*64;
  const bf16*ksrc=Kh+(long)lane*PU+wid*8;
  const bf16*vsrc=Vh+(long)(16*(wid&3)+(lane>>2))*PU+(wid>>2)*32+(lane&3)*8;
  const unsigned kdst=lds0+AV_K+wid*1024, vdst=lds0+AV_V+wid*1024;
  #define DMA_K(t,slot) glds16(ksrc+(long)(t)*KVBLK*PU,(unsigned)__builtin_amdgcn_readfirstlane(kdst+(slot)))
  #define DMA_V(t,slot) do{ glds16(vsrc+(long)(t)*KVBLK*PU,(unsigned)__builtin_amdgcn_readfirstlane(vdst+2*(slot))); glds16(vsrc+64+(long)(t)*KVBLK*PU,(unsigned)__builtin_amdgcn_readfirstlane(vdst+8192+2*(slot))); }while(0)
  const int vb0=(int)(lds0+AV_V)+((lane>>4)&1)*32+(lane&3)*8+(4*hi+((lane&15)>>2))*64;
  const char*Kbase=shm+AV_K; bf16x8 kf[8];
  const lds_cptr shm3=(lds_cptr)shm; const lds_cptr kp0=shm3+AV_K+hi*1024+r32*16; const lds_cptr vp0=shm3+AV_V+((lane>>4)&1)*32+(lane&3)*8+(4*hi+((lane&15)>>2))*64;

  DMA_K(0,0);DMA_V(0,0);DMA_K(1,KSLOT);
  bf16x8 qr[4];
  #pragma unroll
  for(int d0=0;d0<4;++d0)qr[d0]=*reinterpret_cast<const bf16x8*>(&Qw[(long)r32*PU+d0*16+hi*8]);
  float mhat=0.f,l_reg=0.f;f32x16 o[4];o[0]=f32x16{};o[1]=f32x16{};o[2]=f32x16{};o[3]=f32x16{};f32x16 negm=f32x16{};asm volatile("":"+v"(negm));
  bool resc=false;
  #define START(P0,P1) do{ const float rm=rowmax(P0,P1); resc=false; \
    { const float dl=rm; mhat=fadd_s(mhat,dl); \
      _Pragma("unroll") for(int r=0;r<16;++r){P0[r]=fsub_s(P0[r],dl);P1[r]=fsub_s(P1[r],dl);} \
      _Pragma("unroll") for(int r=0;r<16;++r)negm[r]=-mhat; asm volatile("":"+v"(negm)); } \
    _Pragma("unroll") for(int r=0;r<16;++r)P0[r]=__builtin_amdgcn_exp2f(P0[r]); }while(0)
  #define RESC() do{ if(resc){ asm volatile("s_waitcnt lgkmcnt(0)":::"memory"); \
      _Pragma("unroll") for(int d_=0;d_<4;++d_) _Pragma("unroll") for(int r=0;r<16;++r)o[d_][r]*=wsf[crow(r,hi)]; } }while(0)
  f32x16 pA0,pA1,pB0,pB1;
  int sl_prev=0,sl_cur=0,sl_next=KSLOT;
  #define ROT() do{sl_prev=sl_cur;sl_cur=sl_next;sl_next=(sl_next==(NSLOT-1)*KSLOT)?0:sl_next+KSLOT;}while(0)
  DMA_K(2,2*KSLOT);
  WAIT_BAR(3);
  qkt(pA0,pA1,Kbase,qr,negm,r32,hi);asm volatile("s_nop 15\n\ts_nop 7":"+v"(pA0),"+v"(pA1));
  START(pA0,pA1);
  _Pragma("unroll") for(int r=0;r<16;++r)pA1[r]=__builtin_amdgcn_exp2f(pA1[r]);
  WAIT_BAR(0);
  DMA_K(3,0);DMA_V(1,KSLOT);
  ROT();
  kload8(kf,kp0+sl_cur);
  WAIT_BAR(3);
  s16x4 vlo[8],vhi[8]; u32x4 pw0,pw1,pw2,pw3;
  #define PKW(P,B) cvtpk_s(P[B],P[B+1])
  #define PAF(k) __builtin_bit_cast(bf16x8,pw##k)
  #define VFR(i) (bf16x8){vlo[i][0],vlo[i][1],vlo[i][2],vlo[i][3],vhi[i][0],vhi[i][1],vhi[i][2],vhi[i][3]}
  #define PIN(x) asm volatile("":"+v"(x))
  #define MX3(a,b,c) __builtin_fmaxf(__builtin_fmaxf((a),(b)),(c))
  #define GAPA(MF,A0,A1,A2,A3,W0,W1,PW) do{ MF; sacc+=A0; sacc+=A1; sacc+=A2; sacc+=A3; PIN(sacc); W0; W1; PIN(PW); SBAR(); }while(0)
  #define EX(v) __builtin_amdgcn_exp2f(v)
  #define GAPB(MF,X,B) do{ MF; X[B]=EX(X[B]); X[B+1]=EX(X[B+1]); PIN(X); SBAR(); }while(0)
  #define VRD(i) do{ vlo[i]=vtr(vp_+(((i)>>2)*4096+((i)&3)*1024)); vhi[i]=vtr(vp_+(((i)>>2)*4096+((i)&3)*1024+512)); }while(0)
  #define VRD2(i) do{ vlo[i]=vtr(vp_+(8192+((i)>>2)*4096+((i)&3)*1024)); vhi[i]=vtr(vp_+(8192+((i)>>2)*4096+((i)&3)*1024+512)); }while(0)
  #define GAPB1(MF,I,X,B) do{ MF; VRD2(I); X[B]=EX(X[B]); X[B+1]=EX(X[B+1]); PIN(X); SBAR(); }while(0)
  #define KRD(G,j) do{ if(G){ kload2(kf,kp0+sl_next,j); SBAR(); } }while(0)
  #define MF32(a,b,c) __builtin_amdgcn_mfma_f32_32x32x16_bf16(a,b,c,0,0,0)
  #define STEP(C0,C1,P0,P1,t,GK,GV,GL) do{ SBAR(); \
    const lds_cptr vp_=vp0+2*sl_prev; \
    VRD(0); SBAR(); float sacc=(P0[0]+P0[1]); \
    GAPA(C0=MF32(kf[0],qr[0],negm), P0[2],P0[3],P0[4],P0[5],     pw0[0]=PKW(P0,0), pw0[1]=PKW(P0,2), pw0); \
    VRD(4); SBAR(); GAPA(C1=MF32(kf[1],qr[0],negm), P0[6],P0[7],P0[8],P0[9],     pw0[2]=PKW(P0,4), pw0[3]=PKW(P0,6), pw0); \
    VRD(1); SBAR(); GAPA(C0=MF32(kf[2],qr[1],C0),   P0[10],P0[11],P0[12],P0[13], pw1[0]=PKW(P0,8), pw1[1]=PKW(P0,10), pw1); \
    VRD(5); SBAR(); GAPA(C1=MF32(kf[3],qr[1],C1),   P0[14],P0[15],P1[0],P1[1],   pw1[2]=PKW(P0,12),pw1[3]=PKW(P0,14), pw1); \
    VRD(2); SBAR(); GAPA(C0=MF32(kf[4],qr[2],C0),   P1[2],P1[3],P1[4],P1[5],     pw2[0]=PKW(P1,0), pw2[1]=PKW(P1,2), pw2); \
    VRD(6); SBAR(); GAPA(C1=MF32(kf[5],qr[2],C1),   P1[6],P1[7],P1[8],P1[9],     pw2[2]=PKW(P1,4), pw2[3]=PKW(P1,6), pw2); \
    VRD(3); SBAR(); GAPA(C0=MF32(kf[6],qr[3],C0),   P1[10],P1[11],P1[12],P1[13], pw3[0]=PKW(P1,8), pw3[1]=PKW(P1,10), pw3); \
    VRD(7); SBAR(); GAPA(C1=MF32(kf[7],qr[3],C1),   P1[14],P1[15],0.f,0.f,       pw3[2]=PKW(P1,12),pw3[3]=PKW(P1,14), pw3); \
    l_reg+=sacc; \
    if(GK){DMA_K((t)+3,sl_cur);} if(GV){DMA_V((t)+1,sl_next);} \
    { float a=MX3(C0[0],C0[1],C1[0]),b=MX3(C0[2],C0[3],C1[1]); a=MX3(a,C1[2],C1[3]); \
      _Pragma("unroll") for(int r=4;r<16;r+=4){a=MX3(a,C0[r],C0[r+1]);b=MX3(b,C0[r+2],C0[r+3]);a=MX3(a,C1[r],C1[r+1]);b=MX3(b,C1[r+2],C1[r+3]);} \
      float rm=__builtin_fmaxf(a,b); { auto rr=__builtin_amdgcn_permlane32_swap(__float_as_uint(rm),__float_as_uint(rm),false,false); rm=__builtin_fmaxf(__uint_as_float(rr[0]),__uint_as_float(rr[1])); } \
      resc=false; \
      if(__builtin_expect(__any(rm>(float)THRL),0)){ const float dl=__builtin_fmaxf(rm,0.f); mhat+=dl; \
        _Pragma("unroll") for(int r=0;r<16;++r){C0[r]-=dl;C1[r]-=dl;} \
        _Pragma("unroll") for(int r=0;r<16;++r)negm[r]=-mhat; asm volatile("":"+v"(negm)); \
        const float f=__builtin_amdgcn_exp2f(-dl); l_reg*=f; if(hi==0)wsf[r32]=f; resc=true; } } \
    SBAR(); \
    GAPB1(o[0]=MF32(PAF(0),VFR(0),o[0]), 0, C0,0); \
    GAPB1(o[1]=MF32(PAF(0),VFR(4),o[1]), 4, C0,2); \
    GAPB1(o[0]=MF32(PAF(1),VFR(1),o[0]), 1, C0,4); \
    GAPB1(o[1]=MF32(PAF(1),VFR(5),o[1]), 5, C0,6); \
    GAPB1(o[0]=MF32(PAF(2),VFR(2),o[0]), 2, C0,8); \
    GAPB1(o[1]=MF32(PAF(2),VFR(6),o[1]), 6, C0,10); \
    GAPB1(o[0]=MF32(PAF(3),VFR(3),o[0]), 3, C0,12); \
    GAPB1(o[1]=MF32(PAF(3),VFR(7),o[1]), 7, C0,14); \
    GAPB(o[2]=MF32(PAF(0),VFR(0),o[2]), C1,0); \
    GAPB(o[3]=MF32(PAF(0),VFR(4),o[3]), C1,2); \
    KRD(GL,0); GAPB(o[2]=MF32(PAF(1),VFR(1),o[2]), C1,4); \
    KRD(GL,1); GAPB(o[3]=MF32(PAF(1),VFR(5),o[3]), C1,6); \
    KRD(GL,2); GAPB(o[2]=MF32(PAF(2),VFR(2),o[2]), C1,8); \
    KRD(GL,3); GAPB(o[3]=MF32(PAF(2),VFR(6),o[3]), C1,10); \
    GAPB(o[2]=MF32(PAF(3),VFR(3),o[2]), C1,12); \
    GAPB(o[3]=MF32(PAF(3),VFR(7),o[3]), C1,14); \
    }while(0)
  int t=1;
  for(;t+5<NT;t+=2){
    STEP(pB0,pB1,pA0,pA1,t,true,true,true);     WAIT_BAR(3); RESC(); ROT();
    STEP(pA0,pA1,pB0,pB1,t+1,true,true,true);   WAIT_BAR(3); RESC(); ROT();
  }
  #define ENDW(tt) do{ if((tt)+3<NT){WAIT_BAR(3);} else if((tt)+2<NT){WAIT_BAR(2);} else {WAIT_BAR(0);} }while(0)
  for(;t+1<NT;t+=2){
    STEP(pB0,pB1,pA0,pA1,t,(t+3<NT),(t+1<NT),(t+1<NT));       ENDW(t);   RESC(); ROT();
    STEP(pA0,pA1,pB0,pB1,t+1,(t+4<NT),(t+2<NT),(t+2<NT));     ENDW(t+1); RESC(); ROT();
  }
  STEP(pB0,pB1,pA0,pA1,NT-1,false,false,false); RESC();
  { float sacc=pB0[0]+pB0[1]; _Pragma("unroll") for(int r=2;r<16;++r)sacc+=pB0[r]; _Pragma("unroll") for(int r=0;r<16;++r)sacc+=pB1[r]; l_reg+=sacc;
    pw0=(u32x4){PKW(pB0,0),PKW(pB0,2),PKW(pB0,4),PKW(pB0,6)};pw1=(u32x4){PKW(pB0,8),PKW(pB0,10),PKW(pB0,12),PKW(pB0,14)};pw2=(u32x4){PKW(pB1,0),PKW(pB1,2),PKW(pB1,4),PKW(pB1,6)};pw3=(u32x4){PKW(pB1,8),PKW(pB1,10),PKW(pB1,12),PKW(pB1,14)};
    SBAR(); pv4(o,vb0+2*sl_cur,PAF(0),PAF(1),PAF(2),PAF(3)); }
  #undef PKW
  #undef PAF
  #undef VFR
  #undef PIN
  #undef MX3
  #undef GAPA
  #undef GAPB
  #undef GAPB1
  #undef EX
  #undef VRD
  #undef VRD2
  #undef KRD
  #undef MF32
  #undef STEP
  #undef ENDW
  {auto rr=__builtin_amdgcn_permlane32_swap(__float_as_uint(l_reg),__float_as_uint(l_reg),false,false);l_reg=__uint_as_float(rr[0])+__uint_as_float(rr[1]);}
  if(hi==0)wsf[32+r32]=l_reg;asm volatile("s_waitcnt lgkmcnt(0)":::"memory");
  float rli[16];
  #pragma unroll
  for(int r=0;r<16;++r)rli[r]=__builtin_amdgcn_rcpf(wsf[32+crow(r,hi)]);
  unsigned*stw=(unsigned*)(shm+AV_ST)+wid*2048;
  if constexpr(EPI==1){
    #pragma unroll
    for(int d0=0;d0<4;++d0)
      #pragma unroll
      for(int r=0;r<16;r+=2)stw[(d0*8+(r>>1))*64+lane]=cvtpk_s(o[d0][r]*rli[r],o[d0][r+1]*rli[r+1]);
  } else {
    unsigned s1[32];
    #pragma unroll
    for(int j=0;j<32;++j)s1[j]=stw[j*64+lane];
    const float g0=gain[r32],g1=gain[32+r32],g2=gain[64+r32],g3=gain[96+r32];
    asm volatile("s_waitcnt lgkmcnt(0)":::"memory");
    float ss[16];
    #pragma unroll
    for(int r=0;r<16;++r){ float a=0.f;
      #pragma unroll
      for(int d0=0;d0<4;++d0){ const unsigned w=s1[d0*8+(r>>1)]; const float o1=(r&1)?__uint_as_float(w&0xffff0000u):__uint_as_float(w<<16);
        const float d=o1-lam*(o[d0][r]*rli[r]); o[d0][r]=d; a+=d*d; }
      ss[r]=a; }
    #pragma unroll
    for(int r=0;r<16;++r){
      #pragma unroll
      for(int sft=1;sft<32;sft<<=1)ss[r]+=__builtin_bit_cast(float,__builtin_amdgcn_ds_bpermute((lane^sft)<<2,__builtin_bit_cast(int,ss[r])));
      ss[r]=scale/sqrtf(ss[r]*(1.f/128.f)+1e-6f); }
    bf16*Ow=Ou+(long)(wid*QBLK)*PO;
    bf16*stg=(bf16*)stw;
    #pragma unroll
    for(int hf=0;hf<2;++hf){
      #pragma unroll
      for(int r=0;r<16;++r){const int orow=crow(r,hi);
        stg[orow*64+r32]=__float2bfloat16(o[2*hf][r]*ss[r]*(hf?g2:g0)); stg[orow*64+32+r32]=__float2bfloat16(o[2*hf+1][r]*ss[r]*(hf?g3:g1));}
      asm volatile("s_waitcnt lgkmcnt(0)":::"memory");
      #pragma unroll
      for(int i=0;i<4;++i){const int row=i*8+(lane>>3),ch=lane&7; const u32x4 v=*(const u32x4*)(stg+row*64+ch*8); *(u32x4*)(Ow+(long)row*PO+hf*64+ch*8)=v;}
      asm volatile("s_waitcnt lgkmcnt(0)":::"memory"); } }
  asm volatile("s_waitcnt lgkmcnt(0)\n\ts_barrier":::"memory");
  #undef DMA_K
  #undef DMA_V
  #undef START
  #undef RESC
  #undef ROT
}
#undef SBAR
#undef WAIT_BAR
}
constexpr int NWAVES = 8;
constexpr int DM = 2048, DFF = 5632, NU = 8960, NMIX = 3072, DEPTH = 2;
constexpr int NTOK = 65536, CH = 16384, NCHUNK = 4;
constexpr int NIN_SRC = 8224;
constexpr float EPS = 1e-6f;
constexpr float C2 = 0.18033688011112042f;
constexpr int U_AQ = 0, U_AK = 768, U_AV = 1536, U_BQ = 2304, U_BK = 3072, U_BV = 3840, U_CQ = 4608, U_CK = 4992, U_CV = 5376, U_CG = 6144, U_GF = 6912, U_GB = 7296, U_DQ = 7680, U_DK = 8448, U_DV = 8704;

constexpr size_t MiB = 1u << 20;
constexpr size_t WS_CTL = 0, CTL_ZERO_BYTES = 6 * MiB;
constexpr size_t WS_TAB = 1 * MiB;
constexpr size_t WS_TAB_AX = WS_TAB + 8192 * 8 * 8;
constexpr size_t WS_RSS = 2 * MiB;
constexpr size_t WS_W = 6 * MiB;
constexpr size_t W_GU1 = 0, W_D1 = 44 * MiB, W_IN = 66 * MiB, W_OUT = 101 * MiB, W_GU2 = 113 * MiB, W_D2 = 157 * MiB, W_LAYER = 179 * MiB;
constexpr size_t WS_XN = WS_W + 2 * W_LAYER;
constexpr size_t WS_U = WS_XN + 64 * MiB;
constexpr size_t WS_MIX = WS_U + 280 * MiB;
constexpr size_t WS_OA = WS_MIX + 96 * MiB;
constexpr size_t WS_BO = WS_OA;
constexpr size_t WS_BL = WS_BO + 72 * MiB;
constexpr size_t WS_OC = WS_BL + 3 * MiB;
constexpr size_t WS_END = WS_OC + 96 * MiB;
constexpr int CW_BAR = 4096;
constexpr int CW_Q = 16384;
constexpr int CW_LAM = 32768;

constexpr int RING_BYTES = 131072;
constexpr int MISC_OFF = 163328;
constexpr int LDS_BYTES = 163840;

#define GAS __attribute__((address_space(1)))
#define LAS __attribute__((address_space(3)))
#define DI __device__ __forceinline__
typedef unsigned short bfu;
typedef unsigned u32x4 __attribute__((ext_vector_type(4)));
typedef unsigned u32x2 __attribute__((ext_vector_type(2)));
typedef float f32x4 __attribute__((ext_vector_type(4)));
typedef float f32x2 __attribute__((ext_vector_type(2)));
typedef float f32x16 __attribute__((ext_vector_type(16)));
typedef short bf16x8 __attribute__((ext_vector_type(8)));
typedef short s16x4 __attribute__((ext_vector_type(4)));
typedef GAS unsigned gu32;
#define RLX_AGENT __ATOMIC_RELAXED, __HIP_MEMORY_SCOPE_AGENT
#define LDS_WAIT() asm volatile("s_waitcnt lgkmcnt(0)" ::: "memory")
#define VM_WAIT() asm volatile("s_waitcnt vmcnt(0)" ::: "memory")
DI unsigned f2bf(float f) { unsigned u = __builtin_bit_cast(unsigned, f); return (u + 0x7fffu + ((u >> 16) & 1u)) >> 16; }
DI unsigned pk2(float lo, float hi) { typedef __bf16 bf2_t __attribute__((ext_vector_type(2))); f32x2 v = {lo, hi}; bf2_t b = __builtin_convertvector(v, bf2_t); return __builtin_bit_cast(unsigned, b); }
DI float bflo(unsigned w) { return __builtin_bit_cast(float, w << 16); }
DI float bfhi(unsigned w) { return __builtin_bit_cast(float, w & 0xffff0000u); }
DI float bf2f(bfu b) { return __builtin_bit_cast(float, (unsigned)b << 16); }
DI float lane_get(float v, int src_lane) { return __builtin_bit_cast(float, __builtin_amdgcn_ds_bpermute(src_lane << 2, __builtin_bit_cast(int, v))); }
DI float wave_sum(float v, int lane) {
#pragma unroll
    for (int o = 1; o < 64; o <<= 1) v += lane_get(v, lane ^ o);
    return v;
}
DI int crow(int r, int hi) { return (r & 3) + 8 * (r >> 2) + 4 * hi; }
DI bf16x8 pack8(const f32x16& x, int s) { u32x4 p; p.x = pk2(x[8 * s], x[8 * s + 1]); p.y = pk2(x[8 * s + 2], x[8 * s + 3]); p.z = pk2(x[8 * s + 4], x[8 * s + 5]); p.w = pk2(x[8 * s + 6], x[8 * s + 7]); return __builtin_bit_cast(bf16x8, p); }
typedef short v4i16_t __attribute__((ext_vector_type(4)));
DI s16x4 vtr(const LAS bfu* p) { return __builtin_bit_cast(s16x4, __builtin_amdgcn_ds_read_tr16_b64_v4i16((LAS v4i16_t*)p)); }
DI bf16x8 cat8(s16x4 lo, s16x4 hi) { return (bf16x8){lo[0], lo[1], lo[2], lo[3], hi[0], hi[1], hi[2], hi[3]}; }
#define MFMA32(a, b, c) __builtin_amdgcn_mfma_f32_32x32x16_bf16((a), (b), (c), 0, 0, 0)

#define XB_TMO      128
#define XB_XCNT(j)  (256  + 64 * (j))
#define XB_XSUB(j)  (1280 + 64 * (j))
#define XB_XGEN(j)  (2304 + 64 * (j))
#define XB_TOP      3328
#define XB_TOPGEN   3392
#define XCD_BAR_WORDS 3456
#define XB_SPIN_CAP (1u << 18)

__device__ __forceinline__ unsigned xb_ld(unsigned* p)              { return __hip_atomic_load(p, __ATOMIC_RELAXED, __HIP_MEMORY_SCOPE_AGENT); }
__device__ __forceinline__ unsigned xb_add(unsigned* p, unsigned v) { return __hip_atomic_fetch_add(p, v, __ATOMIC_RELAXED, __HIP_MEMORY_SCOPE_AGENT); }
__device__ __forceinline__ unsigned xb_xcc_id() { return (unsigned)__builtin_amdgcn_s_getreg((3 << 11) | 20) & 0xFu; }
#define XB_SPIN(cond, bar) do { unsigned _sp = 0; while (cond) { __builtin_amdgcn_s_sleep(1); \
    if ((++_sp & 255u) == 0u) { if (xb_ld(&(bar)[XB_TMO])) break; if (_sp > XB_SPIN_CAP) { atomicAdd(&(bar)[XB_TMO], 1u); break; } } } } while (0)

struct XcdBarrier {
    unsigned* bar; unsigned x;
    volatile LAS unsigned* st;
};

__device__ __forceinline__ XcdBarrier xcd_barrier_post(unsigned* bar, volatile LAS unsigned* st) {
    XcdBarrier b; b.bar = bar; b.x = xb_xcc_id(); b.st = st;
    if (threadIdx.x == 0) (void)xb_add(&bar[XB_XCNT(b.x)], 1u);
    return b;
}
__device__ __forceinline__ void xcd_barrier_complete(unsigned* bar, unsigned x, unsigned& nloc, unsigned& nx) {
    const unsigned G = gridDim.x * gridDim.y * gridDim.z;
    unsigned sum, cnt, mine, sp = 0u;
    for (;;) {
        sum = 0u; cnt = 0u; mine = 0u;
#pragma unroll
        for (unsigned j = 0; j < 16; ++j) { const unsigned c = xb_ld(&bar[XB_XCNT(j)]); sum += c; cnt += (c > 0u) ? 1u : 0u; mine = (j == x) ? c : mine; }
        if (sum == G) break;
        __builtin_amdgcn_s_sleep(1);
        if ((++sp & 255u) == 0u) { if (xb_ld(&bar[XB_TMO])) break; if (sp > XB_SPIN_CAP) { atomicAdd(&bar[XB_TMO], 1u); break; } }
    }
    nloc = mine > 0u ? mine : 1u; nx = cnt > 0u ? cnt : 1u;
}

__device__ __forceinline__ void xcd_barrier(const XcdBarrier& b) {
    asm volatile("s_waitcnt vmcnt(0)" ::: "memory");
    __syncthreads();
    if (threadIdx.x == 0) {
        GAS unsigned* gbar_ = (GAS unsigned*)b.bar; asm volatile("" : "+s"(gbar_)); unsigned* bar = (unsigned*)gbar_; unsigned bx_ = b.x; asm volatile("" : "+s"(bx_));
        __builtin_amdgcn_s_waitcnt(0);
        unsigned nloc = b.st[0], nx = b.st[1];
        if (nloc == 0u) { xcd_barrier_complete(bar, bx_, nloc, nx); b.st[0] = nloc; b.st[1] = nx; }
        const unsigned old = xb_add(&bar[XB_XSUB(bx_)], 1u);
        const unsigned gen = old / nloc;
        if (old + 1u == (gen + 1u) * nloc) {
            __builtin_amdgcn_fence(__ATOMIC_RELEASE, "agent");
            asm volatile("s_waitcnt vmcnt(0)" ::: "memory");
            const unsigned og = xb_add(&bar[XB_TOP], 1u);
            const unsigned tg = og / nx;
            if (og + 1u == (tg + 1u) * nx) xb_add(&bar[XB_TOPGEN], 1u);
            else XB_SPIN(xb_ld(&bar[XB_TOPGEN]) == tg, bar);
            __builtin_amdgcn_fence(__ATOMIC_ACQUIRE, "agent");
            xb_add(&bar[XB_XGEN(bx_)], 1u);
            asm volatile("s_waitcnt vmcnt(0)" ::: "memory");
        } else {
            XB_SPIN(xb_ld(&bar[XB_XGEN(bx_)]) == gen, bar);
            __builtin_amdgcn_fence(__ATOMIC_ACQUIRE, "agent");
            asm volatile("s_waitcnt vmcnt(0)" ::: "memory");
        }
    }
    __syncthreads();
}
struct Frame {
    LAS unsigned char* lds;
    volatile LAS unsigned* MISC;
    gu32* ctl;
    int tid, lane, wave;
    int vcu, G;
};
struct Args { const float* in[28]; };

DI int tr_rowmap(int d, int rmap) { return rmap == 1 ? ((d >= 4 && d < 8) ? d + 4 : ((d >= 8 && d < 12) ? d - 4 : d)) : (rmap == 2 ? 8 * ((d >> 2) & 3) + 4 * (d >> 4) + (d & 3) : d); }
DI void tr_item(const float* W, size_t ldw, int k0, int nsrc0, bfu* WT, size_t Kd, int dstrow0, float scale, const float* kgain, LAS float* scr, int lane, int rmap = 0) {
    { float v[32];
      const float* wp = W + (size_t)(k0 + (lane >> 5)) * ldw + nsrc0 + (lane & 31);
#pragma unroll
      for (int i = 0; i < 32; ++i) v[i] = wp[(size_t)(2 * i) * ldw];
      if (kgain) {
#pragma unroll
          for (int i = 0; i < 32; ++i) v[i] *= scale * kgain[k0 + 2 * i + (lane >> 5)];
      } else {
#pragma unroll
          for (int i = 0; i < 32; ++i) v[i] *= scale;
      }
#pragma unroll
      for (int i = 0; i < 32; ++i) scr[(2 * i + (lane >> 5)) * 33 + (lane & 31)] = v[i]; }
    LDS_WAIT(); asm volatile("" ::: "memory");
    const int c = lane & 7;
#pragma unroll
    for (int j = 0; j < 4; ++j) { const int n = (lane >> 3) + 8 * j; const LAS float* s = scr + (8 * c) * 33 + n;
        u32x4 o; o.x = pk2(s[0 * 33], s[1 * 33]); o.y = pk2(s[2 * 33], s[3 * 33]); o.z = pk2(s[4 * 33], s[5 * 33]); o.w = pk2(s[6 * 33], s[7 * 33]);
        *(GAS u32x4*)(WT + (size_t)(dstrow0 + tr_rowmap(n, rmap)) * Kd + k0 + 8 * c) = o; }
    LDS_WAIT(); asm volatile("" ::: "memory");
}
DI void conv_gu(const float* Wg, const float* Wu, const float* kgain, bfu* WT, int r, LAS float* scr, int lane) {
    const int which = r / 5632, it = r % 5632, kb = it / 176, nb = it % 176, n0 = 32 * nb;
    tr_item(which ? Wu : Wg, DFF, 64 * kb, n0, WT, DM, 256 * (n0 / 128) + 128 * which + (n0 % 128), 1.0f, kgain, scr, lane);
}
DI void conv_down(const float* Wd, bfu* WT, int it, LAS float* scr, int lane) {
    const int kb = it / 64, nb = it % 64;
    tr_item(Wd, DM, 64 * kb, 32 * nb, WT, DFF, 32 * nb, 1.0f, nullptr, scr, lane);
}
DI void conv_in(const float* Wi, const float* kgain, bfu* WT, int it, LAS float* scr, int lane) {
    const int kb = it / 257, nb = it % 257, n0 = 32 * nb;
    const int dst = n0 < 6944 ? n0 : n0 + 736;
    const float sc = (n0 < 768 || (n0 >= 2304 && n0 < 3072)) ? C2 : 1.0f;
    const int rmap = ((n0 < 1536 || (n0 >= 2304 && n0 < 3840)) && (n0 & 63) == 0) ? 1 : ((n0 >= 6944 && n0 < 7968) ? 2 : 0);
    tr_item(Wi, NIN_SRC, 64 * kb, n0, WT, DM, dst, sc, kgain, scr, lane, rmap);
}
DI void conv_out(const float* Wo, bfu* WT, int it, LAS float* scr, int lane) {
    const int kb = it / 64, nb = it % 64;
    tr_item(Wo, DM, 64 * kb, 32 * nb, WT, NMIX, 32 * nb, 1.0f, nullptr, scr, lane);
}
DI void conv_gate(const float* Gf, const float* Gb, bfu* WT, int it) {
    const int r = it & 15, n = (it >> 4) % 384, dir = it / (16 * 384);
    (WT + (size_t)6944 * DM)[it] = (bfu)f2bf((dir ? Gb : Gf)[r * 384 + n]);
}
DI void sincos_d(double a, float& c, float& s) {
    const double k = rint(a * 0.15915494309189535);
    double r = fma(-k, 6.283185307179586, a); r = fma(-k, 2.4492935982947064e-16, r);
    const double r2 = r * r; double sv = 1.0, cv = 1.0;
#pragma unroll
    for (int n = 14; n >= 1; --n) { sv = 1.0 - sv * r2 * (1.0 / (double)((2 * n) * (2 * n + 1))); cv = 1.0 - cv * r2 * (1.0 / (double)((2 * n - 1) * (2 * n))); }
    s = (float)(sv * r); c = (float)cv;
}
__device__ const double INV_P[8] = {1.0, 0.19392274474868576, 0.03760603093086393, 0.007292664737217109, 0.001414213562373095, 0.0002742481756762073, 5.318295896944988e-05, 1.031338537721246e-05};
__device__ const double INV_AX[16] = {1.0, 0.5623413251903491, 0.31622776601683794, 0.1778279410038923, 0.1, 0.05623413251903491, 0.03162277660168379, 0.01778279410038923, 0.01, 0.005623413251903491, 0.0031622776601683794, 0.0017782794100389228, 0.001, 0.0005623413251903491, 0.00031622776601683794, 0.00017782794100389227};

DI void p0_prologue(Frame& F0, const Args& A) {
    Frame F = F0; F.tid = threadIdx.x; asm volatile("" : "+v"(F.tid), "+s"(F.wave), "+s"(F.vcu), "+s"(F.G)); F.lane = F.tid & 63;
    LAS float* scr = (LAS float*)(F.lds + F.wave * 16384);
    const int gw = F.vcu * NWAVES + F.wave, NGW = F.G * NWAVES;
    constexpr int I_GU = 2 * 5632, I_D = 5632, I_IN = 8224, I_OUT = 3072, I_LAYER = 2 * I_GU + 2 * I_D + I_IN + I_OUT;
    for (int it = gw; it < DEPTH * I_LAYER; it += NGW) {
        const int l = it / I_LAYER; int r = it % I_LAYER;
        bfu* wl = (bfu*)(((unsigned char*)A.in[27]) + WS_W + (size_t)l * W_LAYER);
        if (r < I_GU) { conv_gu(A.in[3] + (size_t)l * DM * DFF, A.in[4] + (size_t)l * DM * DFF, A.in[2] + l * DM, wl + W_GU1 / 2, r, scr, F.lane); continue; } r -= I_GU;
        if (r < I_D) { conv_down(A.in[5] + (size_t)l * DM * DFF, wl + W_D1 / 2, r, scr, F.lane); continue; } r -= I_D;
        if (r < I_IN) { conv_in(A.in[7] + (size_t)l * DM * NIN_SRC, A.in[6] + l * DM, wl + W_IN / 2, r, scr, F.lane); continue; } r -= I_IN;
        if (r < I_OUT) { conv_out(A.in[8] + (size_t)l * NMIX * DM, wl + W_OUT / 2, r, scr, F.lane); continue; } r -= I_OUT;
        if (r < I_GU) { conv_gu(A.in[22] + (size_t)l * DM * DFF, A.in[23] + (size_t)l * DM * DFF, A.in[21] + l * DM, wl + W_GU2 / 2, r, scr, F.lane); continue; } r -= I_GU;
        conv_down(A.in[24] + (size_t)l * DM * DFF, wl + W_D2 / 2, r, scr, F.lane);
    }
    const int gt = F.vcu * (NWAVES * 64) + F.tid, NGT = F.G * NWAVES * 64;
    for (int it = gt; it < DEPTH * 2 * 384 * 16; it += NGT) { const int l = it / (2 * 384 * 16), r = it % (2 * 384 * 16);
        conv_gate(A.in[14] + (size_t)l * 16 * 384, A.in[16] + (size_t)l * 16 * 384, (bfu*)(((unsigned char*)A.in[27]) + WS_W + (size_t)l * W_LAYER + W_IN), r); }
    f32x2* pcs = (f32x2*)(((unsigned char*)A.in[27]) + WS_TAB); f32x2* axcs = (f32x2*)(((unsigned char*)A.in[27]) + WS_TAB_AX);
    for (int it = gt; it < 8192 * 8 + 128 * 16; it += NGT) {
        float c, s;
        if (it < 8192 * 8) { sincos_d((double)(it >> 3) * INV_P[it & 7], c, s); pcs[it] = (f32x2){c, s}; }
        else { const int j = it - 8192 * 8; sincos_d((double)(j >> 4) * INV_AX[j & 15], c, s); axcs[j] = (f32x2){c, s}; }
    }
    if (blockIdx.x == 0 && F.wave == 0) {
#pragma unroll
        for (int l = 0; l < DEPTH; ++l) {
            const float a = wave_sum(A.in[9][l * 64 + F.lane] * A.in[10][l * 64 + F.lane], F.lane), b = wave_sum(A.in[11][l * 64 + F.lane] * A.in[12][l * 64 + F.lane], F.lane);
            const float lam_init = 0.8f - 0.6f * expf(-0.3f * (float)l);
            if (F.lane == 0) F.ctl[CW_LAM + l] = __builtin_bit_cast(unsigned, expf(a) - expf(b) + lam_init);
        }
    }
}

DI void cast_rows(Frame& F0, const float* x, bfu* xb, unsigned long long* rss) {
    Frame F = F0; F.tid = threadIdx.x; asm volatile("" : "+v"(F.tid), "+s"(F.wave), "+s"(F.vcu), "+s"(F.G)); F.lane = F.tid & 63;
    const int gw = F.vcu * NWAVES + F.wave, NGW = F.G * NWAVES;
    for (int m = gw; m < CH; m += NGW) {
        const f32x4* xr = (const f32x4*)(x + (size_t)m * DM) + F.lane;
        f32x4 v[8]; float s = 0.f;
#pragma unroll
        for (int j = 0; j < 8; ++j) { v[j] = xr[64 * j]; s += (v[j].x * v[j].x + v[j].y * v[j].y) + (v[j].z * v[j].z + v[j].w * v[j].w); }
        s = wave_sum(s, F.lane);
        u32x2* o8 = (u32x2*)(xb + (size_t)m * DM) + F.lane;
#pragma unroll
        for (int j = 0; j < 8; ++j) { u32x2 w; w.x = pk2(v[j].x, v[j].y); w.y = pk2(v[j].z, v[j].w); o8[64 * j] = w; }
        if (F.lane == 0) rss[m] = (unsigned long long)(s * 16777216.0f);
    }
}
DI void norm_cast_rows(Frame& F0, bfu* xb, const unsigned long long* rss_fin, const float* gain, float* yout, const float* xnext, unsigned long long* rss0) {
    Frame F = F0; F.tid = threadIdx.x; asm volatile("" : "+v"(F.tid), "+s"(F.wave), "+s"(F.vcu), "+s"(F.G)); F.lane = F.tid & 63;
    const int gw = F.vcu * NWAVES + F.wave, NGW = F.G * NWAVES;
    for (int m = gw; m < CH; m += NGW) {
        { const u32x4* xr = (const u32x4*)(xb + (size_t)m * DM) + F.lane;
          u32x4 v[4];
#pragma unroll
          for (int j = 0; j < 4; ++j) v[j] = xr[64 * j];
          const unsigned long long raw = __hip_atomic_load((const GAS unsigned long long*)(rss_fin + m), RLX_AGENT);
          const float rstd = 1.0f / sqrtf((float)raw * (1.0f / 16777216.0f) * (1.f / DM) + EPS);
          f32x4* yr = (f32x4*)(yout + (size_t)m * DM) + 2 * F.lane;
#pragma unroll
          for (int j = 0; j < 4; ++j) { const f32x4 g0 = ((const f32x4*)gain)[2 * (F.lane + 64 * j)], g1 = ((const f32x4*)gain)[2 * (F.lane + 64 * j) + 1];
              const f32x4 a = {bflo(v[j].x), bfhi(v[j].x), bflo(v[j].y), bfhi(v[j].y)}, b = {bflo(v[j].z), bfhi(v[j].z), bflo(v[j].w), bfhi(v[j].w)};
              yr[128 * j] = a * rstd * g0; yr[128 * j + 1] = b * rstd * g1; } }
        if (xnext) {
            asm volatile("" ::: "memory");
            const f32x4* xr = (const f32x4*)(xnext + (size_t)m * DM) + F.lane;
            f32x4 v[8]; float s = 0.f;
#pragma unroll
            for (int j = 0; j < 8; ++j) { v[j] = xr[64 * j]; s += (v[j].x * v[j].x + v[j].y * v[j].y) + (v[j].z * v[j].z + v[j].w * v[j].w); }
            s = wave_sum(s, F.lane);
            u32x2* o8 = (u32x2*)(xb + (size_t)m * DM) + F.lane;
#pragma unroll
            for (int j = 0; j < 8; ++j) { u32x2 w; w.x = pk2(v[j].x, v[j].y); w.y = pk2(v[j].z, v[j].w); o8[64 * j] = w; }
            if (F.lane == 0) rss0[m] = (unsigned long long)(s * 16777216.0f);
        }
    }
}

DI void clow_rows(Frame& F0, const bfu* XB, const unsigned long long* rss, const bfu* Wl, const bfu* GT, bfu* Uo, int R0) {
    Frame F = F0; F.tid = threadIdx.x; asm volatile("" : "+v"(F.tid), "+s"(F.wave)); F.lane = F.tid & 63;
    const int lane = F.lane, r32 = lane & 31, hi = lane >> 5, w = F.wave;
    LAS float* red = (LAS float*)F.lds;
    LAS float* cls = (LAS float*)(F.lds + 65536);
    { f32x16 acc[2] = {{}, {}};
      const bfu* a0 = XB + (size_t)(R0 + r32) * DM + 256 * w + 8 * hi; const bfu* a1 = a0 + (size_t)32 * DM; const bfu* bp = Wl + (size_t)r32 * DM + 256 * w + 8 * hi;
#pragma unroll
      for (int sb = 0; sb < 4; ++sb) { bf16x8 fa0[4], fa1[4], fb[4];
#pragma unroll
          for (int s = 0; s < 4; ++s) { const int k = 16 * (4 * sb + s); fa0[s] = *(const bf16x8*)(a0 + k); fa1[s] = *(const bf16x8*)(a1 + k); fb[s] = *(const bf16x8*)(bp + k); }
#pragma unroll
          for (int s = 0; s < 4; ++s) { acc[0] = MFMA32(fa0[s], fb[s], acc[0]); acc[1] = MFMA32(fa1[s], fb[s], acc[1]); } }
#pragma unroll
      for (int rb = 0; rb < 2; ++rb)
#pragma unroll
          for (int r = 0; r < 16; ++r) red[((w * 2 + rb) * 16 + r) * 64 + lane] = acc[rb][r]; }
    __syncthreads();
#pragma unroll
    for (int q = 0; q < 4; ++q) { const int o = F.tid + 512 * q, ol = o & 63, rr = (o >> 6) & 15, rb = o >> 10; float sum = 0.f;
#pragma unroll
        for (int ww = 0; ww < 8; ++ww) sum += red[ww * 2048 + o];
        const int row = 32 * rb + crow(rr, ol >> 5), col = ol & 31;
        const unsigned long long raw = __hip_atomic_load((const GAS unsigned long long*)(rss + R0 + row), RLX_AGENT);
        cls[row * 33 + col] = sum * (1.0f / sqrtf((float)raw * (1.0f / 16777216.0f) * (1.f / DM) + EPS)); }
    __syncthreads();
#pragma unroll
    for (int cc = 0; cc < 3; ++cc) { const int cb = 3 * w + cc, dir = cb / 12, n0 = 32 * (cb % 12);
        const bf16x8 gf = *(const bf16x8*)(GT + (size_t)(dir * 384 + n0 + r32) * 16 + 8 * hi);
#pragma unroll
        for (int rb = 0; rb < 2; ++rb) { const LAS float* cp = cls + (32 * rb + r32) * 33 + 16 * dir + 8 * hi;
            u32x4 yw; yw.x = pk2(cp[0], cp[1]); yw.y = pk2(cp[2], cp[3]); yw.z = pk2(cp[4], cp[5]); yw.w = pk2(cp[6], cp[7]);
            f32x16 d = {}; d = MFMA32(gf, __builtin_bit_cast(bf16x8, yw), d);
            bfu* op = Uo + (size_t)(R0 + 32 * rb + r32) * NU + 6912 + dir * 384 + n0 + 4 * hi;
#pragma unroll
            for (int g = 0; g < 4; ++g) { u32x2 v; v.x = pk2(d[4 * g], d[4 * g + 1]); v.y = pk2(d[4 * g + 2], d[4 * g + 3]); *(u32x2*)(op + 8 * g) = v; } } }
    __syncthreads();
}

#define BW_SWZ(row, col) ((row) * 64 + ((((col) >> 3) ^ ((row) & 7)) << 3) + ((col) & 7))
DI void bwin_task(const bfu* U, int seqrow0, int L, int hb, int dil, int idx, bfu* Bo, float* Bl, LAS unsigned char* wl, LAS float* lsc, int lane) {
    asm volatile("" : "+v"(lane));
    const int N = L / dil, qb = idx / dil, rr = idx % dil;
    const int r32 = lane & 31, hi = lane >> 5, q4 = (lane & 15) >> 2, g16 = (lane >> 4) & 1, p4 = lane & 3, il = lane >> 3, dc = lane & 7;
    const bfu* Qc = U + U_BQ + hb * 64; const bfu* Kc = U + U_BK + hb * 64; const bfu* Vc = U + U_BV + hb * 64 + 8 * (dc ^ il);
    const int kbase = 64 * (qb - 1);
    const unsigned lds0 = (unsigned)(size_t)wl;
#define B_ROW(sub) ((size_t)(seqrow0 + (sub) * dil + rr))
#define B_DMA(g, buf) do { _Pragma("unroll") for (int b_ = 0; b_ < 8; ++b_) { int kp_ = kbase + 64 * (g) + 8 * b_ + il; kp_ = kp_ < 0 ? 0 : (kp_ > N - 1 ? N - 1 : kp_); \
        attn_body::glds16(Vc + B_ROW(kp_) * NU, (unsigned)__builtin_amdgcn_readfirstlane(lds0 + (buf) * 8192 + b_ * 1024)); } } while (0)
    B_DMA(0, 0); B_DMA(1, 1);
    bf16x8 pf[2][5][2];
#define BW_MASK(A, KBI, KB) do { \
          \
        if ((KBI) == 0) { _Pragma("unroll") for (int i = 0; i < 16; ++i) A[i] = (crow(i, hi) >= r32) ? A[i] : -1e30f; } \
        if ((KBI) == 4) { _Pragma("unroll") for (int i = 0; i < 16; ++i) A[i] = (crow(i, hi) <= r32) ? A[i] : -1e30f; } \
        const int kb0_ = kbase + 32 * (KB); \
        if (kb0_ < 0 || kb0_ >= N) { _Pragma("unroll") for (int i = 0; i < 16; ++i) A[i] = -1e30f; } } while (0)
#define BW_SOFTMAX(tb, SC) do { float m = SC[0][0]; \
        _Pragma("unroll") for (int kbi = 0; kbi < 5; ++kbi) _Pragma("unroll") for (int i = 0; i < 16; ++i) m = fmaxf(m, SC[kbi][i]); \
        m = fmaxf(m, lane_get(m, lane ^ 32)); float l = 0.f; \
        _Pragma("unroll") for (int kbi = 0; kbi < 5; ++kbi) _Pragma("unroll") for (int i = 0; i < 16; ++i) { const float p = __builtin_amdgcn_exp2f(SC[kbi][i] - m); SC[kbi][i] = p; l += p; } \
        l += lane_get(l, lane ^ 32); \
        _Pragma("unroll") for (int kbi = 0; kbi < 5; ++kbi) { pf[tb][kbi][0] = pack8(SC[kbi], 0); pf[tb][kbi][1] = pack8(SC[kbi], 1); } \
        if (hi == 0) { lsc[32 * (tb) + r32] = l; Bl[B_ROW(64 * qb + 32 * (tb) + r32) * 12 + hb] = m + __builtin_amdgcn_logf(l); }   } while (0)
    { bf16x8 qf[2][4];
#pragma unroll
      for (int tb = 0; tb < 2; ++tb) { const bfu* qp = Qc + B_ROW(64 * qb + 32 * tb + r32) * NU + 8 * hi;
#pragma unroll
          for (int st = 0; st < 4; ++st) qf[tb][st] = *(const bf16x8*)(qp + 16 * st); }
      f32x16 sc0[5], sc1[5];
#pragma unroll
      for (int kb = 0; kb < 6; ++kb) {
          int kp = kbase + 32 * kb + r32; kp = kp < 0 ? 0 : (kp > N - 1 ? N - 1 : kp);
          const bfu* kr = Kc + B_ROW(kp) * NU + 8 * hi;
          const bf16x8 k0 = *(const bf16x8*)(kr), k1 = *(const bf16x8*)(kr + 16), k2 = *(const bf16x8*)(kr + 32), k3 = *(const bf16x8*)(kr + 48);
          if (kb <= 4) { f32x16 a = {}; a = MFMA32(k0, qf[0][0], a); a = MFMA32(k1, qf[0][1], a); a = MFMA32(k2, qf[0][2], a); a = MFMA32(k3, qf[0][3], a); BW_MASK(a, kb, kb); sc0[kb <= 4 ? kb : 0] = a; }
          if (kb >= 1) { f32x16 a = {}; a = MFMA32(k0, qf[1][0], a); a = MFMA32(k1, qf[1][1], a); a = MFMA32(k2, qf[1][2], a); a = MFMA32(k3, qf[1][3], a); BW_MASK(a, kb - 1, kb); sc1[kb >= 1 ? kb - 1 : 0] = a; }
          if (kb == 4) BW_SOFTMAX(0, sc0);
      }
      BW_SOFTMAX(1, sc1); }
#undef BW_MASK
#undef BW_SOFTMAX
    f32x16 o[2][2] = {{{}, {}}, {{}, {}}};
#pragma unroll
    for (int g = 0; g < 3; ++g) {
        if (g == 1) asm volatile("s_waitcnt vmcnt(8)" ::: "memory"); else asm volatile("s_waitcnt vmcnt(0)" ::: "memory");
        const LAS bfu* vv = (const LAS bfu*)(wl + (g & 1) * 8192);
#pragma unroll
        for (int tb = 0; tb < 2; ++tb)
#pragma unroll
            for (int kbl = 0; kbl < 2; ++kbl) { const int kbi = 2 * g + kbl - tb;
                if (kbi >= 0 && kbi <= 4) {
#pragma unroll
                    for (int s2 = 0; s2 < 2; ++s2)
#pragma unroll
                        for (int db = 0; db < 2; ++db) { const LAS bfu* vp = vv + BW_SWZ(32 * kbl + 16 * s2 + 4 * hi + q4, 32 * db + 16 * g16 + 4 * p4);
                            o[tb][db] = MFMA32(pf[tb][kbi][s2], cat8(vtr(vp), vtr(vp + 8 * 64)), o[tb][db]); }
                } }
        LDS_WAIT();
        if (g == 0) B_DMA(2, 0);
    }
#pragma unroll
    for (int tb = 0; tb < 2; ++tb)
#pragma unroll
        for (int i = 0; i < 16; ++i) { const int ql = crow(i, hi); const float inv = __builtin_amdgcn_rcpf(lsc[32 * tb + ql]);
            bfu* op = Bo + B_ROW(64 * qb + 32 * tb + ql) * 768 + hb * 64 + r32;
            op[0] = (bfu)f2bf(o[tb][0][i] * inv); op[32] = (bfu)f2bf(o[tb][1][i] * inv); }
    LDS_WAIT();
#undef B_ROW
#undef B_DMA
}

DI float logsig16(float x) { const float e = __builtin_amdgcn_exp2f(-1.4426950408889634f * fabsf(x)); return (fminf(x, 0.f) - 0.6931471805599453f * __builtin_amdgcn_logf(1.0f + e)) * 0.0625f; }
#define GLA_SWZ(row, col) ((row) * 64 + ((((col) >> 3) ^ ((row) & 7)) << 3) + ((col) & 7))
DI void gla_pre_item(const bfu* U, int seqrow0, int L, int hc, int dir, int c, const float* gbias, bfu* QDi, bfu* KIi, float* DECi, int lane) {
    const int il = lane >> 3, dc = lane & 7;
    const bfu* Qc = U + U_CQ + hc * 64 + 8 * dc; const bfu* Kc = U + U_CK + hc * 64 + 8 * dc; const bfu* Gc = U + (dir ? U_GB : U_GF) + hc * 64 + 8 * dc;
    const f32x4 b0 = *(const f32x4*)(gbias + hc * 64 + 8 * dc), b1 = *(const f32x4*)(gbias + hc * 64 + 8 * dc + 4);
    const float bias8[8] = {b0.x, b0.y, b0.z, b0.w, b1.x, b1.y, b1.z, b1.w};
#define G_ROW(p) ((size_t)(seqrow0 + (dir ? (L - 1 - (p)) : (p))))
    u32x4 aq[8], ak[8], ag[8];
#pragma unroll
    for (int bt = 0; bt < 8; ++bt) { const size_t rw = G_ROW(64 * c + 8 * bt + il) * NU; aq[bt] = *(const u32x4*)(Qc + rw); ak[bt] = *(const u32x4*)(Kc + rw); ag[bt] = *(const u32x4*)(Gc + rw); }
    float carry[8];
#pragma unroll
    for (int e = 0; e < 8; ++e) carry[e] = 0.f;
#pragma unroll
    for (int bt = 0; bt < 8; ++bt) {
        const u32x4 cq = aq[bt], ck = ak[bt], cg = ag[bt];
        float cum[8];
#pragma unroll
        for (int w = 0; w < 4; ++w) { cum[2 * w] = logsig16(bflo(cg[w]) + bias8[2 * w]); cum[2 * w + 1] = logsig16(bfhi(cg[w]) + bias8[2 * w + 1]); }
#pragma unroll
        for (int e = 0; e < 8; ++e) { float t = cum[e]; float y = lane_get(t, lane - 8); if (il >= 1) t += y; y = lane_get(t, lane - 16); if (il >= 2) t += y; y = lane_get(t, lane - 32); if (il >= 4) t += y; cum[e] = carry[e] + t; }
#pragma unroll
        for (int e = 0; e < 8; ++e) carry[e] = lane_get(cum[e], 56 + dc);
        u32x4 oq, ok;
#pragma unroll
        for (int w = 0; w < 4; ++w) {
            const float e0 = __builtin_amdgcn_exp2f(1.4426950408889634f * cum[2 * w]), e1 = __builtin_amdgcn_exp2f(1.4426950408889634f * cum[2 * w + 1]);
            oq[w] = pk2(bflo(cq[w]) * (0.125f * e0), bfhi(cq[w]) * (0.125f * e1));
            ok[w] = pk2(bflo(ck[w]) * __builtin_amdgcn_rcpf(e0), bfhi(ck[w]) * __builtin_amdgcn_rcpf(e1)); }
        const int off = (8 * bt + il) * 64 + 8 * (dc ^ il);
        *(u32x4*)(QDi + off) = oq; *(u32x4*)(KIi + off) = ok;
    }
    if (il == 0) { f32x4 d0, d1;
#pragma unroll
        for (int e = 0; e < 4; ++e) { d0[e] = __builtin_amdgcn_exp2f(1.4426950408889634f * carry[e]); d1[e] = __builtin_amdgcn_exp2f(1.4426950408889634f * carry[4 + e]); }
        *(f32x4*)(DECi + 8 * dc) = d0; *(f32x4*)(DECi + 8 * dc + 4) = d1; }
#undef G_ROW
}
DI void gla_pre_rows(Frame& F0, const bfu* U, int L, const float* bias_f, const float* bias_b, bfu* QD, bfu* KI, float* DEC) {
    Frame F = F0; F.tid = threadIdx.x; asm volatile("" : "+v"(F.tid), "+s"(F.wave), "+s"(F.vcu), "+s"(F.G)); F.lane = F.tid & 63;
    const int gw = F.vcu * NWAVES + F.wave, NGW = F.G * NWAVES, NC = L >> 6;
    for (int it = gw; it < (CH / 64) * 12; it += NGW) {
        const int c = it % NC, dir = (it / NC) & 1, hc = (it / (2 * NC)) % 6, sq = it / (12 * NC);
        gla_pre_item(U, sq * L, L, hc, dir, c, dir ? bias_b : bias_f, QD + (size_t)it * 4096, KI + (size_t)it * 4096, DEC + (size_t)it * 64, F.lane);
    }
}
DI void gla_task(const bfu* U, int seqrow0, int L, int hc, int dir, int half, const bfu* QD, const bfu* KI, const float* DEC, int item0, bfu* Oc, LAS unsigned char* wl, int lane) {
    asm volatile("" : "+v"(lane));
    const int r32 = lane & 31, hi = lane >> 5, q4 = (lane & 15) >> 2, g16 = (lane >> 4) & 1, p4 = lane & 3, il = lane >> 3, dc = lane & 7;
    LAS float* decl = (LAS float*)(wl + 49152);
    const bfu* Vc = U + U_CV + hc * 128 + half * 64 + 8 * (dc ^ il);
    f32x16 S[2][2] = {{{}, {}}, {{}, {}}};
    const int NC = L >> 6;
#define G_ROW(p) ((size_t)(seqrow0 + (dir ? (L - 1 - (p)) : (p))))
    const unsigned lds0 = (unsigned)(size_t)wl;
#define G_DMA(cc) do { const unsigned lb_ = lds0 + ((cc) & 1) * 24576; const bfu* qs_ = QD + (size_t)(item0 + (cc)) * 4096 + lane * 8; const bfu* ks_ = KI + (size_t)(item0 + (cc)) * 4096 + lane * 8; \
        _Pragma("unroll") for (int b_ = 0; b_ < 8; ++b_) { attn_body::glds16(qs_ + b_ * 512, (unsigned)__builtin_amdgcn_readfirstlane(lb_ + b_ * 1024)); attn_body::glds16(ks_ + b_ * 512, (unsigned)__builtin_amdgcn_readfirstlane(lb_ + 8192 + b_ * 1024)); \
            attn_body::glds16(Vc + G_ROW(64 * (cc) + 8 * b_ + il) * NU, (unsigned)__builtin_amdgcn_readfirstlane(lb_ + 16384 + b_ * 1024)); } } while (0)
    G_DMA(0);
    float dnext = DEC[(size_t)item0 * 64 + lane];
    for (int c = 0; c < NC; ++c) {
        asm volatile("s_waitcnt vmcnt(0)" ::: "memory");
        decl[lane] = dnext;
        if (c + 1 < NC) { G_DMA(c + 1); dnext = DEC[(size_t)(item0 + c + 1) * 64 + lane]; }
        const LAS bfu* qd = (const LAS bfu*)(wl + (c & 1) * 24576); const LAS bfu* ki = qd + 4096; const LAS bfu* vv = qd + 8192;
        LDS_WAIT();
        bf16x8 xf[3][2];
#pragma unroll
        for (int blk = 0; blk < 3; ++blk) { const int sb = blk == 2 ? 1 : 0, tb = blk >= 1 ? 1 : 0;
            f32x16 a = {};
#pragma unroll
            for (int st = 0; st < 4; ++st) { const bf16x8 af = *(const LAS bf16x8*)(ki + GLA_SWZ(32 * sb + r32, 16 * st + 8 * hi)); const bf16x8 bf = *(const LAS bf16x8*)(qd + GLA_SWZ(32 * tb + r32, 16 * st + 8 * hi));
                a = MFMA32(af, bf, a); }
            if (sb == tb) {
#pragma unroll
                for (int i = 0; i < 16; ++i) a[i] = (crow(i, hi) <= r32) ? a[i] : 0.f; }
            xf[blk][0] = pack8(a, 0); xf[blk][1] = pack8(a, 1); }
#pragma unroll
        for (int tb = 0; tb < 2; ++tb)
#pragma unroll
            for (int eb = 0; eb < 2; ++eb) {
                f32x16 o = {};
#pragma unroll
                for (int sb = 0; sb < 2; ++sb) { if (sb <= tb) { const int blk = sb == 0 ? tb : 2;
#pragma unroll
                    for (int s2 = 0; s2 < 2; ++s2) { const LAS bfu* vp = vv + GLA_SWZ(32 * sb + 16 * s2 + 4 * hi + q4, 32 * eb + 16 * g16 + 4 * p4);
                        o = MFMA32(xf[blk][s2], cat8(vtr(vp), vtr(vp + 8 * 64)), o); } } }
#pragma unroll
                for (int db = 0; db < 2; ++db)
#pragma unroll
                    for (int s2 = 0; s2 < 2; ++s2) { const int qrow = 32 * tb + r32, qcol = 32 * db + 16 * s2 + 4 * hi;
                        const bf16x8 af = cat8(*(const LAS s16x4*)(qd + GLA_SWZ(qrow, qcol)), *(const LAS s16x4*)(qd + GLA_SWZ(qrow, qcol + 8)));
                        o = MFMA32(af, pack8(S[db][eb], s2), o); }
#pragma unroll
                for (int i = 0; i < 16; i += 2) { const unsigned w = pk2(o[i], o[i + 1]);
                    Oc[G_ROW(64 * c + 32 * tb + crow(i, hi)) * 768 + hc * 128 + half * 64 + 32 * eb + r32] = (bfu)(w & 0xffffu); Oc[G_ROW(64 * c + 32 * tb + crow(i + 1, hi)) * 768 + hc * 128 + half * 64 + 32 * eb + r32] = (bfu)(w >> 16); }
            }
#pragma unroll
        for (int db = 0; db < 2; ++db)
#pragma unroll
            for (int eb = 0; eb < 2; ++eb) {
#pragma unroll
                for (int st = 0; st < 4; ++st) { const int srow = 16 * st + 8 * hi + q4, kcol = 32 * db + 16 * g16 + 4 * p4, vcol = 32 * eb + 16 * g16 + 4 * p4;
                    S[db][eb] = MFMA32(cat8(vtr(ki + GLA_SWZ(srow, kcol)), vtr(ki + GLA_SWZ(srow + 4, kcol))), cat8(vtr(vv + GLA_SWZ(srow, vcol)), vtr(vv + GLA_SWZ(srow + 4, vcol))), S[db][eb]); }
#pragma unroll
                for (int i = 0; i < 16; ++i) S[db][eb][i] *= decl[32 * db + crow(i, hi)];
            }
        LDS_WAIT();
    }
#undef G_ROW
#undef G_DMA
}

DI void finalize_rows(Frame& F0, const float* gain_a, const float* gain_c, int l, const bfu* U, const bfu* OA, const bfu* BO, const float* BL, const bfu* OC, bfu* MIX) {
    Frame F = F0; F.tid = threadIdx.x; asm volatile("" : "+v"(F.tid), "+s"(F.wave), "+s"(F.vcu), "+s"(F.G)); F.lane = F.tid & 63;
    const int lane = F.lane, hl = lane & 31, rsel = lane >> 5;
    const int gw = F.vcu * NWAVES + F.wave, NGW = F.G * NWAVES;
    const float lam = __builtin_bit_cast(float, (unsigned)F.ctl[CW_LAM + l]);
    const float lam_init = 0.8f - 0.6f * expf(-0.3f * (float)l);
    const f32x4 ga = ((const f32x4*)gain_a)[hl], gc = ((const f32x4*)gain_c)[hl];
#define HALF_SUM(v) do { _Pragma("unroll") for (int o_ = 1; o_ < 32; o_ <<= 1) v += lane_get(v, lane ^ o_); } while (0)
    for (int m2 = gw; m2 < CH / 2; m2 += NGW) {
        const size_t m = (size_t)(2 * m2 + rsel);
        u32x2 fw[6], bw[6], g2[6], b0[6], b1[6], b2[6]; float l0[6], l1[6], l2[6];
#pragma unroll
        for (int h = 0; h < 6; ++h) { fw[h] = *(const u32x2*)(OC + m * 768 + h * 128 + 4 * hl); bw[h] = *(const u32x2*)(OC + (size_t)CH * 768 + m * 768 + h * 128 + 4 * hl); g2[h] = *(const u32x2*)(U + m * NU + U_CG + h * 128 + 4 * hl); }
#pragma unroll
        for (int it = 0; it < 6; ++it) { const int h = 2 * it + (hl >> 4), col = h * 64 + 4 * (hl & 15);
            l0[it] = BL[m * 12 + h]; l1[it] = BL[(size_t)CH * 12 + m * 12 + h]; l2[it] = BL[(size_t)2 * CH * 12 + m * 12 + h];
            b0[it] = *(const u32x2*)(BO + m * 768 + col); b1[it] = *(const u32x2*)(BO + (size_t)CH * 768 + m * 768 + col); b2[it] = *(const u32x2*)(BO + (size_t)2 * CH * 768 + m * 768 + col); }
        asm volatile("" ::: "memory");
#pragma unroll
        for (int h = 0; h < 6; ++h) {
            const f32x4 y = {bflo(fw[h].x) + bflo(bw[h].x), bfhi(fw[h].x) + bfhi(bw[h].x), bflo(fw[h].y) + bflo(bw[h].y), bfhi(fw[h].y) + bfhi(bw[h].y)};
            float ss = (y.x * y.x + y.y * y.y) + (y.z * y.z + y.w * y.w); HALF_SUM(ss);
            const float rstd = 1.0f / sqrtf(ss * (1.f / 128.f) + EPS);
            u32x2 o; o.x = pk2(y.x * rstd * gc.x * pg8::silu_f(bflo(g2[h].x)), y.y * rstd * gc.y * pg8::silu_f(bfhi(g2[h].x))); o.y = pk2(y.z * rstd * gc.z * pg8::silu_f(bflo(g2[h].y)), y.w * rstd * gc.w * pg8::silu_f(bfhi(g2[h].y)));
            *(u32x2*)(MIX + m * NMIX + 1536 + h * 128 + 4 * hl) = o; }
#pragma unroll
        for (int it = 0; it < 6; ++it) { const int h = 2 * it + (hl >> 4), col = h * 64 + 4 * (hl & 15);
            const float mx = fmaxf(l0[it], fmaxf(l1[it], l2[it])); const float w0 = __builtin_amdgcn_exp2f(l0[it] - mx), w1 = __builtin_amdgcn_exp2f(l1[it] - mx), w2 = __builtin_amdgcn_exp2f(l2[it] - mx);
            const float inv = 1.0f / (w0 + w1 + w2);
            u32x2 o; o.x = pk2((w0 * bflo(b0[it].x) + w1 * bflo(b1[it].x) + w2 * bflo(b2[it].x)) * inv, (w0 * bfhi(b0[it].x) + w1 * bfhi(b1[it].x) + w2 * bfhi(b2[it].x)) * inv);
            o.y = pk2((w0 * bflo(b0[it].y) + w1 * bflo(b1[it].y) + w2 * bflo(b2[it].y)) * inv, (w0 * bfhi(b0[it].y) + w1 * bfhi(b1[it].y) + w2 * bfhi(b2[it].y)) * inv);
            *(u32x2*)(MIX + m * NMIX + 768 + col) = o; }
    }
#undef HALF_SUM
}

__global__ void __launch_bounds__(NWAVES * 64, 2) hybrid_fwd(Args args) {
    extern __shared__ __attribute__((aligned(16))) unsigned char lds[];
    Frame F;
    F.lds = (LAS unsigned char*)lds;
    F.MISC = (volatile LAS unsigned*)(F.lds + MISC_OFF);
    F.tid = 0; F.lane = 0; F.wave = __builtin_amdgcn_readfirstlane((int)threadIdx.x >> 6);
    F.G = gridDim.x; { const int bx = blockIdx.x; F.vcu = (F.G % 8 == 0) ? (bx % 8) * (F.G / 8) + bx / 8 : bx; }
    GAS unsigned char* ws = (GAS unsigned char*)args.in[27];
    F.ctl = (gu32*)(ws + WS_CTL);
    for (int u = threadIdx.x; u < (LDS_BYTES - RING_BYTES) / 4; u += NWAVES * 64) ((LAS unsigned*)(F.lds + RING_BYTES))[u] = 0u;
    __syncthreads();
    XcdBarrier bar = xcd_barrier_post((unsigned*)(F.ctl + CW_BAR), F.MISC + 8);
#if defined(PROBE)
#ifndef PROBE_BLK
#define PROBE_BLK 0
#endif
#ifdef PROBE_CYC
#define PROBE_NOW() (__builtin_readcyclecounter() / 20)
#else
#define PROBE_NOW() __builtin_amdgcn_s_memrealtime()
#endif
#define PROBE_MARK(bit) do { if (((PROBE) >> (bit)) & 1) { if (blockIdx.x == PROBE_BLK && threadIdx.x == 0) { const unsigned long long t_ = PROBE_NOW(); F.MISC[16] = (unsigned)t_; F.MISC[17] = (unsigned)(t_ >> 32); } } } while (0)
#define PROBE_ACC(bit) do { if (((PROBE) >> (bit)) & 1) { if (blockIdx.x == PROBE_BLK && threadIdx.x == 0) { const unsigned long long t_ = PROBE_NOW(); const unsigned long long m_ = ((unsigned long long)F.MISC[17] << 32) | F.MISC[16]; \
        unsigned long long a_ = ((unsigned long long)F.MISC[19] << 32) | F.MISC[18]; a_ += t_ - m_; F.MISC[18] = (unsigned)a_; F.MISC[19] = (unsigned)(a_ >> 32); } } } while (0)
#define PROBE_MARK2(bit) do { if (((PROBE) >> (bit)) & 1) { if (blockIdx.x == PROBE_BLK && threadIdx.x == 0) { const unsigned long long t_ = __builtin_amdgcn_s_memrealtime(); F.MISC[20] = (unsigned)t_; F.MISC[21] = (unsigned)(t_ >> 32); } } } while (0)
#define PROBE_ACC2(bit) do { if (((PROBE) >> (bit)) & 1) { if (blockIdx.x == PROBE_BLK && threadIdx.x == 0) { const unsigned long long t_ = __builtin_amdgcn_s_memrealtime(); const unsigned long long m_ = ((unsigned long long)F.MISC[21] << 32) | F.MISC[20]; \
        unsigned long long a_ = ((unsigned long long)F.MISC[19] << 32) | F.MISC[18]; a_ += t_ - m_; F.MISC[18] = (unsigned)a_; F.MISC[19] = (unsigned)(a_ >> 32); } } } while (0)
#else
#define PROBE_MARK(bit) do {} while (0)
#define PROBE_ACC(bit) do {} while (0)
#define PROBE_MARK2(bit) do {} while (0)
#define PROBE_ACC2(bit) do {} while (0)
#endif
    int zz = 0;
#define AIN(i) (args.in[(i) + zz])
#define BXO ({ int b_ = (int)blockIdx.x; asm volatile("" : "+s"(b_)); b_; })
#define BXO_G ({ int g_ = F.G; asm volatile("" : "+s"(g_)); g_; })
#define GRID_BAR() do { PROBE_MARK2(14); xcd_barrier(bar); PROBE_ACC2(14); asm volatile("" : "+s"(ws), "+s"(l), "+s"(c), "+s"(zz)); } while (0)

#define XN ((bfu*)(ws + WS_XN))
#define U ((bfu*)(ws + WS_U))
#define HID ((bfu*)(ws + WS_U))
#define MIX ((bfu*)(ws + WS_MIX))
#define OA ((bfu*)(ws + WS_OA))
#define BO ((bfu*)(ws + WS_BO))
#define BL ((float*)(ws + WS_BL))
#define OC ((bfu*)(ws + WS_OC))
#define RSS(j) ((unsigned long long*)(ws + WS_RSS) + (size_t)(c * 7 + (j)) * CH)
#define YCH ((unsigned char*)AIN(26) + (size_t)c * CH * DM * 4)
#define GQD ((bfu*)YCH)
#define GKI ((bfu*)(YCH + 25165824))
#define GDEC ((float*)(YCH + 50331648))
#define pcs ((const f32x2*)(ws + WS_TAB))
#define axcs ((const f32x2*)(ws + WS_TAB_AX))
#define WL ((const bfu*)(ws + WS_W + (size_t)l * W_LAYER))
#define XSRC(cc) (((cc) < 2) ? AIN(0) + (size_t)(cc) * CH * DM : AIN(1) + (size_t)((cc) - 2) * CH * DM)
#define L ((c < 2) ? 8192 : 2048)
#define nseq (CH / L)

    PROBE_MARK(8);
#ifndef NO_PRO
    p0_prologue(F, args);
#endif
    { int c = 0, l = 0;
      cast_rows(F, XSRC(0), XN, RSS(0));
      GRID_BAR(); }
    PROBE_ACC(8);
    for (int c = 0; c < NCHUNK; ++c) {
        int l = 0;
        for (l = 0; l < DEPTH; ++l) {

            PROBE_MARK(0);
            { pg8::Gemm g{XN, WL + W_GU1 / 2, CH, 2 * DFF, DM}; pg8::StaticOrder S; S.init(CH, 2 * DFF, BXO_G, BXO);
              pg8::EpiSwigluN E{HID, DFF, RSS(3 * l)};
              pg8::gemm_phase<pg8::EpiSwigluN, pg8::StaticOrder, true, true>(F.lds, g, S, E); }
            GRID_BAR();
            PROBE_ACC(0);
            PROBE_MARK(1);
            { pg8::Gemm g{HID, WL + W_D1 / 2, CH, DM, DFF}; pg8::StaticOrder S; S.init(CH, DM, BXO_G, BXO);
              pg8::EpiResidN<true> E{XN, DM, RSS(3 * l + 1)};
              pg8::gemm_phase<pg8::EpiResidN<true>, pg8::StaticOrder, true, true>(F.lds, g, S, E); }
            GRID_BAR();
            PROBE_ACC(1);

            PROBE_MARK(2);
            for (int R0 = 64 * BXO; R0 < CH; R0 += 64 * BXO_G) clow_rows(F, XN, RSS(3 * l + 1), WL + W_IN / 2 + (size_t)6912 * DM, WL + W_IN / 2 + (size_t)6944 * DM, U, R0);
            { pg8::Gemm g{XN, WL + W_IN / 2, CH, NU, DM}; pg8::SkipOrder S; S.S.init(CH, NU - 768, BXO_G, BXO);
              pg8::EpiPrepN E{U, NU, RSS(3 * l + 1), L - 1, (const float*)pcs, (const float*)axcs, AIN(19) + l * 64, AIN(20) + l * 64, (LAS float*)(F.lds + 132096), F.lds + 140288};
              pg8::gemm_phase<pg8::EpiPrepN, pg8::SkipOrder, true, true>(F.lds, g, S, E); }
            GRID_BAR();
            PROBE_ACC(2);
            PROBE_MARK(4);
            gla_pre_rows(F, U, L, AIN(15) + l * 384, AIN(17) + l * 384, GQD, GKI, GDEC);
            GRID_BAR();
            PROBE_ACC(4);

            PROBE_MARK(5);
            {
                gu32* qh = F.ctl + CW_Q + 64 * ((l * NCHUNK + c) * 4);
#define DEQUEUE(kind, var) do { if (threadIdx.x == 0) F.MISC[0] = __hip_atomic_fetch_add(qh + 64 * (kind), 1u, RLX_AGENT); __syncthreads(); var = (int)F.MISC[0]; __syncthreads(); } while (0)
#define DEQ_ISSUE(kind) do { if (threadIdx.x == 0) pend = __hip_atomic_fetch_add(qh + 64 * (kind), 1u, RLX_AGENT); } while (0)
#define DEQ_TAKE(var) do { if (threadIdx.x == 0) F.MISC[0] = pend; __syncthreads(); var = (int)F.MISC[0]; __syncthreads(); } while (0)
                const int n_gla = nseq * 24 / 2;
                PROBE_MARK(10);
                {
                for (;;) { int un; DEQUEUE(0, un); if (un >= n_gla) break;

                    if (F.wave < 2) { const int task = un * 2 + F.wave, half = task & 1, dir = (task >> 1) & 1, hc = (task >> 2) % 6, sq = task / 24;
#ifndef NO_GLA
                        gla_task(U, sq * L, L, hc, dir, half, GQD, GKI, GDEC, ((sq * 6 + hc) * 2 + dir) * (L >> 6), OC + (size_t)dir * CH * 768, F.lds + F.wave * 50176, (int)(threadIdx.x & 63));
#endif
 }
                } }
                PROBE_ACC(10); PROBE_MARK(11);
                const int nqb = L / 256, n_aa = nseq * 6 * nqb;
                { const float lam_a = __builtin_bit_cast(float, (unsigned)F.ctl[CW_LAM + l]), sc_a = 1.0f - (0.8f - 0.6f * expf(-0.3f * (float)l));
                for (;;) { int un; DEQUEUE(1, un); if (un >= n_aa) break;
                    const int sq = un / (6 * nqb), rem = un % (6 * nqb), a = rem / nqb, qb = rem % nqb;
                    const size_t r0 = (size_t)sq * L;
#ifndef NO_ATT
                    attn_av::attn_unit_v<8, 1>((const attn_body::bf16*)(U + (r0 + (size_t)qb * 256) * NU + U_AQ + a * 128), (const attn_body::bf16*)(U + r0 * NU + U_AK + a * 128),
                                            (const attn_body::bf16*)(U + r0 * NU + U_AV + a * 128), (attn_body::bf16*)nullptr, 0, L / 64, (char*)lds, 0.f, nullptr, 0.f);
                    attn_av::attn_unit_v<8, 2>((const attn_body::bf16*)(U + (r0 + (size_t)qb * 256) * NU + U_AQ + a * 128 + 64), (const attn_body::bf16*)(U + r0 * NU + U_AK + a * 128 + 64),
                                            (const attn_body::bf16*)(U + r0 * NU + U_AV + a * 128), (attn_body::bf16*)(MIX + (r0 + (size_t)qb * 256) * NMIX + a * 128), NMIX, L / 64, (char*)lds, lam_a, AIN(13) + l * 128, sc_a);
#endif
                } }
                PROBE_ACC(11); PROBE_MARK(12);
                const int n_ad = nseq * 12 * nqb;
                for (;;) { int un; DEQUEUE(3, un); if (un >= n_ad) break;
                    const int sq = un / (12 * nqb), rem = un % (12 * nqb), hq = rem / nqb, qb = rem % nqb;
                    const size_t r0 = (size_t)sq * L;
#ifndef NO_ATT
                    attn_body::attn_unit<8>((const attn_body::bf16*)(U + (r0 + (size_t)qb * 256) * NU + U_DQ + hq * 64), (const attn_body::bf16*)(U + r0 * NU + U_DK + (hq / 3) * 64), (const attn_body::bf16*)(U + r0 * NU + U_DV + (hq / 3) * 64),
                                            (attn_body::bf16*)(MIX + (r0 + (size_t)qb * 256) * NMIX + 2304 + hq * 64), NMIX, L / 64, (char*)lds);
#endif
                }
                PROBE_ACC(12); PROBE_MARK(13);
                const int tps = L / 64, n_b = nseq * 36 * tps / 8;
                { unsigned pend = 0u; DEQ_ISSUE(2);
                for (;;) { int un; DEQ_TAKE(un); if (un >= n_b) break; DEQ_ISSUE(2);
                    const int task = un * 8 + F.wave, idx = task % tps, pat = (task / tps) % 3, hb = (task / (3 * tps)) % 12, sq = task / (36 * tps);
#ifndef NO_B
                    bwin_task(U, sq * L, L, hb, pat == 0 ? 1 : (pat == 1 ? 4 : 16), idx, BO + (size_t)pat * CH * 768, BL + (size_t)pat * CH * 12, F.lds + F.wave * 16384, (LAS float*)(F.lds + 132096) + F.wave * 64, (int)(threadIdx.x & 63));
#endif
                } }
                PROBE_ACC(13);
#undef DEQUEUE
#undef DEQ_ISSUE
#undef DEQ_TAKE
            }
            GRID_BAR();
            PROBE_ACC(5);
            PROBE_MARK(6);
#ifndef NO_FIN
            finalize_rows(F, AIN(13) + l * 128, AIN(18) + l * 128, l, U, OA, BO, BL, OC, MIX);
#endif
            GRID_BAR();
            PROBE_ACC(6);
            PROBE_MARK(3);
            { pg8::Gemm g{MIX, WL + W_OUT / 2, CH, DM, NMIX}; pg8::StaticOrder S; S.init(CH, DM, BXO_G, BXO);
              pg8::EpiResidN<false> E{XN, DM, RSS(3 * l + 2)};
              pg8::gemm_phase<pg8::EpiResidN<false>, pg8::StaticOrder, true, true>(F.lds, g, S, E); }
            GRID_BAR();
            PROBE_ACC(3);

            PROBE_MARK(0);
            { pg8::Gemm g{XN, WL + W_GU2 / 2, CH, 2 * DFF, DM}; pg8::StaticOrder S; S.init(CH, 2 * DFF, BXO_G, BXO);
              pg8::EpiSwigluN E{HID, DFF, RSS(3 * l + 2)};
              pg8::gemm_phase<pg8::EpiSwigluN, pg8::StaticOrder, true, true>(F.lds, g, S, E); }
            GRID_BAR();
            PROBE_ACC(0);
            PROBE_MARK(1);
            { pg8::Gemm g{HID, WL + W_D2 / 2, CH, DM, DFF}; pg8::StaticOrder S; S.init(CH, DM, BXO_G, BXO);
              pg8::EpiResidN<true> E{XN, DM, RSS(3 * l + 3)};
              pg8::gemm_phase<pg8::EpiResidN<true>, pg8::StaticOrder, true, true>(F.lds, g, S, E); }
            GRID_BAR();
            PROBE_ACC(1);
        }
        PROBE_MARK(9);
        norm_cast_rows(F, XN, RSS(6), AIN(25), (float*)YCH, (c + 1 < NCHUNK) ? XSRC(c + 1) : (const float*)nullptr, (unsigned long long*)(ws + WS_RSS) + (size_t)((c + 1) * 7) * CH);
        if (c + 1 < NCHUNK) GRID_BAR();
        PROBE_ACC(9);
    }
#if defined(PROBE)
    if (blockIdx.x == PROBE_BLK && threadIdx.x == 0) {
        unsigned long long a_ = ((unsigned long long)F.MISC[19] << 32) | F.MISC[18];
        const unsigned long long t0_ = __builtin_amdgcn_s_memrealtime();
        while (__builtin_amdgcn_s_memrealtime() - t0_ < a_) __builtin_amdgcn_s_sleep(8);
    }
#endif
}
#undef AIN
#undef XN
#undef U
#undef HID
#undef MIX
#undef OA
#undef BO
#undef BL
#undef OC
#undef RSS
#undef GQD
#undef GKI
#undef GDEC
#undef pcs
#undef axcs
#undef WL
#undef XSRC
#undef YCH
#undef L
#undef nseq

extern "C" void kernel_launch(void* const* d_in, const int* in_sizes, int n_in, void* d_out, int out_size, void* d_ws, size_t ws_size, hipStream_t stream) {
    static int grid = 0;
    if (grid == 0) {
        if (n_in != 26 || out_size != NTOK * DM || ws_size < WS_END) { fprintf(stderr, "kernel_launch: built for 26 inputs, %d outputs, >= %zu bytes of workspace; got n_in %d, out %d, ws %zu; nothing launched\n", NTOK * DM, (size_t)WS_END, n_in, out_size, ws_size); grid = -1; return; }
        int dev = 0, cus = 0, per_cu = 0;
        if (hipGetDevice(&dev) != hipSuccess || hipDeviceGetAttribute(&cus, hipDeviceAttributeMultiprocessorCount, dev) != hipSuccess) { fprintf(stderr, "kernel_launch: device query failed\n"); grid = -1; return; }
        if (hipFuncSetAttribute((const void*)hybrid_fwd, hipFuncAttributeMaxDynamicSharedMemorySize, LDS_BYTES) != hipSuccess) { fprintf(stderr, "kernel_launch: hipFuncSetAttribute failed\n"); grid = -1; return; }
        if (hipOccupancyMaxActiveBlocksPerMultiprocessor(&per_cu, (const void*)hybrid_fwd, NWAVES * 64, LDS_BYTES) != hipSuccess || per_cu < 1)
            fprintf(stderr, "kernel_launch: note: occupancy query reports %d workgroups per CU\n", per_cu);
        (void)hipGetLastError();
        grid = cus;
    }
    if (grid < 0) return;
    if (hipMemsetAsync((char*)d_ws + WS_CTL, 0, CTL_ZERO_BYTES, stream) != hipSuccess) { fprintf(stderr, "kernel_launch: hipMemsetAsync failed\n"); return; }
    Args a{};
    for (int i = 0; i < 26; ++i) a.in[i] = (const float*)d_in[i];
    a.in[26] = (const float*)d_out; a.in[27] = (const float*)d_ws;
    hipLaunchKernelGGL(hybrid_fwd, dim3(grid), dim3(NWAVES * 64), LDS_BYTES, stream, a);
    const hipError_t le = hipPeekAtLastError();
    if (le != hipSuccess) fprintf(stderr, "kernel_launch: launch failed: %s\n", hipGetErrorName(le));
}
```

```cpp
#include <hip/hip_runtime.h>
#include <hip/hip_bf16.h>
#include <cstdio>
#include <cstdint>
#include <cmath>
namespace pg8 {
#define PG8_LAS __attribute__((address_space(3)))
typedef unsigned short bf16_t;
typedef short bf16x8 __attribute__((ext_vector_type(8)));
typedef float f32x4 __attribute__((ext_vector_type(4)));
typedef unsigned u32x4 __attribute__((ext_vector_type(4)));
constexpr int BM = 256, BK = 64, HALF = 128, HTB = HALF * BK * 2  , STAGE_BYTES = 8 * HTB, NXCD = 8, WGM = 8;

__host__ __device__ __forceinline__ int lds_byte(int r, int c) { const int st = (r >> 4) * 2 + (c >> 5), rr = r & 15, cc = c & 31, ob = rr * 64 + cc * 2; return st * 1024 + (ob ^ (((ob >> 9) & 1) << 5)); }
__host__ __device__ __forceinline__ void stage_rc(int b, int& R, int& C) { const int st = b / 1024, sb = b % 1024, swz = sb ^ (((sb >> 9) & 1) << 5); R = (st >> 1) * 16 + swz / 64; C = (st & 1) * 32 + (swz % 64) / 2; }
__host__ __device__ __forceinline__ int perm32(int rho) { const int n = rho >> 4, i = rho & 15; return 8 * (i >> 2) + 4 * n + (i & 3); }

struct Unit { int pm, pn; };
struct Gemm { const bf16_t* A; const bf16_t* Bt; int M, N, K; };

struct StaticOrder {
    int nM, nN, nwg, G, c;
    __host__ __device__ void init(int M, int N, int G_, int c_) { nM = M / BM; nN = N / BM; nwg = nM * nN; G = G_; c = c_; }
    __host__ __device__ bool next(int i, Unit& u) const {
        const long L = (long)i * G + c; if (L >= nwg) return false;
        int wgid = (int)L; { const int q = nwg / NXCD, r = nwg % NXCD, xcd = wgid % NXCD, off = wgid / NXCD; wgid = (xcd < r ? xcd * (q + 1) : r * (q + 1) + (xcd - r) * q) + off; }
        const int nig = WGM * nN, gid = wgid / nig, fm = gid * WGM, gsz = (nM - fm) < WGM ? (nM - fm) : WGM;
        u.pm = fm + ((wgid % nig) % gsz); u.pn = (wgid % nig) / gsz; return true;
    }
    __device__ __forceinline__ void a_ready(const Unit&) const {}
    __device__ __forceinline__ void done(const Unit&) const {}
};

struct PanelOrder {
    StaticOrder S;
    __device__ bool next(int i, Unit& u) const {
        const long L = (long)i * S.G + S.c; if (L >= S.nwg) return false;
        const int xcd = (int)L % NXCD, off = (int)L / NXCD;
        u.pn = off % S.nN; u.pm = xcd * WGM + off / S.nN; return true;
    }
    __device__ __forceinline__ void a_ready(const Unit&) const {}
    __device__ __forceinline__ void done(const Unit&) const {}
};
struct SkipOrder {
    StaticOrder S;
    __device__ bool next(int i, Unit& u) const { const bool ok = S.next(i, u); if (ok && u.pn >= 27) u.pn += 3; return ok; }
    __device__ __forceinline__ void a_ready(const Unit&) const {}
    __device__ __forceinline__ void done(const Unit&) const {}
};

__device__ __forceinline__ unsigned cvt_pk_bf16(float lo, float hi) { unsigned r; asm volatile("v_cvt_pk_bf16_f32 %0, %1, %2" : "=v"(r) : "v"(lo), "v"(hi)); return r; }
typedef float f32x2 __attribute__((ext_vector_type(2)));
__device__ __forceinline__ float silu_f(float g) { return g * __builtin_amdgcn_rcpf(1.0f + __builtin_amdgcn_exp2f(-1.4426950408889634f * g)); }

__device__ __forceinline__ float xlane(float v, int src_lane) { return __builtin_bit_cast(float, __builtin_amdgcn_ds_bpermute(src_lane << 2, __builtin_bit_cast(int, v))); }
__device__ __forceinline__ void rss_pre_load(const unsigned long long* rss, const Unit& u, int wr, int lane, unsigned long long (&raw)[2]) {
#pragma unroll
    for (int s = 0; s < 2; ++s) raw[s] = __hip_atomic_load((const __attribute__((address_space(1))) unsigned long long*)(rss + u.pm * BM + s * HALF + wr * 64 + lane), __ATOMIC_RELAXED, __HIP_MEMORY_SCOPE_AGENT);
}
__device__ __forceinline__ void row_rstd(const unsigned long long (&raw)[2], int fr, float (&rs)[2][4]) {
    float r[2];
#pragma unroll
    for (int s = 0; s < 2; ++s) r[s] = 1.0f / sqrtf((float)raw[s] * (1.0f / 16777216.0f) * (1.0f / 2048.0f) + 1e-6f);
#pragma unroll
    for (int ai = 0; ai < 2; ++ai)
#pragma unroll
        for (int m = 0; m < 4; ++m) rs[ai][m] = xlane(r[ai], m * 16 + fr);
}
struct EpiPrepN {
    static constexpr bool PERM = true, AFTER_DRAIN = false, PRE = true;
    bf16_t* O; int ldc; const unsigned long long* rss; int Lmask; const float* pcs; const float* axcs; const float* gq; const float* gk; PG8_LAS float* scr; PG8_LAS unsigned char* tab;
    __device__ __forceinline__ void pre_load(const Unit& u, int wr, int lane, unsigned long long (&raw)[2]) const {
        __builtin_amdgcn_s_barrier();
        rss_pre_load(rss, u, wr, lane, raw);
        int tid_o = threadIdx.x; asm volatile("" : "+v"(tid_o));
        const int pn = u.pn, wid = __builtin_amdgcn_readfirstlane(tid_o >> 6), T0 = (u.pm * BM) & Lmask; lane = tid_o & 63;
        if (pn < 6 || (pn >= 9 && pn < 15)) {
            const char* src = (const char*)(pcs + (size_t)T0 * 16) + lane * 16;
#pragma unroll
            for (int h = 0; h < 2; ++h) __builtin_amdgcn_global_load_lds((const unsigned*)(src + (wid + 8 * h) * 1024), (PG8_LAS unsigned*)(tab + (wid + 8 * h) * 1024), 16, 0, 0);
        } else if (pn >= 30 && pn < 34) {
            __builtin_amdgcn_global_load_lds((const unsigned*)((const char*)axcs + wid * 1024 + lane * 16), (PG8_LAS unsigned*)(tab + wid * 1024), 16, 0, 0);
            if (wid == 0) __builtin_amdgcn_global_load_lds((const unsigned*)((const char*)axcs + (T0 >> 6) * 128 + (lane & 31) * 16), (PG8_LAS unsigned*)(tab + 8192), 16, 0, 0);
        }
    }
    static __device__ __forceinline__ u32x4 pack8(const f32x4& v0, const f32x4& v1) { u32x4 w; w.x = cvt_pk_bf16(v0[0], v0[1]); w.y = cvt_pk_bf16(v0[2], v0[3]); w.z = cvt_pk_bf16(v1[0], v1[1]); w.w = cvt_pk_bf16(v1[2], v1[3]); return w; }
    typedef unsigned u32x2_ __attribute__((ext_vector_type(2)));
    static __device__ __forceinline__ void rot_store(const f32x4& x1, const f32x4& x2, const f32x4& q0, const f32x4& q1, bf16_t* p1, bf16_t* p2) {
        const f32x4 c = {q0[0], q0[2], q1[0], q1[2]}, sn = {q0[1], q0[3], q1[1], q1[3]};
        const f32x4 o1 = x1 * c - x2 * sn, o2 = x2 * c + x1 * sn;
        u32x2_ w1, w2; w1.x = cvt_pk_bf16(o1[0], o1[1]); w1.y = cvt_pk_bf16(o1[2], o1[3]); w2.x = cvt_pk_bf16(o2[0], o2[1]); w2.y = cvt_pk_bf16(o2[2], o2[3]);
        *(u32x2_*)p1 = w1; *(u32x2_*)p2 = w2;
    }
    __device__ __forceinline__ void operator()(const f32x4 (&acc)[2][2][4][2], const Unit& u, int wr, int wc, int fr, int fq, const unsigned long long (&raw)[2]) const {
        asm volatile("" : "+v"(fr), "+v"(fq));
        const int row0 = u.pm * BM + wr * 64 + fr; const int col0 = u.pn * BM + wc * 32 + 8 * fq; const int lane = fq * 16 + fr;
        float rs[2][4]; row_rstd(raw, fr, rs);
        const int pn = u.pn;
        const int mode = (pn < 6 || (pn >= 9 && pn < 15)) ? (((wc & 1) == 0) ? 1 : 0) : ((pn >= 30 && pn < 34) ? 2 : 0);
        if (mode == 0) {
#pragma unroll
            for (int ai = 0; ai < 2; ++ai)
#pragma unroll
                for (int m = 0; m < 4; ++m) { bf16_t* rowp = O + (size_t)(row0 + ai * HALF + m * 16) * ldc + col0; const float r = rs[ai][m];
#pragma unroll
                    for (int bj = 0; bj < 2; ++bj) *(u32x4*)(rowp + bj * HALF) = pack8(acc[ai][bj][m][0] * r, acc[ai][bj][m][1] * r); }
        } else if (mode == 1) {
            const bool rot = fq < 2;
#pragma unroll
            for (int ai = 0; ai < 2; ++ai)
#pragma unroll
                for (int m = 0; m < 4; ++m) { const int row = row0 + ai * HALF + m * 16; bf16_t* rowp = O + (size_t)row * ldc + col0; const float r = rs[ai][m];
                    const PG8_LAS f32x4* cs = (const PG8_LAS f32x4*)(tab + (ai * HALF + wr * 64 + m * 16 + fr) * 64 + 32 * (fq & 1)); const f32x4 q0 = cs[0], q1 = cs[1];
#pragma unroll
                    for (int bj = 0; bj < 2; ++bj) { const f32x4 v0 = acc[ai][bj][m][0] * r, v1 = acc[ai][bj][m][1] * r;
                        if (rot) rot_store(v0, v1, q0, q1, rowp + bj * HALF - 4 * fq, rowp + bj * HALF - 4 * fq + 8);
                        else *(u32x4*)(rowp + bj * HALF) = pack8(v0, v1); }
                    if (m & 1) asm volatile("" ::: "memory"); }
        } else {
#pragma unroll
            for (int ai = 0; ai < 2; ++ai)
#pragma unroll
                for (int m = 0; m < 4; ++m) { const float r = rs[ai][m];
#pragma unroll
                    for (int bj = 0; bj < 2; ++bj) { const f32x4 v0 = acc[ai][bj][m][0] * r, v1 = acc[ai][bj][m][1] * r;
                        float ss = (v0[0] * v0[0] + v0[1] * v0[1]) + (v0[2] * v0[2] + v0[3] * v0[3]) + (v1[0] * v1[0] + v1[1] * v1[1]) + (v1[2] * v1[2] + v1[3] * v1[3]);
                        ss += xlane(ss, lane ^ 16); ss += xlane(ss, lane ^ 32);
                        if (fq == 0) scr[(ai * HALF + wr * 64 + m * 16 + fr) * 8 + bj * 4 + wc] = ss; } }
            asm volatile("s_waitcnt lgkmcnt(0)\n\ts_barrier" ::: "memory");
            const bool isk = pn == 33; const float* gain = (isk ? gk : gq) + 32 * (wc & 1) + 4 * fq; const float qs = isk ? 1.0f : 0.18033688011112042f;
            const f32x4 g0 = *(const f32x4*)gain, g1 = *(const f32x4*)(gain + 16);
#pragma unroll
            for (int ai = 0; ai < 2; ++ai)
#pragma unroll
                for (int m = 0; m < 4; ++m) { const int row = row0 + ai * HALF + m * 16; bf16_t* rowp = O + (size_t)row * ldc + col0 - 4 * fq; const float r = rs[ai][m];
                    const int tl = ai * HALF + wr * 64 + m * 16 + fr;
                    const PG8_LAS f32x4* cs = (const PG8_LAS f32x4*)(tab + ((wc & 1) ? (tl & 63) * 128 : 8192 + (tl >> 6) * 128) + 32 * fq); const f32x4 q0 = cs[0], q1 = cs[1];
#pragma unroll
                    for (int bj = 0; bj < 2; ++bj) { const f32x2 so = *(const PG8_LAS f32x2*)(scr + (ai * HALF + wr * 64 + m * 16 + fr) * 8 + bj * 4 + (wc & 2));
                        const float rh = r * qs / sqrtf((so[0] + so[1]) * (1.0f / 64.0f) + 1e-6f);
                        rot_store(acc[ai][bj][m][0] * rh * g0, acc[ai][bj][m][1] * rh * g1, q0, q1, rowp + bj * HALF, rowp + bj * HALF + 16); }
                    if (m & 1) asm volatile("" ::: "memory"); }
        }
    }
};
struct EpiSwigluN {
    static constexpr bool PERM = true, AFTER_DRAIN = false, PRE = true;
    bf16_t* O; int ldc; const unsigned long long* rss;
    __device__ __forceinline__ void pre_load(const Unit& u, int wr, int lane, unsigned long long (&raw)[2]) const { rss_pre_load(rss, u, wr, lane, raw); }
    static __device__ __forceinline__ unsigned swiglu2(f32x2 ag, f32x2 au, float nr, float r2) {
        const f32x2 t = ag * nr; f32x2 e = {__builtin_amdgcn_exp2f(t[0]), __builtin_amdgcn_exp2f(t[1])};
        e = e + 1.0f; const f32x2 rc = {__builtin_amdgcn_rcpf(e[0]), __builtin_amdgcn_rcpf(e[1])};
        const f32x2 h = (ag * au) * (rc * r2); return cvt_pk_bf16(h[0], h[1]);
    }
    __device__ __forceinline__ void operator()(const f32x4 (&acc)[2][2][4][2], const Unit& u, int wr, int wc, int fr, int fq, const unsigned long long (&raw)[2]) const {
        const int row0 = u.pm * BM + wr * 64 + fr; const int col0 = u.pn * HALF + wc * 32 + 8 * fq;
        float rs[2][4]; row_rstd(raw, fr, rs);
#pragma unroll
        for (int ai = 0; ai < 2; ++ai)
#pragma unroll
            for (int m = 0; m < 4; ++m) { bf16_t* rowp = O + (size_t)(row0 + ai * HALF + m * 16) * ldc + col0; const float r = rs[ai][m], nr = -1.4426950408889634f * r, r2 = r * r;
                const f32x4 g0 = acc[ai][0][m][0], g1 = acc[ai][0][m][1], u0 = acc[ai][1][m][0], u1 = acc[ai][1][m][1];
                u32x4 w; w.x = swiglu2((f32x2){g0[0], g0[1]}, (f32x2){u0[0], u0[1]}, nr, r2); w.y = swiglu2((f32x2){g0[2], g0[3]}, (f32x2){u0[2], u0[3]}, nr, r2);
                w.z = swiglu2((f32x2){g1[0], g1[1]}, (f32x2){u1[0], u1[1]}, nr, r2); w.w = swiglu2((f32x2){g1[2], g1[3]}, (f32x2){u1[2], u1[3]}, nr, r2);
                *(u32x4*)rowp = w; }
    }
};
__device__ __forceinline__ float bf_lo(unsigned w) { return __builtin_bit_cast(float, w << 16); }
__device__ __forceinline__ float bf_hi(unsigned w) { return __builtin_bit_cast(float, w & 0xffff0000u); }
template <bool HALF_STEP> struct EpiResidN {
    static constexpr bool PERM = true, AFTER_DRAIN = false, PRE = false; static constexpr float alpha = HALF_STEP ? 0.5f : 1.0f;
    bf16_t* xb; int ldc; unsigned long long* rss;
    __device__ __forceinline__ void operator()(const f32x4 (&acc)[2][2][4][2], const Unit& u, int wr, int wc, int fr, int fq) const {
        asm volatile("" : "+v"(fr), "+v"(fq));
        const int row0 = u.pm * BM + wr * 64 + fr; const int col0 = u.pn * BM + wc * 32 + 8 * fq; const int lane = fq * 16 + fr;
        u32x4 b[2][4][2];
#pragma unroll
        for (int ai = 0; ai < 2; ++ai)
#pragma unroll
            for (int m = 0; m < 4; ++m)
#pragma unroll
                for (int bj = 0; bj < 2; ++bj) b[ai][m][bj] = *(const u32x4*)(xb + (size_t)(row0 + ai * HALF + m * 16) * ldc + col0 + bj * HALF);
        asm volatile("" ::: "memory");
#pragma unroll
        for (int ai = 0; ai < 2; ++ai) {
#pragma unroll
            for (int m = 0; m < 4; ++m) { const int row = row0 + ai * HALF + m * 16; const size_t off = (size_t)row * ldc + col0; float ss = 0.f;
#pragma unroll
                for (int bj = 0; bj < 2; ++bj) { const u32x4 bb = b[ai][m][bj];
                    const f32x4 b0 = {bf_lo(bb.x), bf_hi(bb.x), bf_lo(bb.y), bf_hi(bb.y)}, b1 = {bf_lo(bb.z), bf_hi(bb.z), bf_lo(bb.w), bf_hi(bb.w)};
                    const f32x4 o0 = b0 + acc[ai][bj][m][0] * alpha, o1 = b1 + acc[ai][bj][m][1] * alpha;
                    u32x4 w; w.x = cvt_pk_bf16(o0[0], o0[1]); w.y = cvt_pk_bf16(o0[2], o0[3]); w.z = cvt_pk_bf16(o1[0], o1[1]); w.w = cvt_pk_bf16(o1[2], o1[3]);
                    *(u32x4*)(xb + off + bj * HALF) = w;
                    ss += (o0[0] * o0[0] + o0[1] * o0[1]) + (o0[2] * o0[2] + o0[3] * o0[3]) + (o1[0] * o1[0] + o1[1] * o1[1]) + (o1[2] * o1[2] + o1[3] * o1[3]); }
                ss += xlane(ss, lane ^ 16); ss += xlane(ss, lane ^ 32);
                if (fq == 0) __hip_atomic_fetch_add((__attribute__((address_space(1))) unsigned long long*)(rss + row), (unsigned long long)(ss * 16777216.0f), __ATOMIC_RELAXED, __HIP_MEMORY_SCOPE_AGENT);
            }
        }
    }
};

template <class Epi, class Sched, bool ALIGN_EPI = false, bool SP2 = false>
__device__ __forceinline__ void gemm_phase(PG8_LAS unsigned char* lds, const Gemm g, const Sched& S, const Epi& E) {
    int tid_l = threadIdx.x; asm volatile("" : "+v"(tid_l));
    const int tid = tid_l, wid = __builtin_amdgcn_readfirstlane(tid >> 6), lane = tid & 63, wr = wid >> 2, wc = wid & 3, fr = lane & 15, fq = lane >> 4;
    const int K = g.K, nt = K / BK;
    unsigned voffA[2], voffB[2];
#pragma unroll
    for (int i = 0; i < 2; ++i) { int R, C; stage_rc(tid * 16 + i * 8192, R, C); const int Rb = Epi::PERM ? ((R & ~31) + perm32(R & 31)) : R;
        voffA[i] = (unsigned)(R * K + C) * 2u; voffB[i] = (unsigned)(Rb * K + C) * 2u; }
    const size_t kstep = (size_t)(BK * 2);
    const size_t hstep = (size_t)HALF * K * 2;
    const size_t tstep = 2 * hstep;
    const unsigned ldsw = (unsigned)wid * 1024u;
    const int aoff = lds_byte(wr * 64 + fr, fq * 8), boff = lds_byte(wc * 32 + fr, fq * 8);
#define PG8_SA(b, h) (((b) * 2 + (h)) * HTB)
#define PG8_SB(b, h) ((4 + (b) * 2 + (h)) * HTB)
#define PG8_STAGE(bufoff, gbase, voff) do { _Pragma("unroll") for (int _i = 0; _i < 2; ++_i) \
        __builtin_amdgcn_global_load_lds((const unsigned*)((const char*)(gbase) + (voff)[_i]), (PG8_LAS unsigned*)(lds + (bufoff) + ldsw + _i * 8192), 16, 0, 0); } while (0)
#define PG8_LDA(dst, b, h) do { _Pragma("unroll") for (int m = 0; m < 4; ++m) _Pragma("unroll") for (int k = 0; k < 2; ++k) dst[m][k] = *(const PG8_LAS bf16x8*)(lds + PG8_SA(b, h) + aoff + m * 2048 + k * 1024); } while (0)
#define PG8_LDB(dst, b, h) do { _Pragma("unroll") for (int n = 0; n < 2; ++n) _Pragma("unroll") for (int k = 0; k < 2; ++k) dst[n][k] = *(const PG8_LAS bf16x8*)(lds + PG8_SB(b, h) + boff + n * 2048 + k * 1024); } while (0)
#define PG8_MMA(ai, bj, At, Bt) do { __builtin_amdgcn_s_setprio(1); _Pragma("unroll") for (int m = 0; m < 4; ++m) _Pragma("unroll") for (int n = 0; n < 2; ++n) _Pragma("unroll") for (int k = 0; k < 2; ++k) \
        acc[ai][bj][m][n] = __builtin_amdgcn_mfma_f32_16x16x32_bf16(Bt[n][k], At[m][k], acc[ai][bj][m][n], 0, 0, 0); __builtin_amdgcn_s_setprio(0); } while (0)
#define PG8_WAIT_V(n) asm volatile("s_waitcnt vmcnt(" #n ")" ::: "memory")
#define PG8_WAIT_L(n) asm volatile("s_waitcnt lgkmcnt(" #n ")" ::: "memory")
#define PG8_BAR __builtin_amdgcn_s_barrier()
#define PG8_SCHED __builtin_amdgcn_sched_barrier(0)
    Unit cur, nxt; int ui = 0;
    if (!S.next(0, cur)) return;
    f32x4 acc[2][2][4][2];
#pragma unroll
    for (int a = 0; a < 2; ++a)
#pragma unroll
        for (int b = 0; b < 2; ++b)
#pragma unroll
            for (int m = 0; m < 4; ++m)
#pragma unroll
                for (int n = 0; n < 2; ++n) acc[a][b][m][n] = (f32x4){0.f, 0.f, 0.f, 0.f};
    bf16x8 At[4][2], B0[2][2], B1[2][2];
    const char* cA = (const char*)g.A + (size_t)cur.pm * tstep; const char* cB = (const char*)g.Bt + (size_t)cur.pn * tstep;
    S.a_ready(cur);
    unsigned long long praw[2] = {0ull, 0ull};
    if constexpr (Epi::PRE) E.pre_load(cur, wr, lane, praw);
    if constexpr (SP2) {
        PG8_STAGE(PG8_SB(0, 0), cB, voffB); PG8_STAGE(PG8_SB(0, 1), cB + hstep, voffB); PG8_STAGE(PG8_SA(0, 0), cA, voffA); PG8_STAGE(PG8_SA(0, 1), cA + hstep, voffA);
        if (wr == 1) PG8_BAR;
        PG8_WAIT_V(2); PG8_BAR;
        PG8_STAGE(PG8_SB(1, 0), cB + kstep, voffB); PG8_STAGE(PG8_SA(1, 0), cA + kstep, voffA); PG8_STAGE(PG8_SB(1, 1), cB + hstep + kstep, voffB);
        PG8_WAIT_V(6); PG8_BAR;
    } else {
        PG8_STAGE(PG8_SB(0, 0), cB, voffB); PG8_STAGE(PG8_SA(0, 0), cA, voffA); PG8_STAGE(PG8_SB(0, 1), cB + hstep, voffB); PG8_STAGE(PG8_SA(0, 1), cA + hstep, voffA);
        if (wr == 1) PG8_BAR;
        PG8_WAIT_V(4); PG8_BAR;
        PG8_STAGE(PG8_SB(1, 0), cB + kstep, voffB); PG8_STAGE(PG8_SA(1, 0), cA + kstep, voffA); PG8_STAGE(PG8_SB(1, 1), cB + hstep + kstep, voffB);
        PG8_WAIT_V(6); PG8_BAR;
    }
    for (;;) {
        const bool has_next = S.next(ui + 1, nxt);
        const char* nA = has_next ? (const char*)g.A + (size_t)nxt.pm * tstep : cA; const char* nB = has_next ? (const char*)g.Bt + (size_t)nxt.pn * tstep : cB;
        for (int t = 0; t < nt; t += 2) {
            const bool last = (t == nt - 2);
            const char* a1 = cA + (size_t)(t + 1) * kstep;
            const char* a2 = last ? nA : cA + (size_t)(t + 2) * kstep; const char* b2 = last ? nB : cB + (size_t)(t + 2) * kstep;
            const char* a3 = a2 + kstep; const char* b3 = b2 + kstep;
            if (last && has_next) S.a_ready(nxt);
            if constexpr (SP2) {
            PG8_LDB(B0, 0, 0); PG8_LDB(B1, 0, 1); PG8_SCHED; PG8_LDA(At, 0, 0); PG8_STAGE(PG8_SA(1, 1), a1 + hstep, voffA);
            PG8_WAIT_V(8); PG8_WAIT_L(0); PG8_BAR; PG8_MMA(0, 0, At, B0); PG8_MMA(0, 1, At, B1); PG8_BAR; PG8_SCHED;
            PG8_LDA(At, 0, 1); PG8_STAGE(PG8_SB(0, 0), b2, voffB); PG8_STAGE(PG8_SB(0, 1), b2 + hstep, voffB); PG8_STAGE(PG8_SA(0, 0), a2, voffA);
            PG8_WAIT_V(8); PG8_WAIT_L(0); PG8_BAR; PG8_MMA(1, 0, At, B0); PG8_MMA(1, 1, At, B1); PG8_BAR; PG8_SCHED;
            PG8_LDB(B0, 1, 0); PG8_LDB(B1, 1, 1); PG8_SCHED; PG8_LDA(At, 1, 0); PG8_STAGE(PG8_SA(0, 1), a2 + hstep, voffA);
            PG8_WAIT_V(8); PG8_WAIT_L(0); PG8_BAR; PG8_MMA(0, 0, At, B0); PG8_MMA(0, 1, At, B1); PG8_BAR; PG8_SCHED;
            PG8_LDA(At, 1, 1); PG8_STAGE(PG8_SB(1, 0), b3, voffB); PG8_STAGE(PG8_SB(1, 1), b3 + hstep, voffB); PG8_STAGE(PG8_SA(1, 0), a3, voffA);
            PG8_WAIT_V(8); PG8_WAIT_L(0); PG8_BAR; PG8_MMA(1, 0, At, B0); PG8_MMA(1, 1, At, B1); PG8_BAR; PG8_SCHED;
            } else {
            PG8_LDB(B0, 0, 0); PG8_SCHED; PG8_LDA(At, 0, 0); PG8_STAGE(PG8_SA(1, 1), a1 + hstep, voffA);
            PG8_WAIT_L(8); PG8_BAR; PG8_WAIT_L(0); PG8_MMA(0, 0, At, B0); PG8_BAR; PG8_SCHED;
            PG8_LDB(B1, 0, 1); PG8_STAGE(PG8_SB(0, 0), b2, voffB);
            PG8_BAR; PG8_WAIT_L(0); PG8_MMA(0, 1, At, B1); PG8_BAR;
            PG8_LDA(At, 0, 1); PG8_STAGE(PG8_SA(0, 0), a2, voffA);
            PG8_BAR; PG8_WAIT_L(0); PG8_MMA(1, 0, At, B0); PG8_BAR; PG8_SCHED;
            PG8_STAGE(PG8_SB(0, 1), b2 + hstep, voffB);
            PG8_WAIT_V(6); PG8_BAR; PG8_MMA(1, 1, At, B1); PG8_BAR;
            PG8_LDB(B0, 1, 0); PG8_SCHED; PG8_LDA(At, 1, 0); PG8_STAGE(PG8_SA(0, 1), a2 + hstep, voffA);
            PG8_WAIT_L(8); PG8_BAR; PG8_WAIT_L(0); PG8_MMA(0, 0, At, B0); PG8_BAR; PG8_SCHED;
            PG8_LDB(B1, 1, 1); PG8_STAGE(PG8_SB(1, 0), b3, voffB);
            PG8_BAR; PG8_WAIT_L(0); PG8_MMA(0, 1, At, B1); PG8_BAR;
            PG8_LDA(At, 1, 1); PG8_STAGE(PG8_SA(1, 0), a3, voffA);
            PG8_BAR; PG8_WAIT_L(0); PG8_MMA(1, 0, At, B0); PG8_BAR; PG8_SCHED;
            PG8_STAGE(PG8_SB(1, 1), b3 + hstep, voffB);
            PG8_WAIT_V(6); PG8_BAR; PG8_MMA(1, 1, At, B1); PG8_BAR;
            }
        }
        if constexpr (ALIGN_EPI) { if (wr == 0) PG8_BAR; }
        if constexpr (!Epi::AFTER_DRAIN) { if constexpr (Epi::PRE) E(acc, cur, wr, wc, fr, fq, praw); else E(acc, cur, wr, wc, fr, fq); S.done(cur); }
        if (!has_next) break;
#pragma unroll
        for (int a = 0; a < 2; ++a)
#pragma unroll
            for (int b = 0; b < 2; ++b)
#pragma unroll
                for (int m = 0; m < 4; ++m)
#pragma unroll
                    for (int n = 0; n < 2; ++n) acc[a][b][m][n] = (f32x4){0.f, 0.f, 0.f, 0.f};
        cur = nxt; cA = nA; cB = nB; ++ui;
        if constexpr (Epi::PRE) E.pre_load(cur, wr, lane, praw);
        if constexpr (ALIGN_EPI) { if (wr == 1) PG8_BAR; }
    }
    PG8_WAIT_V(0);
    if constexpr (!ALIGN_EPI) { if (wr == 0) PG8_BAR; }
    PG8_BAR;
    if constexpr (Epi::AFTER_DRAIN) { E.fused(acc, cur, wr, wc, fr, fq, lds, wid, lane); S.done(cur); }
#undef PG8_SA
#undef PG8_SB
#undef PG8_STAGE
#undef PG8_LDA
#undef PG8_LDB
#undef PG8_MMA
#undef PG8_WAIT_V
#undef PG8_WAIT_L
#undef PG8_BAR
#undef PG8_SCHED
}
}
#include <hip/hip_bf16.h>
#include <cmath>
namespace attn_body {
using bf16=__hip_bfloat16;
using bf16x8=__attribute__((ext_vector_type(8)))short;
using s16x4=__attribute__((ext_vector_type(4)))short;
using f32x16=__attribute__((ext_vector_type(16)))float;
using u32x4=__attribute__((ext_vector_type(4)))unsigned;
constexpr int D=64,PU=8960;
constexpr int NW=8,QBLK=32,QB=QBLK*NW,KVBLK=64;

__device__ __forceinline__ int crow(int r,int hi){return (r&3)+8*(r>>2)+4*hi;}
#define SBAR() __builtin_amdgcn_sched_barrier(0)


constexpr int NSLOT=3, SLOTB=8192;
constexpr int LDS_K=0, LDS_V=NSLOT*SLOTB, LDS_WS=2*NSLOT*SLOTB, LDS_OST=LDS_WS+NW*64*4, LDS_BYTES=LDS_OST+NW*4096;
constexpr float C2=0.125f*1.4426950408889634f;
__device__ __forceinline__ void glds16(const void*gsrc,unsigned lds_dst){unsigned keep;
  asm volatile("s_mov_b32 %0, m0\n\ts_mov_b32 m0, %2\n\ts_nop 0\n\tglobal_load_lds_dwordx4 %1, off\n\ts_mov_b32 m0, %0":"=&s"(keep):"v"(gsrc),"s"(lds_dst):"memory");}
__device__ __forceinline__ float max3f(float a,float b,float c){float r;asm("v_max3_f32 %0, %1, %2, %3":"=v"(r):"v"(a),"v"(b),"v"(c));return r;}
__device__ __forceinline__ float max2f(float a,float b){float r;asm("v_max_f32_e32 %0, %1, %2":"=v"(r):"v"(a),"v"(b));return r;}
__device__ __forceinline__ float fadd_s(float a,float b){float r;asm("v_add_f32_e32 %0, %1, %2":"=v"(r):"v"(a),"v"(b));return r;}
__device__ __forceinline__ float fsub_s(float a,float b){float r;asm("v_sub_f32_e32 %0, %1, %2":"=v"(r):"v"(a),"v"(b));return r;}
typedef float f32x2_t __attribute__((ext_vector_type(2))); typedef __bf16 bf16x2_t __attribute__((ext_vector_type(2)));
__device__ __forceinline__ unsigned cvtpk_s(float lo,float hi){f32x2_t v={lo,hi};bf16x2_t b=__builtin_convertvector(v,bf16x2_t);return __builtin_bit_cast(unsigned,b);}
#define WAIT_BAR(N) asm volatile("s_waitcnt vmcnt(" #N ") lgkmcnt(0)\n\ts_barrier":::"memory")

__device__ __forceinline__ void qkt(f32x16&p0,f32x16&p1,const char*Kslot,const bf16x8*qr,const f32x16&negm,int r32,int hi){
  const char*kb=Kslot+hi*1024+r32*16;
  #pragma unroll
  for(int d0=0;d0<4;++d0){
    const bf16x8 b0=*reinterpret_cast<const bf16x8*>(kb+d0*2048);
    const bf16x8 b1=*reinterpret_cast<const bf16x8*>(kb+d0*2048+512);
    if(d0==0){p0=__builtin_amdgcn_mfma_f32_32x32x16_bf16(b0,qr[0],negm,0,0,0);p1=__builtin_amdgcn_mfma_f32_32x32x16_bf16(b1,qr[0],negm,0,0,0);}
    else{p0=__builtin_amdgcn_mfma_f32_32x32x16_bf16(b0,qr[d0],p0,0,0,0);p1=__builtin_amdgcn_mfma_f32_32x32x16_bf16(b1,qr[d0],p1,0,0,0);}}
}
typedef __attribute__((address_space(3))) const char* lds_cptr;
typedef short v4i16_t __attribute__((ext_vector_type(4)));
__device__ __forceinline__ void kload8(bf16x8*kf,lds_cptr kp){
  kf[0]=*(const __attribute__((address_space(3))) bf16x8*)(kp);      kf[1]=*(const __attribute__((address_space(3))) bf16x8*)(kp+512);
  kf[2]=*(const __attribute__((address_space(3))) bf16x8*)(kp+2048); kf[3]=*(const __attribute__((address_space(3))) bf16x8*)(kp+2560);
  kf[4]=*(const __attribute__((address_space(3))) bf16x8*)(kp+4096); kf[5]=*(const __attribute__((address_space(3))) bf16x8*)(kp+4608);
  kf[6]=*(const __attribute__((address_space(3))) bf16x8*)(kp+6144); kf[7]=*(const __attribute__((address_space(3))) bf16x8*)(kp+6656);
}
__device__ __forceinline__ void kload2(bf16x8*kf,lds_cptr kp,int j){ kf[2*j]=*(const __attribute__((address_space(3))) bf16x8*)(kp+j*2048); kf[2*j+1]=*(const __attribute__((address_space(3))) bf16x8*)(kp+j*2048+512); }
__device__ __forceinline__ s16x4 vtr(lds_cptr p){ return __builtin_bit_cast(s16x4,__builtin_amdgcn_ds_read_tr16_b64_v4i16((__attribute__((address_space(3))) v4i16_t*)p)); }
__device__ __forceinline__ float rowmax(const f32x16&p0,const f32x16&p1){
  float a=max3f(p0[0],p0[1],p1[0]),b=max3f(p0[2],p0[3],p1[1]);a=max3f(a,p1[2],p1[3]);
  #pragma unroll
  for(int r=4;r<16;r+=4){a=max3f(a,p0[r],p0[r+1]);b=max3f(b,p0[r+2],p0[r+3]);a=max3f(a,p1[r],p1[r+1]);b=max3f(b,p1[r+2],p1[r+3]);}
  const float m=max2f(a,b);
  auto rr=__builtin_amdgcn_permlane32_swap(__float_as_uint(m),__float_as_uint(m),false,false);
  return max2f(__uint_as_float(rr[0]),__uint_as_float(rr[1]));
}
__device__ __forceinline__ void pv(f32x16*o,int vb,bf16x8 pa0,bf16x8 pa1,bf16x8 pa2,bf16x8 pa3){
  #pragma unroll
  for(int d0=0;d0<2;++d0){s16x4 lo[4],hi[4];
    #pragma unroll
    for(int ks=0;ks<4;++ks){
      asm volatile("ds_read_b64_tr_b16 %0,%1 offset:%c2":"=&v"(lo[ks]):"v"(vb),"i"(d0*4096+ks*1024):"memory");
      asm volatile("ds_read_b64_tr_b16 %0,%1 offset:%c2":"=&v"(hi[ks]):"v"(vb),"i"(d0*4096+ks*1024+512):"memory");}
    asm volatile("s_waitcnt lgkmcnt(0)":::"memory");SBAR();
    #define PK(k) (bf16x8){lo[k][0],lo[k][1],lo[k][2],lo[k][3],hi[k][0],hi[k][1],hi[k][2],hi[k][3]}
    o[d0]=__builtin_amdgcn_mfma_f32_32x32x16_bf16(pa0,PK(0),o[d0],0,0,0);
    o[d0]=__builtin_amdgcn_mfma_f32_32x32x16_bf16(pa1,PK(1),o[d0],0,0,0);
    o[d0]=__builtin_amdgcn_mfma_f32_32x32x16_bf16(pa2,PK(2),o[d0],0,0,0);
    o[d0]=__builtin_amdgcn_mfma_f32_32x32x16_bf16(pa3,PK(3),o[d0],0,0,0);
    #undef PK
  }
}

#ifndef ATTN_STORE16
#define ATTN_STORE16(p,v) (*(u32x4*)(p)=(v))
#endif
template<int THRL> __device__ __forceinline__ void attn_unit(const bf16*Qu,const bf16*__restrict__ Kh,const bf16*__restrict__ Vh,bf16*Ou,const long PO,const int NT,char*shm){
  int tid_l=threadIdx.x; asm volatile("":"+v"(tid_l)); const int tid=tid_l,lane=tid&63,r32=lane&31,hi=lane>>5; const int wid=__builtin_amdgcn_readfirstlane(tid>>6);

  const bf16*Qw=Qu+(long)(wid*QBLK)*PU;

  const unsigned lds0=(unsigned)(uintptr_t)shm;
  float*wsf=(float*)(shm+LDS_WS)+wid*64;
  const bf16*ksrc=Kh+(long)lane*PU+wid*8;
  const bf16*vsrc=Vh+(long)(16*(wid&3)+(lane>>2))*PU+(wid>>2)*32+(lane&3)*8;
  const unsigned kdst=lds0+LDS_K+wid*1024, vdst=lds0+LDS_V+wid*1024;
  #define DMA_K(t,slot) glds16(ksrc+(long)(t)*KVBLK*PU,(unsigned)__builtin_amdgcn_readfirstlane(kdst+(slot)))
  #define DMA_V(t,slot) glds16(vsrc+(long)(t)*KVBLK*PU,(unsigned)__builtin_amdgcn_readfirstlane(vdst+(slot)))
  const int vb0=(int)(lds0+LDS_V)+((lane>>4)&1)*32+(lane&3)*8+(4*hi+((lane&15)>>2))*64;
  const char*Kbase=shm+LDS_K; bf16x8 kf[8];
  const lds_cptr shm3=(lds_cptr)shm; const lds_cptr kp0=shm3+LDS_K+hi*1024+r32*16; const lds_cptr vp0=shm3+LDS_V+((lane>>4)&1)*32+(lane&3)*8+(4*hi+((lane&15)>>2))*64;

  DMA_K(0,0);DMA_V(0,0);DMA_K(1,SLOTB);
  bf16x8 qr[4];
  #pragma unroll
  for(int d0=0;d0<4;++d0)qr[d0]=*reinterpret_cast<const bf16x8*>(&Qw[(long)r32*PU+d0*16+hi*8]);
  float mhat=0.f,l_reg=0.f;f32x16 o[2];o[0]=f32x16{};o[1]=f32x16{};f32x16 negm=f32x16{};asm volatile("":"+v"(negm));

  #define CMASK(P0,P1,t) do{}while(0)
  bool resc=false;
  #define START(P0,P1) do{ const float rm=rowmax(P0,P1); resc=false; \
    { const float dl=rm; mhat=fadd_s(mhat,dl); \
      _Pragma("unroll") for(int r=0;r<16;++r){P0[r]=fsub_s(P0[r],dl);P1[r]=fsub_s(P1[r],dl);} \
      _Pragma("unroll") for(int r=0;r<16;++r)negm[r]=-mhat; asm volatile("":"+v"(negm)); } \
    _Pragma("unroll") for(int r=0;r<16;++r)P0[r]=__builtin_amdgcn_exp2f(P0[r]); }while(0)
  #define RESC() do{ if(resc){ asm volatile("s_waitcnt lgkmcnt(0)":::"memory"); \
      _Pragma("unroll") for(int d_=0;d_<2;++d_) _Pragma("unroll") for(int r=0;r<16;++r)o[d_][r]*=wsf[crow(r,hi)]; } }while(0)
  f32x16 pA0,pA1,pB0,pB1;
  int sl_prev=0,sl_cur=0,sl_next=SLOTB;
  #define ROT() do{sl_prev=sl_cur;sl_cur=sl_next;sl_next=(sl_next==(NSLOT-1)*SLOTB)?0:sl_next+SLOTB;}while(0)
  DMA_K(2,2*SLOTB);
  WAIT_BAR(3);
  qkt(pA0,pA1,Kbase,qr,negm,r32,hi);asm volatile("s_nop 15\n\ts_nop 7":"+v"(pA0),"+v"(pA1));CMASK(pA0,pA1,0);
  START(pA0,pA1);
  _Pragma("unroll") for(int r=0;r<16;++r)pA1[r]=__builtin_amdgcn_exp2f(pA1[r]);
  WAIT_BAR(0);
  DMA_K(3,0);DMA_V(1,SLOTB);
  ROT();
  kload8(kf,kp0+sl_cur);
  WAIT_BAR(2);
  s16x4 vlo[8],vhi[8]; u32x4 pw0,pw1,pw2,pw3;
  #define PKW(P,B) cvtpk_s(P[B],P[B+1])
  #define PAF(k) __builtin_bit_cast(bf16x8,pw##k)
  #define VFR(i) (bf16x8){vlo[i][0],vlo[i][1],vlo[i][2],vlo[i][3],vhi[i][0],vhi[i][1],vhi[i][2],vhi[i][3]}
  #define PIN(x) asm volatile("":"+v"(x))
  #define MX3(a,b,c) __builtin_fmaxf(__builtin_fmaxf((a),(b)),(c))
  #define GAPA(MF,A0,A1,A2,A3,W0,W1,PW) do{ MF; sacc+=A0; sacc+=A1; sacc+=A2; sacc+=A3; PIN(sacc); W0; W1; PIN(PW); SBAR(); }while(0)
  #define EX(v) __builtin_amdgcn_exp2f(v)
  #define GAPB(MF,X,B) do{ MF; X[B]=EX(X[B]); X[B+1]=EX(X[B+1]); X[B+2]=EX(X[B+2]); X[B+3]=EX(X[B+3]); PIN(X); SBAR(); }while(0)
  #define VRD(i) do{ vlo[i]=vtr(vp_+(((i)>>2)*4096+((i)&3)*1024)); vhi[i]=vtr(vp_+(((i)>>2)*4096+((i)&3)*1024+512)); }while(0)
  #define KRD(G,j) do{ if(G){ kload2(kf,kp0+sl_next,j); SBAR(); } }while(0)
  #define STEP(C0,C1,P0,P1,t,GK,GV,GL) do{ SBAR(); \
    const lds_cptr vp_=vp0+sl_prev; \
    VRD(0); SBAR(); float sacc=(P0[0]+P0[1]); \
    GAPA(C0=__builtin_amdgcn_mfma_f32_32x32x16_bf16(kf[0],qr[0],negm,0,0,0), P0[2],P0[3],P0[4],P0[5],     pw0[0]=PKW(P0,0), pw0[1]=PKW(P0,2), pw0); \
    VRD(4); SBAR(); GAPA(C1=__builtin_amdgcn_mfma_f32_32x32x16_bf16(kf[1],qr[0],negm,0,0,0), P0[6],P0[7],P0[8],P0[9],     pw0[2]=PKW(P0,4), pw0[3]=PKW(P0,6), pw0); \
    VRD(1); SBAR(); GAPA(C0=__builtin_amdgcn_mfma_f32_32x32x16_bf16(kf[2],qr[1],C0,0,0,0),   P0[10],P0[11],P0[12],P0[13], pw1[0]=PKW(P0,8), pw1[1]=PKW(P0,10), pw1); \
    VRD(5); SBAR(); GAPA(C1=__builtin_amdgcn_mfma_f32_32x32x16_bf16(kf[3],qr[1],C1,0,0,0),   P0[14],P0[15],P1[0],P1[1],   pw1[2]=PKW(P0,12),pw1[3]=PKW(P0,14), pw1); \
    VRD(2); SBAR(); GAPA(C0=__builtin_amdgcn_mfma_f32_32x32x16_bf16(kf[4],qr[2],C0,0,0,0),   P1[2],P1[3],P1[4],P1[5],     pw2[0]=PKW(P1,0), pw2[1]=PKW(P1,2), pw2); \
    VRD(6); SBAR(); GAPA(C1=__builtin_amdgcn_mfma_f32_32x32x16_bf16(kf[5],qr[2],C1,0,0,0),   P1[6],P1[7],P1[8],P1[9],     pw2[2]=PKW(P1,4), pw2[3]=PKW(P1,6), pw2); \
    VRD(3); SBAR(); GAPA(C0=__builtin_amdgcn_mfma_f32_32x32x16_bf16(kf[6],qr[3],C0,0,0,0),   P1[10],P1[11],P1[12],P1[13], pw3[0]=PKW(P1,8), pw3[1]=PKW(P1,10), pw3); \
    VRD(7); SBAR(); GAPA(C1=__builtin_amdgcn_mfma_f32_32x32x16_bf16(kf[7],qr[3],C1,0,0,0),   P1[14],P1[15],0.f,0.f,       pw3[2]=PKW(P1,12),pw3[3]=PKW(P1,14), pw3); \
    l_reg+=sacc; \
    if(GK){DMA_K((t)+3,sl_cur);} if(GV){DMA_V((t)+1,sl_next);} \
    CMASK(C0,C1,t); \
    { float a=MX3(C0[0],C0[1],C1[0]),b=MX3(C0[2],C0[3],C1[1]); a=MX3(a,C1[2],C1[3]); \
      _Pragma("unroll") for(int r=4;r<16;r+=4){a=MX3(a,C0[r],C0[r+1]);b=MX3(b,C0[r+2],C0[r+3]);a=MX3(a,C1[r],C1[r+1]);b=MX3(b,C1[r+2],C1[r+3]);} \
      float rm=__builtin_fmaxf(a,b); { auto rr=__builtin_amdgcn_permlane32_swap(__float_as_uint(rm),__float_as_uint(rm),false,false); rm=__builtin_fmaxf(__uint_as_float(rr[0]),__uint_as_float(rr[1])); } \
      resc=false; \
      if(__builtin_expect(__any(rm>(float)THRL),0)){ const float dl=__builtin_fmaxf(rm,0.f); mhat+=dl; \
        _Pragma("unroll") for(int r=0;r<16;++r){C0[r]-=dl;C1[r]-=dl;} \
        _Pragma("unroll") for(int r=0;r<16;++r)negm[r]=-mhat; asm volatile("":"+v"(negm)); \
        const float f=__builtin_amdgcn_exp2f(-dl); l_reg*=f; if(hi==0)wsf[r32]=f; resc=true; } } \
    SBAR(); \
    GAPB(o[0]=__builtin_amdgcn_mfma_f32_32x32x16_bf16(PAF(0),VFR(0),o[0],0,0,0), C0,0); \
    GAPB(o[1]=__builtin_amdgcn_mfma_f32_32x32x16_bf16(PAF(0),VFR(4),o[1],0,0,0), C0,4); \
    KRD(GL,0); GAPB(o[0]=__builtin_amdgcn_mfma_f32_32x32x16_bf16(PAF(1),VFR(1),o[0],0,0,0), C0,8); \
    KRD(GL,1); GAPB(o[1]=__builtin_amdgcn_mfma_f32_32x32x16_bf16(PAF(1),VFR(5),o[1],0,0,0), C0,12); \
    KRD(GL,2); GAPB(o[0]=__builtin_amdgcn_mfma_f32_32x32x16_bf16(PAF(2),VFR(2),o[0],0,0,0), C1,0); \
    KRD(GL,3); GAPB(o[1]=__builtin_amdgcn_mfma_f32_32x32x16_bf16(PAF(2),VFR(6),o[1],0,0,0), C1,4); \
    GAPB(o[0]=__builtin_amdgcn_mfma_f32_32x32x16_bf16(PAF(3),VFR(3),o[0],0,0,0), C1,8); \
    GAPB(o[1]=__builtin_amdgcn_mfma_f32_32x32x16_bf16(PAF(3),VFR(7),o[1],0,0,0), C1,12); \
    }while(0)
  int t=1;
  #undef CMASK
  #define CMASK(P0,P1,t) do{}while(0)
  for(;t+5<NT;t+=2){
    STEP(pB0,pB1,pA0,pA1,t,true,true,true);     WAIT_BAR(2); RESC(); ROT();
    STEP(pA0,pA1,pB0,pB1,t+1,true,true,true);   WAIT_BAR(2); RESC(); ROT();
  }
  #undef CMASK
  #define CMASK(P0,P1,t) do{}while(0)
  #define ENDW(tt) do{ if((tt)+3<NT){WAIT_BAR(2);} else if((tt)+2<NT){WAIT_BAR(1);} else {WAIT_BAR(0);} }while(0)
  for(;t+1<NT;t+=2){
    STEP(pB0,pB1,pA0,pA1,t,(t+3<NT),(t+1<NT),(t+1<NT));       ENDW(t);   RESC(); ROT();
    STEP(pA0,pA1,pB0,pB1,t+1,(t+4<NT),(t+2<NT),(t+2<NT));     ENDW(t+1); RESC(); ROT();
  }
  STEP(pB0,pB1,pA0,pA1,NT-1,false,false,false); RESC();
  { float sacc=pB0[0]+pB0[1]; _Pragma("unroll") for(int r=2;r<16;++r)sacc+=pB0[r]; _Pragma("unroll") for(int r=0;r<16;++r)sacc+=pB1[r]; l_reg+=sacc;
    pw0=(u32x4){PKW(pB0,0),PKW(pB0,2),PKW(pB0,4),PKW(pB0,6)};pw1=(u32x4){PKW(pB0,8),PKW(pB0,10),PKW(pB0,12),PKW(pB0,14)};pw2=(u32x4){PKW(pB1,0),PKW(pB1,2),PKW(pB1,4),PKW(pB1,6)};pw3=(u32x4){PKW(pB1,8),PKW(pB1,10),PKW(pB1,12),PKW(pB1,14)};
    SBAR(); pv(o,vb0+sl_cur,PAF(0),PAF(1),PAF(2),PAF(3)); }
  #undef PKW
  #undef PAF
  #undef VFR
  #undef PIN
  #undef MX3
  #undef GAPA
  #undef GAPB
  #undef EX
  #undef VRD
  #undef KRD
  #undef STEP
  #undef ENDW
  {auto rr=__builtin_amdgcn_permlane32_swap(__float_as_uint(l_reg),__float_as_uint(l_reg),false,false);l_reg=__uint_as_float(rr[0])+__uint_as_float(rr[1]);}
  if(hi==0)wsf[32+r32]=l_reg;asm volatile("s_waitcnt lgkmcnt(0)":::"memory");
  float rli[16];
  #pragma unroll
  for(int r=0;r<16;++r)rli[r]=__builtin_amdgcn_rcpf(wsf[32+crow(r,hi)]);
  bf16*Ow=Ou+(long)(wid*QBLK)*PO;
  { bf16*stg=(bf16*)(shm+LDS_OST)+wid*2048;
    #pragma unroll
    for(int r=0;r<16;++r){const int orow=crow(r,hi);
      #pragma unroll
      for(int d0=0;d0<2;++d0)stg[orow*64+d0*32+r32]=__float2bfloat16(o[d0][r]*rli[r]);}
    asm volatile("s_waitcnt lgkmcnt(0)":::"memory");
    #pragma unroll
    for(int i=0;i<4;++i){const int row=i*8+(lane>>3),ch=lane&7; const u32x4 v=*(const u32x4*)(stg+row*64+ch*8); ATTN_STORE16(Ow+(long)row*PO+ch*8,v);} }
  asm volatile("s_waitcnt lgkmcnt(0)\n\ts_barrier":::"memory");
  #undef DMA_K
  #undef DMA_V
  #undef CMASK
  #undef START
  #undef RESC
  #undef ROT
}
constexpr int ATTN_LDS_BYTES=LDS_BYTES;
#undef SBAR
#undef WAIT_BAR
}
namespace attn_av {
using namespace attn_body;
#define SBAR() __builtin_amdgcn_sched_barrier(0)
#define WAIT_BAR(N) asm volatile("s_waitcnt vmcnt(" #N ") lgkmcnt(0)\n\ts_barrier":::"memory")
constexpr int KSLOT=8192, VSLOT=16384;
constexpr int AV_K=0, AV_V=NSLOT*KSLOT, AV_WS=AV_V+NSLOT*VSLOT, AV_ST=AV_WS+NW*64*4, AV_LDS_BYTES=AV_ST+NW*8192;
__device__ __forceinline__ void pv4(f32x16*o,int vb,bf16x8 pa0,bf16x8 pa1,bf16x8 pa2,bf16x8 pa3){
  #pragma unroll
  for(int d0=0;d0<4;++d0){s16x4 lo[4],hi[4];
    #pragma unroll
    for(int ks=0;ks<4;++ks){
      asm volatile("ds_read_b64_tr_b16 %0,%1 offset:%c2":"=&v"(lo[ks]):"v"(vb),"i"(d0*4096+ks*1024):"memory");
      asm volatile("ds_read_b64_tr_b16 %0,%1 offset:%c2":"=&v"(hi[ks]):"v"(vb),"i"(d0*4096+ks*1024+512):"memory");}
    asm volatile("s_waitcnt lgkmcnt(0)":::"memory");SBAR();
    #define PK(k) (bf16x8){lo[k][0],lo[k][1],lo[k][2],lo[k][3],hi[k][0],hi[k][1],hi[k][2],hi[k][3]}
    o[d0]=__builtin_amdgcn_mfma_f32_32x32x16_bf16(pa0,PK(0),o[d0],0,0,0);
    o[d0]=__builtin_amdgcn_mfma_f32_32x32x16_bf16(pa1,PK(1),o[d0],0,0,0);
    o[d0]=__builtin_amdgcn_mfma_f32_32x32x16_bf16(pa2,PK(2),o[d0],0,0,0);
    o[d0]=__builtin_amdgcn_mfma_f32_32x32x16_bf16(pa3,PK(3),o[d0],0,0,0);
    #undef PK
  }
}
template<int THRL,int EPI> __device__ __forceinline__ void attn_unit_v(const bf16*Qu,const bf16*__restrict__ Kh,const bf16*__restrict__ Vh,bf16*Ou,const long PO,const int NT,char*shm,const float lam,const float*__restrict__ gain,const float scale){
  int tid_l=threadIdx.x; asm volatile("":"+v"(tid_l)); const int tid=tid_l,lane=tid&63,r32=lane&31,hi=lane>>5; const int wid=__builtin_amdgcn_readfirstlane(tid>>6);
  const bf16*Qw=Qu+(long)(wid*QBLK)*PU;
  const unsigned lds0=(unsigned)(uintptr_t)shm;
  float*wsf=(float*)(shm+AV_WS)+wid*64;
  const bf16*ksrc=Kh+(long)lane*PU+wid*8;
  const bf16*vsrc=Vh+(long)(16*(wid&3)+(lane>>2))*PU+(wid>>2)*32+(lane&3)*8;
  const unsigned kdst=lds0+AV_K+wid*1024, vdst=lds0+AV_V+wid*1024;
  #define DMA_K(t,slot) glds16(ksrc+(long)(t)*KVBLK*PU,(unsigned)__builtin_amdgcn_readfirstlane(kdst+(slot)))
  #define DMA_V(t,slot) do{ glds16(vsrc+(long)(t)*KVBLK*PU,(unsigned)__builtin_amdgcn_readfirstlane(vdst+2*(slot))); glds16(vsrc+64+(long)(t)*KVBLK*PU,(unsigned)__builtin_amdgcn_readfirstlane(vdst+8192+2*(slot))); }while(0)
  const int vb0=(int)(lds0+AV_V)+((lane>>4)&1)*32+(lane&3)*8+(4*hi+((lane&15)>>2))*64;
  const char*Kbase=shm+AV_K; bf16x8 kf[8];
  const lds_cptr shm3=(lds_cptr)shm; const lds_cptr kp0=shm3+AV_K+hi*1024+r32*16; const lds_cptr vp0=shm3+AV_V+((lane>>4)&1)*32+(lane&3)*8+(4*hi+((lane&15)>>2))*64;

  DMA_K(0,0);DMA_V(0,0);DMA_K(1,KSLOT);
  bf16x8 qr[4];
  #pragma unroll
  for(int d0=0;d0<4;++d0)qr[d0]=*reinterpret_cast<const bf16x8*>(&Qw[(long)r32*PU+d0*16+hi*8]);
  float mhat=0.f,l_reg=0.f;f32x16 o[4];o[0]=f32x16{};o[1]=f32x16{};o[2]=f32x16{};o[3]=f32x16{};f32x16 negm=f32x16{};asm volatile("":"+v"(negm));
  bool resc=false;
  #define START(P0,P1) do{ const float rm=rowmax(P0,P1); resc=false; \
    { const float dl=rm; mhat=fadd_s(mhat,dl); \
      _Pragma("unroll") for(int r=0;r<16;++r){P0[r]=fsub_s(P0[r],dl);P1[r]=fsub_s(P1[r],dl);} \
      _Pragma("unroll") for(int r=0;r<16;++r)negm[r]=-mhat; asm volatile("":"+v"(negm)); } \
    _Pragma("unroll") for(int r=0;r<16;++r)P0[r]=__builtin_amdgcn_exp2f(P0[r]); }while(0)
  #define RESC() do{ if(resc){ asm volatile("s_waitcnt lgkmcnt(0)":::"memory"); \
      _Pragma("unroll") for(int d_=0;d_<4;++d_) _Pragma("unroll") for(int r=0;r<16;++r)o[d_][r]*=wsf[crow(r,hi)]; } }while(0)
  f32x16 pA0,pA1,pB0,pB1;
  int sl_prev=0,sl_cur=0,sl_next=KSLOT;
  #define ROT() do{sl_prev=sl_cur;sl_cur=sl_next;sl_next=(sl_next==(NSLOT-1)*KSLOT)?0:sl_next+KSLOT;}while(0)
  DMA_K(2,2*KSLOT);
  WAIT_BAR(3);
  qkt(pA0,pA1,Kbase,qr,negm,r32,hi);asm volatile("s_nop 15\n\ts_nop 7":"+v"(pA0),"+v"(pA1));
  START(pA0,pA1);
  _Pragma("unroll") for(int r=0;r<16;++r)pA1[r]=__builtin_amdgcn_exp2f(pA1[r]);
  WAIT_BAR(0);
  DMA_K(3,0);DMA_V(1,KSLOT);
  ROT();
  kload8(kf,kp0+sl_cur);
  WAIT_BAR(3);
  s16x4 vlo[8],vhi[8]; u32x4 pw0,pw1,pw2,pw3;
  #define PKW(P,B) cvtpk_s(P[B],P[B+1])
  #define PAF(k) __builtin_bit_cast(bf16x8,pw##k)
  #define VFR(i) (bf16x8){vlo[i][0],vlo[i][1],vlo[i][2],vlo[i][3],vhi[i][0],vhi[i][1],vhi[i][2],vhi[i][3]}
  #define PIN(x) asm volatile("":"+v"(x))
  #define MX3(a,b,c) __builtin_fmaxf(__builtin_fmaxf((a),(b)),(c))
  #define GAPA(MF,A0,A1,A2,A3,W0,W1,PW) do{ MF; sacc+=A0; sacc+=A1; sacc+=A2; sacc+=A3; PIN(sacc); W0; W1; PIN(PW); SBAR(); }while(0)
  #define EX(v) __builtin_amdgcn_exp2f(v)
  #define GAPB(MF,X,B) do{ MF; X[B]=EX(X[B]); X[B+1]=EX(X[B+1]); PIN(X); SBAR(); }while(0)
  #define VRD(i) do{ vlo[i]=vtr(vp_+(((i)>>2)*4096+((i)&3)*1024)); vhi[i]=vtr(vp_+(((i)>>2)*4096+((i)&3)*1024+512)); }while(0)
  #define VRD2(i) do{ vlo[i]=vtr(vp_+(8192+((i)>>2)*4096+((i)&3)*1024)); vhi[i]=vtr(vp_+(8192+((i)>>2)*4096+((i)&3)*1024+512)); }while(0)
  #define GAPB1(MF,I,X,B) do{ MF; VRD2(I); X[B]=EX(X[B]); X[B+1]=EX(X[B+1]); PIN(X); SBAR(); }while(0)
  #define KRD(G,j) do{ if(G){ kload2(kf,kp0+sl_next,j); SBAR(); } }while(0)
  #define MF32(a,b,c) __builtin_amdgcn_mfma_f32_32x32x16_bf16(a,b,c,0,0,0)
  #define STEP(C0,C1,P0,P1,t,GK,GV,GL) do{ SBAR(); \
    const lds_cptr vp_=vp0+2*sl_prev; \
    VRD(0); SBAR(); float sacc=(P0[0]+P0[1]); \
    GAPA(C0=MF32(kf[0],qr[0],negm), P0[2],P0[3],P0[4],P0[5],     pw0[0]=PKW(P0,0), pw0[1]=PKW(P0,2), pw0); \
    VRD(4); SBAR(); GAPA(C1=MF32(kf[1],qr[0],negm), P0[6],P0[7],P0[8],P0[9],     pw0[2]=PKW(P0,4), pw0[3]=PKW(P0,6), pw0); \
    VRD(1); SBAR(); GAPA(C0=MF32(kf[2],qr[1],C0),   P0[10],P0[11],P0[12],P0[13], pw1[0]=PKW(P0,8), pw1[1]=PKW(P0,10), pw1); \
    VRD(5); SBAR(); GAPA(C1=MF32(kf[3],qr[1],C1),   P0[14],P0[15],P1[0],P1[1],   pw1[2]=PKW(P0,12),pw1[3]=PKW(P0,14), pw1); \
    VRD(2); SBAR(); GAPA(C0=MF32(kf[4],qr[2],C0),   P1[2],P1[3],P1[4],P1[5],     pw2[0]=PKW(P1,0), pw2[1]=PKW(P1,2), pw2); \
    VRD(6); SBAR(); GAPA(C1=MF32(kf[5],qr[2],C1),   P1[6],P1[7],P1[8],P1[9],     pw2[2]=PKW(P1,4), pw2[3]=PKW(P1,6), pw2); \
    VRD(3); SBAR(); GAPA(C0=MF32(kf[6],qr[3],C0),   P1[10],P1[11],P1[12],P1[13], pw3[0]=PKW(P1,8), pw3[1]=PKW(P1,10), pw3); \
    VRD(7); SBAR(); GAPA(C1=MF32(kf[7],qr[3],C1),   P1[14],P1[15],0.f,0.f,       pw3[2]=PKW(P1,12),pw3[3]=PKW(P1,14), pw3); \
    l_reg+=sacc; \
    if(GK){DMA_K((t)+3,sl_cur);} if(GV){DMA_V((t)+1,sl_next);} \
    { float a=MX3(C0[0],C0[1],C1[0]),b=MX3(C0[2],C0[3],C1[1]); a=MX3(a,C1[2],C1[3]); \
      _Pragma("unroll") for(int r=4;r<16;r+=4){a=MX3(a,C0[r],C0[r+1]);b=MX3(b,C0[r+2],C0[r+3]);a=MX3(a,C1[r],C1[r+1]);b=MX3(b,C1[r+2],C1[r+3]);} \
      float rm=__builtin_fmaxf(a,b); { auto rr=__builtin_amdgcn_permlane32_swap(__float_as_uint(rm),__float_as_uint(rm),false,false); rm=__builtin_fmaxf(__uint_as_float(rr[0]),__uint_as_float(rr[1])); } \
      resc=false; \
      if(__builtin_expect(__any(rm>(float)THRL),0)){ const float dl=__builtin_fmaxf(rm,0.f); mhat+=dl; \
        _Pragma("unroll") for(int r=0;r<16;++r){C0[r]-=dl;C1[r]-=dl;} \
        _Pragma("unroll") for(int r=0;r<16;++r)negm[r]=-mhat; asm volatile("":"+v"(negm)); \
        const float f=__builtin_amdgcn_exp2f(-dl); l_reg*=f; if(hi==0)wsf[r32]=f; resc=true; } } \
    SBAR(); \
    GAPB1(o[0]=MF32(PAF(0),VFR(0),o[0]), 0, C0,0); \
    GAPB1(o[1]=MF32(PAF(0),VFR(4),o[1]), 4, C0,2); \
    GAPB1(o[0]=MF32(PAF(1),VFR(1),o[0]), 1, C0,4); \
    GAPB1(o[1]=MF32(PAF(1),VFR(5),o[1]), 5, C0,6); \
    GAPB1(o[0]=MF32(PAF(2),VFR(2),o[0]), 2, C0,8); \
    GAPB1(o[1]=MF32(PAF(2),VFR(6),o[1]), 6, C0,10); \
    GAPB1(o[0]=MF32(PAF(3),VFR(3),o[0]), 3, C0,12); \
    GAPB1(o[1]=MF32(PAF(3),VFR(7),o[1]), 7, C0,14); \
    GAPB(o[2]=MF32(PAF(0),VFR(0),o[2]), C1,0); \
    GAPB(o[3]=MF32(PAF(0),VFR(4),o[3]), C1,2); \
    KRD(GL,0); GAPB(o[2]=MF32(PAF(1),VFR(1),o[2]), C1,4); \
    KRD(GL,1); GAPB(o[3]=MF32(PAF(1),VFR(5),o[3]), C1,6); \
    KRD(GL,2); GAPB(o[2]=MF32(PAF(2),VFR(2),o[2]), C1,8); \
    KRD(GL,3); GAPB(o[3]=MF32(PAF(2),VFR(6),o[3]), C1,10); \
    GAPB(o[2]=MF32(PAF(3),VFR(3),o[2]), C1,12); \
    GAPB(o[3]=MF32(PAF(3),VFR(7),o[3]), C1,14); \
    }while(0)
  int t=1;
  for(;t+5<NT;t+=2){
    STEP(pB0,pB1,pA0,pA1,t,true,true,true);     WAIT_BAR(3); RESC(); ROT();
    STEP(pA0,pA1,pB0,pB1,t+1,true,true,true);   WAIT_BAR(3); RESC(); ROT();
  }
  #define ENDW(tt) do{ if((tt)+3<NT){WAIT_BAR(3);} else if((tt)+2<NT){WAIT_BAR(2);} else {WAIT_BAR(0);} }while(0)
  for(;t+1<NT;t+=2){
    STEP(pB0,pB1,pA0,pA1,t,(t+3<NT),(t+1<NT),(t+1<NT));       ENDW(t);   RESC(); ROT();
    STEP(pA0,pA1,pB0,pB1,t+1,(t+4<NT),(t+2<NT),(t+2<NT));     ENDW(t+1); RESC(); ROT();
  }
  STEP(pB0,pB1,pA0,pA1,NT-1,false,false,false); RESC();
  { float sacc=pB0[0]+pB0[1]; _Pragma("unroll") for(int r=2;r<16;++r)sacc+=pB0[r]; _Pragma("unroll") for(int r=0;r<16;++r)sacc+=pB1[r]; l_reg+=sacc;
    pw0=(u32x4){PKW(pB0,0),PKW(pB0,2),PKW(pB0,4),PKW(pB0,6)};pw1=(u32x4){PKW(pB0,8),PKW(pB0,10),PKW(pB0,12),PKW(pB0,14)};pw2=(u32x4){PKW(pB1,0),PKW(pB1,2),PKW(pB1,4),PKW(pB1,6)};pw3=(u32x4){PKW(pB1,8),PKW(pB1,10),PKW(pB1,12),PKW(pB1,14)};
    SBAR(); pv4(o,vb0+2*sl_cur,PAF(0),PAF(1),PAF(2),PAF(3)); }
  #undef PKW
  #undef PAF
  #undef VFR
  #undef PIN
  #undef MX3
  #undef GAPA
  #undef GAPB
  #undef GAPB1
  #undef EX
  #undef VRD
  #undef VRD2
  #undef KRD
  #undef MF32
  #undef STEP
  #undef ENDW
  {auto rr=__builtin_amdgcn_permlane32_swap(__float_as_uint(l_reg),__float_as_uint(l_reg),false,false);l_reg=__uint_as_float(rr[0])+__uint_as_float(rr[1]);}
  if(hi==0)wsf[32+r32]=l_reg;asm volatile("s_waitcnt lgkmcnt(0)":::"memory");
  float rli[16];
  #pragma unroll
  for(int r=0;r<16;++r)rli[r]=__builtin_amdgcn_rcpf(wsf[32+crow(r,hi)]);
  unsigned*stw=(unsigned*)(shm+AV_ST)+wid*2048;
  if constexpr(EPI==1){
    #pragma unroll
    for(int d0=0;d0<4;++d0)
      #pragma unroll
      for(int r=0;r<16;r+=2)stw[(d0*8+(r>>1))*64+lane]=cvtpk_s(o[d0][r]*rli[r],o[d0][r+1]*rli[r+1]);
  } else {
    unsigned s1[32];
    #pragma unroll
    for(int j=0;j<32;++j)s1[j]=stw[j*64+lane];
    const float g0=gain[r32],g1=gain[32+r32],g2=gain[64+r32],g3=gain[96+r32];
    asm volatile("s_waitcnt lgkmcnt(0)":::"memory");
    float ss[16];
    #pragma unroll
    for(int r=0;r<16;++r){ float a=0.f;
      #pragma unroll
      for(int d0=0;d0<4;++d0){ const unsigned w=s1[d0*8+(r>>1)]; const float o1=(r&1)?__uint_as_float(w&0xffff0000u):__uint_as_float(w<<16);
        const float d=o1-lam*(o[d0][r]*rli[r]); o[d0][r]=d; a+=d*d; }
      ss[r]=a; }
    #pragma unroll
    for(int r=0;r<16;++r){
      #pragma unroll
      for(int sft=1;sft<32;sft<<=1)ss[r]+=__builtin_bit_cast(float,__builtin_amdgcn_ds_bpermute((lane^sft)<<2,__builtin_bit_cast(int,ss[r])));
      ss[r]=scale/sqrtf(ss[r]*(1.f/128.f)+1e-6f); }
    bf16*Ow=Ou+(long)(wid*QBLK)*PO;
    bf16*stg=(bf16*)stw;
    #pragma unroll
    for(int hf=0;hf<2;++hf){
      #pragma unroll
      for(int r=0;r<16;++r){const int orow=crow(r,hi);
        stg[orow*64+r32]=__float2bfloat16(o[2*hf][r]*ss[r]*(hf?g2:g0)); stg[orow*64+32+r32]=__float2bfloat16(o[2*hf+1][r]*ss[r]*(hf?g3:g1));}
      asm volatile("s_waitcnt lgkmcnt(0)":::"memory");
      #pragma unroll
      for(int i=0;i<4;++i){const int row=i*8+(lane>>3),ch=lane&7; const u32x4 v=*(const u32x4*)(stg+row*64+ch*8); *(u32x4*)(Ow+(long)row*PO+hf*64+ch*8)=v;}
      asm volatile("s_waitcnt lgkmcnt(0)":::"memory"); } }
  asm volatile("s_waitcnt lgkmcnt(0)\n\ts_barrier":::"memory");
  #undef DMA_K
  #undef DMA_V
  #undef START
  #undef RESC
  #undef ROT
}
#undef SBAR
#undef WAIT_BAR
}
constexpr int NWAVES = 8;
constexpr int DM = 2048, DFF = 5632, NU = 8960, NMIX = 3072, DEPTH = 2;
constexpr int NTOK = 65536, CH = 16384, NCHUNK = 4;
constexpr int NIN_SRC = 8224;
constexpr float EPS = 1e-6f;
constexpr float C2 = 0.18033688011112042f;
constexpr int U_AQ = 0, U_AK = 768, U_AV = 1536, U_BQ = 2304, U_BK = 3072, U_BV = 3840, U_CQ = 4608, U_CK = 4992, U_CV = 5376, U_CG = 6144, U_GF = 6912, U_GB = 7296, U_DQ = 7680, U_DK = 8448, U_DV = 8704;

constexpr size_t MiB = 1u << 20;
constexpr size_t WS_CTL = 0, CTL_ZERO_BYTES = 6 * MiB;
constexpr size_t WS_TAB = 1 * MiB;
constexpr size_t WS_TAB_AX = WS_TAB + 8192 * 8 * 8;
constexpr size_t WS_RSS = 2 * MiB;
constexpr size_t WS_W = 6 * MiB;
constexpr size_t W_GU1 = 0, W_D1 = 44 * MiB, W_IN = 66 * MiB, W_OUT = 101 * MiB, W_GU2 = 113 * MiB, W_D2 = 157 * MiB, W_LAYER = 179 * MiB;
constexpr size_t WS_XN = WS_W + 2 * W_LAYER;
constexpr size_t WS_U = WS_XN + 64 * MiB;
constexpr size_t WS_MIX = WS_U + 280 * MiB;
constexpr size_t WS_OA = WS_MIX + 96 * MiB;
constexpr size_t WS_BO = WS_OA;
constexpr size_t WS_BL = WS_BO + 72 * MiB;
constexpr size_t WS_OC = WS_BL + 3 * MiB;
constexpr size_t WS_END = WS_OC + 96 * MiB;
constexpr int CW_BAR = 4096;
constexpr int CW_Q = 16384;
constexpr int CW_LAM = 32768;

constexpr int RING_BYTES = 131072;
constexpr int MISC_OFF = 163328;
constexpr int LDS_BYTES = 163840;

#define GAS __attribute__((address_space(1)))
#define LAS __attribute__((address_space(3)))
#define DI __device__ __forceinline__
typedef unsigned short bfu;
typedef unsigned u32x4 __attribute__((ext_vector_type(4)));
typedef unsigned u32x2 __attribute__((ext_vector_type(2)));
typedef float f32x4 __attribute__((ext_vector_type(4)));
typedef float f32x2 __attribute__((ext_vector_type(2)));
typedef float f32x16 __attribute__((ext_vector_type(16)));
typedef short bf16x8 __attribute__((ext_vector_type(8)));
typedef short s16x4 __attribute__((ext_vector_type(4)));
typedef GAS unsigned gu32;
#define RLX_AGENT __ATOMIC_RELAXED, __HIP_MEMORY_SCOPE_AGENT
#define LDS_WAIT() asm volatile("s_waitcnt lgkmcnt(0)" ::: "memory")
#define VM_WAIT() asm volatile("s_waitcnt vmcnt(0)" ::: "memory")
DI unsigned f2bf(float f) { unsigned u = __builtin_bit_cast(unsigned, f); return (u + 0x7fffu + ((u >> 16) & 1u)) >> 16; }
DI unsigned pk2(float lo, float hi) { typedef __bf16 bf2_t __attribute__((ext_vector_type(2))); f32x2 v = {lo, hi}; bf2_t b = __builtin_convertvector(v, bf2_t); return __builtin_bit_cast(unsigned, b); }
DI float bflo(unsigned w) { return __builtin_bit_cast(float, w << 16); }
DI float bfhi(unsigned w) { return __builtin_bit_cast(float, w & 0xffff0000u); }
DI float bf2f(bfu b) { return __builtin_bit_cast(float, (unsigned)b << 16); }
DI float lane_get(float v, int src_lane) { return __builtin_bit_cast(float, __builtin_amdgcn_ds_bpermute(src_lane << 2, __builtin_bit_cast(int, v))); }
DI float wave_sum(float v, int lane) {
#pragma unroll
    for (int o = 1; o < 64; o <<= 1) v += lane_get(v, lane ^ o);
    return v;
}
DI int crow(int r, int hi) { return (r & 3) + 8 * (r >> 2) + 4 * hi; }
DI bf16x8 pack8(const f32x16& x, int s) { u32x4 p; p.x = pk2(x[8 * s], x[8 * s + 1]); p.y = pk2(x[8 * s + 2], x[8 * s + 3]); p.z = pk2(x[8 * s + 4], x[8 * s + 5]); p.w = pk2(x[8 * s + 6], x[8 * s + 7]); return __builtin_bit_cast(bf16x8, p); }
typedef short v4i16_t __attribute__((ext_vector_type(4)));
DI s16x4 vtr(const LAS bfu* p) { return __builtin_bit_cast(s16x4, __builtin_amdgcn_ds_read_tr16_b64_v4i16((LAS v4i16_t*)p)); }
DI bf16x8 cat8(s16x4 lo, s16x4 hi) { return (bf16x8){lo[0], lo[1], lo[2], lo[3], hi[0], hi[1], hi[2], hi[3]}; }
#define MFMA32(a, b, c) __builtin_amdgcn_mfma_f32_32x32x16_bf16((a), (b), (c), 0, 0, 0)

#define XB_TMO      128
#define XB_XCNT(j)  (256  + 64 * (j))
#define XB_XSUB(j)  (1280 + 64 * (j))
#define XB_XGEN(j)  (2304 + 64 * (j))
#define XB_TOP      3328
#define XB_TOPGEN   3392
#define XCD_BAR_WORDS 3456
#define XB_SPIN_CAP (1u << 18)

__device__ __forceinline__ unsigned xb_ld(unsigned* p)              { return __hip_atomic_load(p, __ATOMIC_RELAXED, __HIP_MEMORY_SCOPE_AGENT); }
__device__ __forceinline__ unsigned xb_add(unsigned* p, unsigned v) { return __hip_atomic_fetch_add(p, v, __ATOMIC_RELAXED, __HIP_MEMORY_SCOPE_AGENT); }
__device__ __forceinline__ unsigned xb_xcc_id() { return (unsigned)__builtin_amdgcn_s_getreg((3 << 11) | 20) & 0xFu; }
#define XB_SPIN(cond, bar) do { unsigned _sp = 0; while (cond) { __builtin_amdgcn_s_sleep(1); \
    if ((++_sp & 255u) == 0u) { if (xb_ld(&(bar)[XB_TMO])) break; if (_sp > XB_SPIN_CAP) { atomicAdd(&(bar)[XB_TMO], 1u); break; } } } } while (0)

struct XcdBarrier {
    unsigned* bar; unsigned x;
    volatile LAS unsigned* st;
};

__device__ __forceinline__ XcdBarrier xcd_barrier_post(unsigned* bar, volatile LAS unsigned* st) {
    XcdBarrier b; b.bar = bar; b.x = xb_xcc_id(); b.st = st;
    if (threadIdx.x == 0) (void)xb_add(&bar[XB_XCNT(b.x)], 1u);
    return b;
}
__device__ __forceinline__ void xcd_barrier_complete(unsigned* bar, unsigned x, unsigned& nloc, unsigned& nx) {
    const unsigned G = gridDim.x * gridDim.y * gridDim.z;
    unsigned sum, cnt, mine, sp = 0u;
    for (;;) {
        sum = 0u; cnt = 0u; mine = 0u;
#pragma unroll
        for (unsigned j = 0; j < 16; ++j) { const unsigned c = xb_ld(&bar[XB_XCNT(j)]); sum += c; cnt += (c > 0u) ? 1u : 0u; mine = (j == x) ? c : mine; }
        if (sum == G) break;
        __builtin_amdgcn_s_sleep(1);
        if ((++sp & 255u) == 0u) { if (xb_ld(&bar[XB_TMO])) break; if (sp > XB_SPIN_CAP) { atomicAdd(&bar[XB_TMO], 1u); break; } }
    }
    nloc = mine > 0u ? mine : 1u; nx = cnt > 0u ? cnt : 1u;
}

__device__ __forceinline__ void xcd_barrier(const XcdBarrier& b) {
    asm volatile("s_waitcnt vmcnt(0)" ::: "memory");
    __syncthreads();
    if (threadIdx.x == 0) {
        GAS unsigned* gbar_ = (GAS unsigned*)b.bar; asm volatile("" : "+s"(gbar_)); unsigned* bar = (unsigned*)gbar_; unsigned bx_ = b.x; asm volatile("" : "+s"(bx_));
        __builtin_amdgcn_s_waitcnt(0);
        unsigned nloc = b.st[0], nx = b.st[1];
        if (nloc == 0u) { xcd_barrier_complete(bar, bx_, nloc, nx); b.st[0] = nloc; b.st[1] = nx; }
        const unsigned old = xb_add(&bar[XB_XSUB(bx_)], 1u);
        const unsigned gen = old / nloc;
        if (old + 1u == (gen + 1u) * nloc) {
            __builtin_amdgcn_fence(__ATOMIC_RELEASE, "agent");
            asm volatile("s_waitcnt vmcnt(0)" ::: "memory");
            const unsigned og = xb_add(&bar[XB_TOP], 1u);
            const unsigned tg = og / nx;
            if (og + 1u == (tg + 1u) * nx) xb_add(&bar[XB_TOPGEN], 1u);
            else XB_SPIN(xb_ld(&bar[XB_TOPGEN]) == tg, bar);
            __builtin_amdgcn_fence(__ATOMIC_ACQUIRE, "agent");
            xb_add(&bar[XB_XGEN(bx_)], 1u);
            asm volatile("s_waitcnt vmcnt(0)" ::: "memory");
        } else {
            XB_SPIN(xb_ld(&bar[XB_XGEN(bx_)]) == gen, bar);
            __builtin_amdgcn_fence(__ATOMIC_ACQUIRE, "agent");
            asm volatile("s_waitcnt vmcnt(0)" ::: "memory");
        }
    }
    __syncthreads();
}
struct Frame {
    LAS unsigned char* lds;
    volatile LAS unsigned* MISC;
    gu32* ctl;
    int tid, lane, wave;
    int vcu, G;
};
struct Args { const float* in[28]; };

DI int tr_rowmap(int d, int rmap) { return rmap == 1 ? ((d >= 4 && d < 8) ? d + 4 : ((d >= 8 && d < 12) ? d - 4 : d)) : (rmap == 2 ? 8 * ((d >> 2) & 3) + 4 * (d >> 4) + (d & 3) : d); }
DI void tr_item(const float* W, size_t ldw, int k0, int nsrc0, bfu* WT, size_t Kd, int dstrow0, float scale, const float* kgain, LAS float* scr, int lane, int rmap = 0) {
    { float v[32];
      const float* wp = W + (size_t)(k0 + (lane >> 5)) * ldw + nsrc0 + (lane & 31);
#pragma unroll
      for (int i = 0; i < 32; ++i) v[i] = wp[(size_t)(2 * i) * ldw];
      if (kgain) {
#pragma unroll
          for (int i = 0; i < 32; ++i) v[i] *= scale * kgain[k0 + 2 * i + (lane >> 5)];
      } else {
#pragma unroll
          for (int i = 0; i < 32; ++i) v[i] *= scale;
      }
#pragma unroll
      for (int i = 0; i < 32; ++i) scr[(2 * i + (lane >> 5)) * 33 + (lane & 31)] = v[i]; }
    LDS_WAIT(); asm volatile("" ::: "memory");
    const int c = lane & 7;
#pragma unroll
    for (int j = 0; j < 4; ++j) { const int n = (lane >> 3) + 8 * j; const LAS float* s = scr + (8 * c) * 33 + n;
        u32x4 o; o.x = pk2(s[0 * 33], s[1 * 33]); o.y = pk2(s[2 * 33], s[3 * 33]); o.z = pk2(s[4 * 33], s[5 * 33]); o.w = pk2(s[6 * 33], s[7 * 33]);
        *(GAS u32x4*)(WT + (size_t)(dstrow0 + tr_rowmap(n, rmap)) * Kd + k0 + 8 * c) = o; }
    LDS_WAIT(); asm volatile("" ::: "memory");
}
DI void conv_gu(const float* Wg, const float* Wu, const float* kgain, bfu* WT, int r, LAS float* scr, int lane) {
    const int which = r / 5632, it = r % 5632, kb = it / 176, nb = it % 176, n0 = 32 * nb;
    tr_item(which ? Wu : Wg, DFF, 64 * kb, n0, WT, DM, 256 * (n0 / 128) + 128 * which + (n0 % 128), 1.0f, kgain, scr, lane);
}
DI void conv_down(const float* Wd, bfu* WT, int it, LAS float* scr, int lane) {
    const int kb = it / 64, nb = it % 64;
    tr_item(Wd, DM, 64 * kb, 32 * nb, WT, DFF, 32 * nb, 1.0f, nullptr, scr, lane);
}
DI void conv_in(const float* Wi, const float* kgain, bfu* WT, int it, LAS float* scr, int lane) {
    const int kb = it / 257, nb = it % 257, n0 = 32 * nb;
    const int dst = n0 < 6944 ? n0 : n0 + 736;
    const float sc = (n0 < 768 || (n0 >= 2304 && n0 < 3072)) ? C2 : 1.0f;
    const int rmap = ((n0 < 1536 || (n0 >= 2304 && n0 < 3840)) && (n0 & 63) == 0) ? 1 : ((n0 >= 6944 && n0 < 7968) ? 2 : 0);
    tr_item(Wi, NIN_SRC, 64 * kb, n0, WT, DM, dst, sc, kgain, scr, lane, rmap);
}
DI void conv_out(const float* Wo, bfu* WT, int it, LAS float* scr, int lane) {
    const int kb = it / 64, nb = it % 64;
    tr_item(Wo, DM, 64 * kb, 32 * nb, WT, NMIX, 32 * nb, 1.0f, nullptr, scr, lane);
}
DI void conv_gate(const float* Gf, const float* Gb, bfu* WT, int it) {
    const int r = it & 15, n = (it >> 4) % 384, dir = it / (16 * 384);
    (WT + (size_t)6944 * DM)[it] = (bfu)f2bf((dir ? Gb : Gf)[r * 384 + n]);
}
DI void sincos_d(double a, float& c, float& s) {
    const double k = rint(a * 0.15915494309189535);
    double r = fma(-k, 6.283185307179586, a); r = fma(-k, 2.4492935982947064e-16, r);
    const double r2 = r * r; double sv = 1.0, cv = 1.0;
#pragma unroll
    for (int n = 14; n >= 1; --n) { sv = 1.0 - sv * r2 * (1.0 / (double)((2 * n) * (2 * n + 1))); cv = 1.0 - cv * r2 * (1.0 / (double)((2 * n - 1) * (2 * n))); }
    s = (float)(sv * r); c = (float)cv;
}
__device__ const double INV_P[8] = {1.0, 0.19392274474868576, 0.03760603093086393, 0.007292664737217109, 0.001414213562373095, 0.0002742481756762073, 5.318295896944988e-05, 1.031338537721246e-05};
__device__ const double INV_AX[16] = {1.0, 0.5623413251903491, 0.31622776601683794, 0.1778279410038923, 0.1, 0.05623413251903491, 0.03162277660168379, 0.01778279410038923, 0.01, 0.005623413251903491, 0.0031622776601683794, 0.0017782794100389228, 0.001, 0.0005623413251903491, 0.00031622776601683794, 0.00017782794100389227};

DI void p0_prologue(Frame& F0, const Args& A) {
    Frame F = F0; F.tid = threadIdx.x; asm volatile("" : "+v"(F.tid), "+s"(F.wave), "+s"(F.vcu), "+s"(F.G)); F.lane = F.tid & 63;
    LAS float* scr = (LAS float*)(F.lds + F.wave * 16384);
    const int gw = F.vcu * NWAVES + F.wave, NGW = F.G * NWAVES;
    constexpr int I_GU = 2 * 5632, I_D = 5632, I_IN = 8224, I_OUT = 3072, I_LAYER = 2 * I_GU + 2 * I_D + I_IN + I_OUT;
    for (int it = gw; it < DEPTH * I_LAYER; it += NGW) {
        const int l = it / I_LAYER; int r = it % I_LAYER;
        bfu* wl = (bfu*)(((unsigned char*)A.in[27]) + WS_W + (size_t)l * W_LAYER);
        if (r < I_GU) { conv_gu(A.in[3] + (size_t)l * DM * DFF, A.in[4] + (size_t)l * DM * DFF, A.in[2] + l * DM, wl + W_GU1 / 2, r, scr, F.lane); continue; } r -= I_GU;
        if (r < I_D) { conv_down(A.in[5] + (size_t)l * DM * DFF, wl + W_D1 / 2, r, scr, F.lane); continue; } r -= I_D;
        if (r < I_IN) { conv_in(A.in[7] + (size_t)l * DM * NIN_SRC, A.in[6] + l * DM, wl + W_IN / 2, r, scr, F.lane); continue; } r -= I_IN;
        if (r < I_OUT) { conv_out(A.in[8] + (size_t)l * NMIX * DM, wl + W_OUT / 2, r, scr, F.lane); continue; } r -= I_OUT;
        if (r < I_GU) { conv_gu(A.in[22] + (size_t)l * DM * DFF, A.in[23] + (size_t)l * DM * DFF, A.in[21] + l * DM, wl + W_GU2 / 2, r, scr, F.lane); continue; } r -= I_GU;
        conv_down(A.in[24] + (size_t)l * DM * DFF, wl + W_D2 / 2, r, scr, F.lane);
    }
    const int gt = F.vcu * (NWAVES * 64) + F.tid, NGT = F.G * NWAVES * 64;
    for (int it = gt; it < DEPTH * 2 * 384 * 16; it += NGT) { const int l = it / (2 * 384 * 16), r = it % (2 * 384 * 16);
        conv_gate(A.in[14] + (size_t)l * 16 * 384, A.in[16] + (size_t)l * 16 * 384, (bfu*)(((unsigned char*)A.in[27]) + WS_W + (size_t)l * W_LAYER + W_IN), r); }
    f32x2* pcs = (f32x2*)(((unsigned char*)A.in[27]) + WS_TAB); f32x2* axcs = (f32x2*)(((unsigned char*)A.in[27]) + WS_TAB_AX);
    for (int it = gt; it < 8192 * 8 + 128 * 16; it += NGT) {
        float c, s;
        if (it < 8192 * 8) { sincos_d((double)(it >> 3) * INV_P[it & 7], c, s); pcs[it] = (f32x2){c, s}; }
        else { const int j = it - 8192 * 8; sincos_d((double)(j >> 4) * INV_AX[j & 15], c, s); axcs[j] = (f32x2){c, s}; }
    }
    if (blockIdx.x == 0 && F.wave == 0) {
#pragma unroll
        for (int l = 0; l < DEPTH; ++l) {
            const float a = wave_sum(A.in[9][l * 64 + F.lane] * A.in[10][l * 64 + F.lane], F.lane), b = wave_sum(A.in[11][l * 64 + F.lane] * A.in[12][l * 64 + F.lane], F.lane);
            const float lam_init = 0.8f - 0.6f * expf(-0.3f * (float)l);
            if (F.lane == 0) F.ctl[CW_LAM + l] = __builtin_bit_cast(unsigned, expf(a) - expf(b) + lam_init);
        }
    }
}

DI void cast_rows(Frame& F0, const float* x, bfu* xb, unsigned long long* rss) {
    Frame F = F0; F.tid = threadIdx.x; asm volatile("" : "+v"(F.tid), "+s"(F.wave), "+s"(F.vcu), "+s"(F.G)); F.lane = F.tid & 63;
    const int gw = F.vcu * NWAVES + F.wave, NGW = F.G * NWAVES;
    for (int m = gw; m < CH; m += NGW) {
        const f32x4* xr = (const f32x4*)(x + (size_t)m * DM) + F.lane;
        f32x4 v[8]; float s = 0.f;
#pragma unroll
        for (int j = 0; j < 8; ++j) { v[j] = xr[64 * j]; s += (v[j].x * v[j].x + v[j].y * v[j].y) + (v[j].z * v[j].z + v[j].w * v[j].w); }
        s = wave_sum(s, F.lane);
        u32x2* o8 = (u32x2*)(xb + (size_t)m * DM) + F.lane;
#pragma unroll
        for (int j = 0; j < 8; ++j) { u32x2 w; w.x = pk2(v[j].x, v[j].y); w.y = pk2(v[j].z, v[j].w); o8[64 * j] = w; }
        if (F.lane == 0) rss[m] = (unsigned long long)(s * 16777216.0f);
    }
}
DI void norm_cast_rows(Frame& F0, bfu* xb, const unsigned long long* rss_fin, const float* gain, float* yout, const float* xnext, unsigned long long* rss0) {
    Frame F = F0; F.tid = threadIdx.x; asm volatile("" : "+v"(F.tid), "+s"(F.wave), "+s"(F.vcu), "+s"(F.G)); F.lane = F.tid & 63;
    const int gw = F.vcu * NWAVES + F.wave, NGW = F.G * NWAVES;
    for (int m = gw; m < CH; m += NGW) {
        { const u32x4* xr = (const u32x4*)(xb + (size_t)m * DM) + F.lane;
          u32x4 v[4];
#pragma unroll
          for (int j = 0; j < 4; ++j) v[j] = xr[64 * j];
          const unsigned long long raw = __hip_atomic_load((const GAS unsigned long long*)(rss_fin + m), RLX_AGENT);
          const float rstd = 1.0f / sqrtf((float)raw * (1.0f / 16777216.0f) * (1.f / DM) + EPS);
          f32x4* yr = (f32x4*)(yout + (size_t)m * DM) + 2 * F.lane;
#pragma unroll
          for (int j = 0; j < 4; ++j) { const f32x4 g0 = ((const f32x4*)gain)[2 * (F.lane + 64 * j)], g1 = ((const f32x4*)gain)[2 * (F.lane + 64 * j) + 1];
              const f32x4 a = {bflo(v[j].x), bfhi(v[j].x), bflo(v[j].y), bfhi(v[j].y)}, b = {bflo(v[j].z), bfhi(v[j].z), bflo(v[j].w), bfhi(v[j].w)};
              yr[128 * j] = a * rstd * g0; yr[128 * j + 1] = b * rstd * g1; } }
        if (xnext) {
            asm volatile("" ::: "memory");
            const f32x4* xr = (const f32x4*)(xnext + (size_t)m * DM) + F.lane;
            f32x4 v[8]; float s = 0.f;
#pragma unroll
            for (int j = 0; j < 8; ++j) { v[j] = xr[64 * j]; s += (v[j].x * v[j].x + v[j].y * v[j].y) + (v[j].z * v[j].z + v[j].w * v[j].w); }
            s = wave_sum(s, F.lane);
            u32x2* o8 = (u32x2*)(xb + (size_t)m * DM) + F.lane;
#pragma unroll
            for (int j = 0; j < 8; ++j) { u32x2 w; w.x = pk2(v[j].x, v[j].y); w.y = pk2(v[j].z, v[j].w); o8[64 * j] = w; }
            if (F.lane == 0) rss0[m] = (unsigned long long)(s * 16777216.0f);
        }
    }
}

DI void clow_rows(Frame& F0, const bfu* XB, const unsigned long long* rss, const bfu* Wl, const bfu* GT, bfu* Uo, int R0) {
    Frame F = F0; F.tid = threadIdx.x; asm volatile("" : "+v"(F.tid), "+s"(F.wave)); F.lane = F.tid & 63;
    const int lane = F.lane, r32 = lane & 31, hi = lane >> 5, w = F.wave;
    LAS float* red = (LAS float*)F.lds;
    LAS float* cls = (LAS float*)(F.lds + 65536);
    { f32x16 acc[2] = {{}, {}};
      const bfu* a0 = XB + (size_t)(R0 + r32) * DM + 256 * w + 8 * hi; const bfu* a1 = a0 + (size_t)32 * DM; const bfu* bp = Wl + (size_t)r32 * DM + 256 * w + 8 * hi;
#pragma unroll
      for (int sb = 0; sb < 4; ++sb) { bf16x8 fa0[4], fa1[4], fb[4];
#pragma unroll
          for (int s = 0; s < 4; ++s) { const int k = 16 * (4 * sb + s); fa0[s] = *(const bf16x8*)(a0 + k); fa1[s] = *(const bf16x8*)(a1 + k); fb[s] = *(const bf16x8*)(bp + k); }
#pragma unroll
          for (int s = 0; s < 4; ++s) { acc[0] = MFMA32(fa0[s], fb[s], acc[0]); acc[1] = MFMA32(fa1[s], fb[s], acc[1]); } }
#pragma unroll
      for (int rb = 0; rb < 2; ++rb)
#pragma unroll
          for (int r = 0; r < 16; ++r) red[((w * 2 + rb) * 16 + r) * 64 + lane] = acc[rb][r]; }
    __syncthreads();
#pragma unroll
    for (int q = 0; q < 4; ++q) { const int o = F.tid + 512 * q, ol = o & 63, rr = (o >> 6) & 15, rb = o >> 10; float sum = 0.f;
#pragma unroll
        for (int ww = 0; ww < 8; ++ww) sum += red[ww * 2048 + o];
        const int row = 32 * rb + crow(rr, ol >> 5), col = ol & 31;
        const unsigned long long raw = __hip_atomic_load((const GAS unsigned long long*)(rss + R0 + row), RLX_AGENT);
        cls[row * 33 + col] = sum * (1.0f / sqrtf((float)raw * (1.0f / 16777216.0f) * (1.f / DM) + EPS)); }
    __syncthreads();
#pragma unroll
    for (int cc = 0; cc < 3; ++cc) { const int cb = 3 * w + cc, dir = cb / 12, n0 = 32 * (cb % 12);
        const bf16x8 gf = *(const bf16x8*)(GT + (size_t)(dir * 384 + n0 + r32) * 16 + 8 * hi);
#pragma unroll
        for (int rb = 0; rb < 2; ++rb) { const LAS float* cp = cls + (32 * rb + r32) * 33 + 16 * dir + 8 * hi;
            u32x4 yw; yw.x = pk2(cp[0], cp[1]); yw.y = pk2(cp[2], cp[3]); yw.z = pk2(cp[4], cp[5]); yw.w = pk2(cp[6], cp[7]);
            f32x16 d = {}; d = MFMA32(gf, __builtin_bit_cast(bf16x8, yw), d);
            bfu* op = Uo + (size_t)(R0 + 32 * rb + r32) * NU + 6912 + dir * 384 + n0 + 4 * hi;
#pragma unroll
            for (int g = 0; g < 4; ++g) { u32x2 v; v.x = pk2(d[4 * g], d[4 * g + 1]); v.y = pk2(d[4 * g + 2], d[4 * g + 3]); *(u32x2*)(op + 8 * g) = v; } } }
    __syncthreads();
}

#define BW_SWZ(row, col) ((row) * 64 + ((((col) >> 3) ^ ((row) & 7)) << 3) + ((col) & 7))
DI void bwin_task(const bfu* U, int seqrow0, int L, int hb, int dil, int idx, bfu* Bo, float* Bl, LAS unsigned char* wl, LAS float* lsc, int lane) {
    asm volatile("" : "+v"(lane));
    const int N = L / dil, qb = idx / dil, rr = idx % dil;
    const int r32 = lane & 31, hi = lane >> 5, q4 = (lane & 15) >> 2, g16 = (lane >> 4) & 1, p4 = lane & 3, il = lane >> 3, dc = lane & 7;
    const bfu* Qc = U + U_BQ + hb * 64; const bfu* Kc = U + U_BK + hb * 64; const bfu* Vc = U + U_BV + hb * 64 + 8 * (dc ^ il);
    const int kbase = 64 * (qb - 1);
    const unsigned lds0 = (unsigned)(size_t)wl;
#define B_ROW(sub) ((size_t)(seqrow0 + (sub) * dil + rr))
#define B_DMA(g, buf) do { _Pragma("unroll") for (int b_ = 0; b_ < 8; ++b_) { int kp_ = kbase + 64 * (g) + 8 * b_ + il; kp_ = kp_ < 0 ? 0 : (kp_ > N - 1 ? N - 1 : kp_); \
        attn_body::glds16(Vc + B_ROW(kp_) * NU, (unsigned)__builtin_amdgcn_readfirstlane(lds0 + (buf) * 8192 + b_ * 1024)); } } while (0)
    B_DMA(0, 0); B_DMA(1, 1);
    bf16x8 pf[2][5][2];
#define BW_MASK(A, KBI, KB) do { \
          \
        if ((KBI) == 0) { _Pragma("unroll") for (int i = 0; i < 16; ++i) A[i] = (crow(i, hi) >= r32) ? A[i] : -1e30f; } \
        if ((KBI) == 4) { _Pragma("unroll") for (int i = 0; i < 16; ++i) A[i] = (crow(i, hi) <= r32) ? A[i] : -1e30f; } \
        const int kb0_ = kbase + 32 * (KB); \
        if (kb0_ < 0 || kb0_ >= N) { _Pragma("unroll") for (int i = 0; i < 16; ++i) A[i] = -1e30f; } } while (0)
#define BW_SOFTMAX(tb, SC) do { float m = SC[0][0]; \
        _Pragma("unroll") for (int kbi = 0; kbi < 5; ++kbi) _Pragma("unroll") for (int i = 0; i < 16; ++i) m = fmaxf(m, SC[kbi][i]); \
        m = fmaxf(m, lane_get(m, lane ^ 32)); float l = 0.f; \
        _Pragma("unroll") for (int kbi = 0; kbi < 5; ++kbi) _Pragma("unroll") for (int i = 0; i < 16; ++i) { const float p = __builtin_amdgcn_exp2f(SC[kbi][i] - m); SC[kbi][i] = p; l += p; } \
        l += lane_get(l, lane ^ 32); \
        _Pragma("unroll") for (int kbi = 0; kbi < 5; ++kbi) { pf[tb][kbi][0] = pack8(SC[kbi], 0); pf[tb][kbi][1] = pack8(SC[kbi], 1); } \
        if (hi == 0) { lsc[32 * (tb) + r32] = l; Bl[B_ROW(64 * qb + 32 * (tb) + r32) * 12 + hb] = m + __builtin_amdgcn_logf(l); }   } while (0)
    { bf16x8 qf[2][4];
#pragma unroll
      for (int tb = 0; tb < 2; ++tb) { const bfu* qp = Qc + B_ROW(64 * qb + 32 * tb + r32) * NU + 8 * hi;
#pragma unroll
          for (int st = 0; st < 4; ++st) qf[tb][st] = *(const bf16x8*)(qp + 16 * st); }
      f32x16 sc0[5], sc1[5];
#pragma unroll
      for (int kb = 0; kb < 6; ++kb) {
          int kp = kbase + 32 * kb + r32; kp = kp < 0 ? 0 : (kp > N - 1 ? N - 1 : kp);
          const bfu* kr = Kc + B_ROW(kp) * NU + 8 * hi;
          const bf16x8 k0 = *(const bf16x8*)(kr), k1 = *(const bf16x8*)(kr + 16), k2 = *(const bf16x8*)(kr + 32), k3 = *(const bf16x8*)(kr + 48);
          if (kb <= 4) { f32x16 a = {}; a = MFMA32(k0, qf[0][0], a); a = MFMA32(k1, qf[0][1], a); a = MFMA32(k2, qf[0][2], a); a = MFMA32(k3, qf[0][3], a); BW_MASK(a, kb, kb); sc0[kb <= 4 ? kb : 0] = a; }
          if (kb >= 1) { f32x16 a = {}; a = MFMA32(k0, qf[1][0], a); a = MFMA32(k1, qf[1][1], a); a = MFMA32(k2, qf[1][2], a); a = MFMA32(k3, qf[1][3], a); BW_MASK(a, kb - 1, kb); sc1[kb >= 1 ? kb - 1 : 0] = a; }
          if (kb == 4) BW_SOFTMAX(0, sc0);
      }
      BW_SOFTMAX(1, sc1); }
#undef BW_MASK
#undef BW_SOFTMAX
    f32x16 o[2][2] = {{{}, {}}, {{}, {}}};
#pragma unroll
    for (int g = 0; g < 3; ++g) {
        if (g == 1) asm volatile("s_waitcnt vmcnt(8)" ::: "memory"); else asm volatile("s_waitcnt vmcnt(0)" ::: "memory");
        const LAS bfu* vv = (const LAS bfu*)(wl + (g & 1) * 8192);
#pragma unroll
        for (int tb = 0; tb < 2; ++tb)
#pragma unroll
            for (int kbl = 0; kbl < 2; ++kbl) { const int kbi = 2 * g + kbl - tb;
                if (kbi >= 0 && kbi <= 4) {
#pragma unroll
                    for (int s2 = 0; s2 < 2; ++s2)
#pragma unroll
                        for (int db = 0; db < 2; ++db) { const LAS bfu* vp = vv + BW_SWZ(32 * kbl + 16 * s2 + 4 * hi + q4, 32 * db + 16 * g16 + 4 * p4);
                            o[tb][db] = MFMA32(pf[tb][kbi][s2], cat8(vtr(vp), vtr(vp + 8 * 64)), o[tb][db]); }
                } }
        LDS_WAIT();
        if (g == 0) B_DMA(2, 0);
    }
#pragma unroll
    for (int tb = 0; tb < 2; ++tb)
#pragma unroll
        for (int i = 0; i < 16; ++i) { const int ql = crow(i, hi); const float inv = __builtin_amdgcn_rcpf(lsc[32 * tb + ql]);
            bfu* op = Bo + B_ROW(64 * qb + 32 * tb + ql) * 768 + hb * 64 + r32;
            op[0] = (bfu)f2bf(o[tb][0][i] * inv); op[32] = (bfu)f2bf(o[tb][1][i] * inv); }
    LDS_WAIT();
#undef B_ROW
#undef B_DMA
}

DI float logsig16(float x) { const float e = __builtin_amdgcn_exp2f(-1.4426950408889634f * fabsf(x)); return (fminf(x, 0.f) - 0.6931471805599453f * __builtin_amdgcn_logf(1.0f + e)) * 0.0625f; }
#define GLA_SWZ(row, col) ((row) * 64 + ((((col) >> 3) ^ ((row) & 7)) << 3) + ((col) & 7))
DI void gla_pre_item(const bfu* U, int seqrow0, int L, int hc, int dir, int c, const float* gbias, bfu* QDi, bfu* KIi, float* DECi, int lane) {
    const int il = lane >> 3, dc = lane & 7;
    const bfu* Qc = U + U_CQ + hc * 64 + 8 * dc; const bfu* Kc = U + U_CK + hc * 64 + 8 * dc; const bfu* Gc = U + (dir ? U_GB : U_GF) + hc * 64 + 8 * dc;
    const f32x4 b0 = *(const f32x4*)(gbias + hc * 64 + 8 * dc), b1 = *(const f32x4*)(gbias + hc * 64 + 8 * dc + 4);
    const float bias8[8] = {b0.x, b0.y, b0.z, b0.w, b1.x, b1.y, b1.z, b1.w};
#define G_ROW(p) ((size_t)(seqrow0 + (dir ? (L - 1 - (p)) : (p))))
    u32x4 aq[8], ak[8], ag[8];
#pragma unroll
    for (int bt = 0; bt < 8; ++bt) { const size_t rw = G_ROW(64 * c + 8 * bt + il) * NU; aq[bt] = *(const u32x4*)(Qc + rw); ak[bt] = *(const u32x4*)(Kc + rw); ag[bt] = *(const u32x4*)(Gc + rw); }
    float carry[8];
#pragma unroll
    for (int e = 0; e < 8; ++e) carry[e] = 0.f;
#pragma unroll
    for (int bt = 0; bt < 8; ++bt) {
        const u32x4 cq = aq[bt], ck = ak[bt], cg = ag[bt];
        float cum[8];
#pragma unroll
        for (int w = 0; w < 4; ++w) { cum[2 * w] = logsig16(bflo(cg[w]) + bias8[2 * w]); cum[2 * w + 1] = logsig16(bfhi(cg[w]) + bias8[2 * w + 1]); }
#pragma unroll
        for (int e = 0; e < 8; ++e) { float t = cum[e]; float y = lane_get(t, lane - 8); if (il >= 1) t += y; y = lane_get(t, lane - 16); if (il >= 2) t += y; y = lane_get(t, lane - 32); if (il >= 4) t += y; cum[e] = carry[e] + t; }
#pragma unroll
        for (int e = 0; e < 8; ++e) carry[e] = lane_get(cum[e], 56 + dc);
        u32x4 oq, ok;
#pragma unroll
        for (int w = 0; w < 4; ++w) {
            const float e0 = __builtin_amdgcn_exp2f(1.4426950408889634f * cum[2 * w]), e1 = __builtin_amdgcn_exp2f(1.4426950408889634f * cum[2 * w + 1]);
            oq[w] = pk2(bflo(cq[w]) * (0.125f * e0), bfhi(cq[w]) * (0.125f * e1));
            ok[w] = pk2(bflo(ck[w]) * __builtin_amdgcn_rcpf(e0), bfhi(ck[w]) * __builtin_amdgcn_rcpf(e1)); }
        const int off = (8 * bt + il) * 64 + 8 * (dc ^ il);
        *(u32x4*)(QDi + off) = oq; *(u32x4*)(KIi + off) = ok;
    }
    if (il == 0) { f32x4 d0, d1;
#pragma unroll
        for (int e = 0; e < 4; ++e) { d0[e] = __builtin_amdgcn_exp2f(1.4426950408889634f * carry[e]); d1[e] = __builtin_amdgcn_exp2f(1.4426950408889634f * carry[4 + e]); }
        *(f32x4*)(DECi + 8 * dc) = d0; *(f32x4*)(DECi + 8 * dc + 4) = d1; }
#undef G_ROW
}
DI void gla_pre_rows(Frame& F0, const bfu* U, int L, const float* bias_f, const float* bias_b, bfu* QD, bfu* KI, float* DEC) {
    Frame F = F0; F.tid = threadIdx.x; asm volatile("" : "+v"(F.tid), "+s"(F.wave), "+s"(F.vcu), "+s"(F.G)); F.lane = F.tid & 63;
    const int gw = F.vcu * NWAVES + F.wave, NGW = F.G * NWAVES, NC = L >> 6;
    for (int it = gw; it < (CH / 64) * 12; it += NGW) {
        const int c = it % NC, dir = (it / NC) & 1, hc = (it / (2 * NC)) % 6, sq = it / (12 * NC);
        gla_pre_item(U, sq * L, L, hc, dir, c, dir ? bias_b : bias_f, QD + (size_t)it * 4096, KI + (size_t)it * 4096, DEC + (size_t)it * 64, F.lane);
    }
}
DI void gla_task(const bfu* U, int seqrow0, int L, int hc, int dir, int half, const bfu* QD, const bfu* KI, const float* DEC, int item0, bfu* Oc, LAS unsigned char* wl, int lane) {
    asm volatile("" : "+v"(lane));
    const int r32 = lane & 31, hi = lane >> 5, q4 = (lane & 15) >> 2, g16 = (lane >> 4) & 1, p4 = lane & 3, il = lane >> 3, dc = lane & 7;
    LAS float* decl = (LAS float*)(wl + 49152);
    const bfu* Vc = U + U_CV + hc * 128 + half * 64 + 8 * (dc ^ il);
    f32x16 S[2][2] = {{{}, {}}, {{}, {}}};
    const int NC = L >> 6;
#define G_ROW(p) ((size_t)(seqrow0 + (dir ? (L - 1 - (p)) : (p))))
    const unsigned lds0 = (unsigned)(size_t)wl;
#define G_DMA(cc) do { const unsigned lb_ = lds0 + ((cc) & 1) * 24576; const bfu* qs_ = QD + (size_t)(item0 + (cc)) * 4096 + lane * 8; const bfu* ks_ = KI + (size_t)(item0 + (cc)) * 4096 + lane * 8; \
        _Pragma("unroll") for (int b_ = 0; b_ < 8; ++b_) { attn_body::glds16(qs_ + b_ * 512, (unsigned)__builtin_amdgcn_readfirstlane(lb_ + b_ * 1024)); attn_body::glds16(ks_ + b_ * 512, (unsigned)__builtin_amdgcn_readfirstlane(lb_ + 8192 + b_ * 1024)); \
            attn_body::glds16(Vc + G_ROW(64 * (cc) + 8 * b_ + il) * NU, (unsigned)__builtin_amdgcn_readfirstlane(lb_ + 16384 + b_ * 1024)); } } while (0)
    G_DMA(0);
    float dnext = DEC[(size_t)item0 * 64 + lane];
    for (int c = 0; c < NC; ++c) {
        asm volatile("s_waitcnt vmcnt(0)" ::: "memory");
        decl[lane] = dnext;
        if (c + 1 < NC) { G_DMA(c + 1); dnext = DEC[(size_t)(item0 + c + 1) * 64 + lane]; }
        const LAS bfu* qd = (const LAS bfu*)(wl + (c & 1) * 24576); const LAS bfu* ki = qd + 4096; const LAS bfu* vv = qd + 8192;
        LDS_WAIT();
        bf16x8 xf[3][2];
#pragma unroll
        for (int blk = 0; blk < 3; ++blk) { const int sb = blk == 2 ? 1 : 0, tb = blk >= 1 ? 1 : 0;
            f32x16 a = {};
#pragma unroll
            for (int st = 0; st < 4; ++st) { const bf16x8 af = *(const LAS bf16x8*)(ki + GLA_SWZ(32 * sb + r32, 16 * st + 8 * hi)); const bf16x8 bf = *(const LAS bf16x8*)(qd + GLA_SWZ(32 * tb + r32, 16 * st + 8 * hi));
                a = MFMA32(af, bf, a); }
            if (sb == tb) {
#pragma unroll
                for (int i = 0; i < 16; ++i) a[i] = (crow(i, hi) <= r32) ? a[i] : 0.f; }
            xf[blk][0] = pack8(a, 0); xf[blk][1] = pack8(a, 1); }
#pragma unroll
        for (int tb = 0; tb < 2; ++tb)
#pragma unroll
            for (int eb = 0; eb < 2; ++eb) {
                f32x16 o = {};
#pragma unroll
                for (int sb = 0; sb < 2; ++sb) { if (sb <= tb) { const int blk = sb == 0 ? tb : 2;
#pragma unroll
                    for (int s2 = 0; s2 < 2; ++s2) { const LAS bfu* vp = vv + GLA_SWZ(32 * sb + 16 * s2 + 4 * hi + q4, 32 * eb + 16 * g16 + 4 * p4);
                        o = MFMA32(xf[blk][s2], cat8(vtr(vp), vtr(vp + 8 * 64)), o); } } }
#pragma unroll
                for (int db = 0; db < 2; ++db)
#pragma unroll
                    for (int s2 = 0; s2 < 2; ++s2) { const int qrow = 32 * tb + r32, qcol = 32 * db + 16 * s2 + 4 * hi;
                        const bf16x8 af = cat8(*(const LAS s16x4*)(qd + GLA_SWZ(qrow, qcol)), *(const LAS s16x4*)(qd + GLA_SWZ(qrow, qcol + 8)));
                        o = MFMA32(af, pack8(S[db][eb], s2), o); }
#pragma unroll
                for (int i = 0; i < 16; i += 2) { const unsigned w = pk2(o[i], o[i + 1]);
                    Oc[G_ROW(64 * c + 32 * tb + crow(i, hi)) * 768 + hc * 128 + half * 64 + 32 * eb + r32] = (bfu)(w & 0xffffu); Oc[G_ROW(64 * c + 32 * tb + crow(i + 1, hi)) * 768 + hc * 128 + half * 64 + 32 * eb + r32] = (bfu)(w >> 16); }
            }
#pragma unroll
        for (int db = 0; db < 2; ++db)
#pragma unroll
            for (int eb = 0; eb < 2; ++eb) {
#pragma unroll
                for (int st = 0; st < 4; ++st) { const int srow = 16 * st + 8 * hi + q4, kcol = 32 * db + 16 * g16 + 4 * p4, vcol = 32 * eb + 16 * g16 + 4 * p4;
                    S[db][eb] = MFMA32(cat8(vtr(ki + GLA_SWZ(srow, kcol)), vtr(ki + GLA_SWZ(srow + 4, kcol))), cat8(vtr(vv + GLA_SWZ(srow, vcol)), vtr(vv + GLA_SWZ(srow + 4, vcol))), S[db][eb]); }
#pragma unroll
                for (int i = 0; i < 16; ++i) S[db][eb][i] *= decl[32 * db + crow(i, hi)];
            }
        LDS_WAIT();
    }
#undef G_ROW
#undef G_DMA
}

DI void finalize_rows(Frame& F0, const float* gain_a, const float* gain_c, int l, const bfu* U, const bfu* OA, const bfu* BO, const float* BL, const bfu* OC, bfu* MIX) {
    Frame F = F0; F.tid = threadIdx.x; asm volatile("" : "+v"(F.tid), "+s"(F.wave), "+s"(F.vcu), "+s"(F.G)); F.lane = F.tid & 63;
    const int lane = F.lane, hl = lane & 31, rsel = lane >> 5;
    const int gw = F.vcu * NWAVES + F.wave, NGW = F.G * NWAVES;
    const float lam = __builtin_bit_cast(float, (unsigned)F.ctl[CW_LAM + l]);
    const float lam_init = 0.8f - 0.6f * expf(-0.3f * (float)l);
    const f32x4 ga = ((const f32x4*)gain_a)[hl], gc = ((const f32x4*)gain_c)[hl];
#define HALF_SUM(v) do { _Pragma("unroll") for (int o_ = 1; o_ < 32; o_ <<= 1) v += lane_get(v, lane ^ o_); } while (0)
    for (int m2 = gw; m2 < CH / 2; m2 += NGW) {
        const size_t m = (size_t)(2 * m2 + rsel);
        u32x2 fw[6], bw[6], g2[6], b0[6], b1[6], b2[6]; float l0[6], l1[6], l2[6];
#pragma unroll
        for (int h = 0; h < 6; ++h) { fw[h] = *(const u32x2*)(OC + m * 768 + h * 128 + 4 * hl); bw[h] = *(const u32x2*)(OC + (size_t)CH * 768 + m * 768 + h * 128 + 4 * hl); g2[h] = *(const u32x2*)(U + m * NU + U_CG + h * 128 + 4 * hl); }
#pragma unroll
        for (int it = 0; it < 6; ++it) { const int h = 2 * it + (hl >> 4), col = h * 64 + 4 * (hl & 15);
            l0[it] = BL[m * 12 + h]; l1[it] = BL[(size_t)CH * 12 + m * 12 + h]; l2[it] = BL[(size_t)2 * CH * 12 + m * 12 + h];
            b0[it] = *(const u32x2*)(BO + m * 768 + col); b1[it] = *(const u32x2*)(BO + (size_t)CH * 768 + m * 768 + col); b2[it] = *(const u32x2*)(BO + (size_t)2 * CH * 768 + m * 768 + col); }
        asm volatile("" ::: "memory");
#pragma unroll
        for (int h = 0; h < 6; ++h) {
            const f32x4 y = {bflo(fw[h].x) + bflo(bw[h].x), bfhi(fw[h].x) + bfhi(bw[h].x), bflo(fw[h].y) + bflo(bw[h].y), bfhi(fw[h].y) + bfhi(bw[h].y)};
            float ss = (y.x * y.x + y.y * y.y) + (y.z * y.z + y.w * y.w); HALF_SUM(ss);
            const float rstd = 1.0f / sqrtf(ss * (1.f / 128.f) + EPS);
            u32x2 o; o.x = pk2(y.x * rstd * gc.x * pg8::silu_f(bflo(g2[h].x)), y.y * rstd * gc.y * pg8::silu_f(bfhi(g2[h].x))); o.y = pk2(y.z * rstd * gc.z * pg8::silu_f(bflo(g2[h].y)), y.w * rstd * gc.w * pg8::silu_f(bfhi(g2[h].y)));
            *(u32x2*)(MIX + m * NMIX + 1536 + h * 128 + 4 * hl) = o; }
#pragma unroll
        for (int it = 0; it < 6; ++it) { const int h = 2 * it + (hl >> 4), col = h * 64 + 4 * (hl & 15);
            const float mx = fmaxf(l0[it], fmaxf(l1[it], l2[it])); const float w0 = __builtin_amdgcn_exp2f(l0[it] - mx), w1 = __builtin_amdgcn_exp2f(l1[it] - mx), w2 = __builtin_amdgcn_exp2f(l2[it] - mx);
            const float inv = 1.0f / (w0 + w1 + w2);
            u32x2 o; o.x = pk2((w0 * bflo(b0[it].x) + w1 * bflo(b1[it].x) + w2 * bflo(b2[it].x)) * inv, (w0 * bfhi(b0[it].x) + w1 * bfhi(b1[it].x) + w2 * bfhi(b2[it].x)) * inv);
            o.y = pk2((w0 * bflo(b0[it].y) + w1 * bflo(b1[it].y) + w2 * bflo(b2[it].y)) * inv, (w0 * bfhi(b0[it].y) + w1 * bfhi(b1[it].y) + w2 * bfhi(b2[it].y)) * inv);
            *(u32x2*)(MIX + m * NMIX + 768 + col) = o; }
    }
#undef HALF_SUM
}

__global__ void __launch_bounds__(NWAVES * 64, 2) hybrid_fwd(Args args) {
    extern __shared__ __attribute__((aligned(16))) unsigned char lds[];
    Frame F;
    F.lds = (LAS unsigned char*)lds;
    F.MISC = (volatile LAS unsigned*)(F.lds + MISC_OFF);
    F.tid = 0; F.lane = 0; F.wave = __builtin_amdgcn_readfirstlane((int)threadIdx.x >> 6);
    F.G = gridDim.x; { const int bx = blockIdx.x; F.vcu = (F.G % 8 == 0) ? (bx % 8) * (F.G / 8) + bx / 8 : bx; }
    GAS unsigned char* ws = (GAS unsigned char*)args.in[27];
    F.ctl = (gu32*)(ws + WS_CTL);
    for (int u = threadIdx.x; u < (LDS_BYTES - RING_BYTES) / 4; u += NWAVES * 64) ((LAS unsigned*)(F.lds + RING_BYTES))[u] = 0u;
    __syncthreads();
    XcdBarrier bar = xcd_barrier_post((unsigned*)(F.ctl + CW_BAR), F.MISC + 8);
#if defined(PROBE)
#ifndef PROBE_BLK
#define PROBE_BLK 0
#endif
#ifdef PROBE_CYC
#define PROBE_NOW() (__builtin_readcyclecounter() / 20)
#else
#define PROBE_NOW() __builtin_amdgcn_s_memrealtime()
#endif
#define PROBE_MARK(bit) do { if (((PROBE) >> (bit)) & 1) { if (blockIdx.x == PROBE_BLK && threadIdx.x == 0) { const unsigned long long t_ = PROBE_NOW(); F.MISC[16] = (unsigned)t_; F.MISC[17] = (unsigned)(t_ >> 32); } } } while (0)
#define PROBE_ACC(bit) do { if (((PROBE) >> (bit)) & 1) { if (blockIdx.x == PROBE_BLK && threadIdx.x == 0) { const unsigned long long t_ = PROBE_NOW(); const unsigned long long m_ = ((unsigned long long)F.MISC[17] << 32) | F.MISC[16]; \
        unsigned long long a_ = ((unsigned long long)F.MISC[19] << 32) | F.MISC[18]; a_ += t_ - m_; F.MISC[18] = (unsigned)a_; F.MISC[19] = (unsigned)(a_ >> 32); } } } while (0)
#define PROBE_MARK2(bit) do { if (((PROBE) >> (bit)) & 1) { if (blockIdx.x == PROBE_BLK && threadIdx.x == 0) { const unsigned long long t_ = __builtin_amdgcn_s_memrealtime(); F.MISC[20] = (unsigned)t_; F.MISC[21] = (unsigned)(t_ >> 32); } } } while (0)
#define PROBE_ACC2(bit) do { if (((PROBE) >> (bit)) & 1) { if (blockIdx.x == PROBE_BLK && threadIdx.x == 0) { const unsigned long long t_ = __builtin_amdgcn_s_memrealtime(); const unsigned long long m_ = ((unsigned long long)F.MISC[21] << 32) | F.MISC[20]; \
        unsigned long long a_ = ((unsigned long long)F.MISC[19] << 32) | F.MISC[18]; a_ += t_ - m_; F.MISC[18] = (unsigned)a_; F.MISC[19] = (unsigned)(a_ >> 32); } } } while (0)
#else
#define PROBE_MARK(bit) do {} while (0)
#define PROBE_ACC(bit) do {} while (0)
#define PROBE_MARK2(bit) do {} while (0)
#define PROBE_ACC2(bit) do {} while (0)
#endif
    int zz = 0;
#define AIN(i) (args.in[(i) + zz])
#define BXO ({ int b_ = (int)blockIdx.x; asm volatile("" : "+s"(b_)); b_; })
#define BXO_G ({ int g_ = F.G; asm volatile("" : "+s"(g_)); g_; })
#define GRID_BAR() do { PROBE_MARK2(14); xcd_barrier(bar); PROBE_ACC2(14); asm volatile("" : "+s"(ws), "+s"(l), "+s"(c), "+s"(zz)); } while (0)

#define XN ((bfu*)(ws + WS_XN))
#define U ((bfu*)(ws + WS_U))
#define HID ((bfu*)(ws + WS_U))
#define MIX ((bfu*)(ws + WS_MIX))
#define OA ((bfu*)(ws + WS_OA))
#define BO ((bfu*)(ws + WS_BO))
#define BL ((float*)(ws + WS_BL))
#define OC ((bfu*)(ws + WS_OC))
#define RSS(j) ((unsigned long long*)(ws + WS_RSS) + (size_t)(c * 7 + (j)) * CH)
#define YCH ((unsigned char*)AIN(26) + (size_t)c * CH * DM * 4)
#define GQD ((bfu*)YCH)
#define GKI ((bfu*)(YCH + 25165824))
#define GDEC ((float*)(YCH + 50331648))
#define pcs ((const f32x2*)(ws + WS_TAB))
#define axcs ((const f32x2*)(ws + WS_TAB_AX))
#define WL ((const bfu*)(ws + WS_W + (size_t)l * W_LAYER))
#define XSRC(cc) (((cc) < 2) ? AIN(0) + (size_t)(cc) * CH * DM : AIN(1) + (size_t)((cc) - 2) * CH * DM)
#define L ((c < 2) ? 8192 : 2048)
#define nseq (CH / L)

    PROBE_MARK(8);
#ifndef NO_PRO
    p0_prologue(F, args);
#endif
    { int c = 0, l = 0;
      cast_rows(F, XSRC(0), XN, RSS(0));
      GRID_BAR(); }
    PROBE_ACC(8);
    for (int c = 0; c < NCHUNK; ++c) {
        int l = 0;
        for (l = 0; l < DEPTH; ++l) {

            PROBE_MARK(0);
            { pg8::Gemm g{XN, WL + W_GU1 / 2, CH, 2 * DFF, DM}; pg8::StaticOrder S; S.init(CH, 2 * DFF, BXO_G, BXO);
              pg8::EpiSwigluN E{HID, DFF, RSS(3 * l)};
              pg8::gemm_phase<pg8::EpiSwigluN, pg8::StaticOrder, true, true>(F.lds, g, S, E); }
            GRID_BAR();
            PROBE_ACC(0);
            PROBE_MARK(1);
            { pg8::Gemm g{HID, WL + W_D1 / 2, CH, DM, DFF}; pg8::PanelOrder S; S.S.init(CH, DM, BXO_G, BXO);
              pg8::EpiResidN<true> E{XN, DM, RSS(3 * l + 1)};
              pg8::gemm_phase<pg8::EpiResidN<true>, pg8::PanelOrder, true, true>(F.lds, g, S, E); }
            GRID_BAR();
            PROBE_ACC(1);

            PROBE_MARK(2);
            for (int R0 = 64 * BXO; R0 < CH; R0 += 64 * BXO_G) clow_rows(F, XN, RSS(3 * l + 1), WL + W_IN / 2 + (size_t)6912 * DM, WL + W_IN / 2 + (size_t)6944 * DM, U, R0);
            { pg8::Gemm g{XN, WL + W_IN / 2, CH, NU, DM}; pg8::SkipOrder S; S.S.init(CH, NU - 768, BXO_G, BXO);
              pg8::EpiPrepN E{U, NU, RSS(3 * l + 1), L - 1, (const float*)pcs, (const float*)axcs, AIN(19) + l * 64, AIN(20) + l * 64, (LAS float*)(F.lds + 132096), F.lds + 140288};
              pg8::gemm_phase<pg8::EpiPrepN, pg8::SkipOrder, true, true>(F.lds, g, S, E); }
            GRID_BAR();
            PROBE_ACC(2);
            PROBE_MARK(4);
            gla_pre_rows(F, U, L, AIN(15) + l * 384, AIN(17) + l * 384, GQD, GKI, GDEC);
            GRID_BAR();
            PROBE_ACC(4);

            PROBE_MARK(5);
            {
                gu32* qh = F.ctl + CW_Q + 64 * ((l * NCHUNK + c) * 4);
#define DEQUEUE(kind, var) do { if (threadIdx.x == 0) F.MISC[0] = __hip_atomic_fetch_add(qh + 64 * (kind), 1u, RLX_AGENT); __syncthreads(); var = (int)F.MISC[0]; __syncthreads(); } while (0)
#define DEQ_ISSUE(kind) do { if (threadIdx.x == 0) pend = __hip_atomic_fetch_add(qh + 64 * (kind), 1u, RLX_AGENT); } while (0)
#define DEQ_TAKE(var) do { if (threadIdx.x == 0) F.MISC[0] = pend; __syncthreads(); var = (int)F.MISC[0]; __syncthreads(); } while (0)
                const int n_gla = nseq * 24 / 2;
                PROBE_MARK(10);
                {
                for (;;) { int un; DEQUEUE(0, un); if (un >= n_gla) break;

                    if (F.wave < 2) { const int task = un * 2 + F.wave, half = task & 1, dir = (task >> 1) & 1, hc = (task >> 2) % 6, sq = task / 24;
#ifndef NO_GLA
                        gla_task(U, sq * L, L, hc, dir, half, GQD, GKI, GDEC, ((sq * 6 + hc) * 2 + dir) * (L >> 6), OC + (size_t)dir * CH * 768, F.lds + F.wave * 50176, (int)(threadIdx.x & 63));
#endif
 }
                } }
                PROBE_ACC(10); PROBE_MARK(11);
                const int nqb = L / 256, n_aa = nseq * 6 * nqb;
                { const float lam_a = __builtin_bit_cast(float, (unsigned)F.ctl[CW_LAM + l]), sc_a = 1.0f - (0.8f - 0.6f * expf(-0.3f * (float)l));
                for (;;) { int un; DEQUEUE(1, un); if (un >= n_aa) break;
                    const int sq = un / (6 * nqb), rem = un % (6 * nqb), a = rem / nqb, qb = rem % nqb;
                    const size_t r0 = (size_t)sq * L;
#ifndef NO_ATT
                    attn_av::attn_unit_v<8, 1>((const attn_body::bf16*)(U + (r0 + (size_t)qb * 256) * NU + U_AQ + a * 128), (const attn_body::bf16*)(U + r0 * NU + U_AK + a * 128),
                                            (const attn_body::bf16*)(U + r0 * NU + U_AV + a * 128), (attn_body::bf16*)nullptr, 0, L / 64, (char*)lds, 0.f, nullptr, 0.f);
                    attn_av::attn_unit_v<8, 2>((const attn_body::bf16*)(U + (r0 + (size_t)qb * 256) * NU + U_AQ + a * 128 + 64), (const attn_body::bf16*)(U + r0 * NU + U_AK + a * 128 + 64),
                                            (const attn_body::bf16*)(U + r0 * NU + U_AV + a * 128), (attn_body::bf16*)(MIX + (r0 + (size_t)qb * 256) * NMIX + a * 128), NMIX, L / 64, (char*)lds, lam_a, AIN(13) + l * 128, sc_a);
#endif
                } }
                PROBE_ACC(11); PROBE_MARK(12);
                const int n_ad = nseq * 12 * nqb;
                for (;;) { int un; DEQUEUE(3, un); if (un >= n_ad) break;
                    const int sq = un / (12 * nqb), rem = un % (12 * nqb), hq = rem / nqb, qb = rem % nqb;
                    const size_t r0 = (size_t)sq * L;
#ifndef NO_ATT
                    attn_body::attn_unit<8>((const attn_body::bf16*)(U + (r0 + (size_t)qb * 256) * NU + U_DQ + hq * 64), (const attn_body::bf16*)(U + r0 * NU + U_DK + (hq / 3) * 64), (const attn_body::bf16*)(U + r0 * NU + U_DV + (hq / 3) * 64),
                                            (attn_body::bf16*)(MIX + (r0 + (size_t)qb * 256) * NMIX + 2304 + hq * 64), NMIX, L / 64, (char*)lds);
#endif
                }
                PROBE_ACC(12); PROBE_MARK(13);
                const int tps = L / 64, n_b = nseq * 36 * tps / 8;
                { unsigned pend = 0u; DEQ_ISSUE(2);
                for (;;) { int un; DEQ_TAKE(un); if (un >= n_b) break; DEQ_ISSUE(2);
                    const int task = un * 8 + F.wave, idx = task % tps, pat = (task / tps) % 3, hb = (task / (3 * tps)) % 12, sq = task / (36 * tps);
#ifndef NO_B
                    bwin_task(U, sq * L, L, hb, pat == 0 ? 1 : (pat == 1 ? 4 : 16), idx, BO + (size_t)pat * CH * 768, BL + (size_t)pat * CH * 12, F.lds + F.wave * 16384, (LAS float*)(F.lds + 132096) + F.wave * 64, (int)(threadIdx.x & 63));
#endif
                } }
                PROBE_ACC(13);
#undef DEQUEUE
#undef DEQ_ISSUE
#undef DEQ_TAKE
            }
            GRID_BAR();
            PROBE_ACC(5);
            PROBE_MARK(6);
#ifndef NO_FIN
            finalize_rows(F, AIN(13) + l * 128, AIN(18) + l * 128, l, U, OA, BO, BL, OC, MIX);
#endif
            GRID_BAR();
            PROBE_ACC(6);
            PROBE_MARK(3);
            { pg8::Gemm g{MIX, WL + W_OUT / 2, CH, DM, NMIX}; pg8::PanelOrder S; S.S.init(CH, DM, BXO_G, BXO);
              pg8::EpiResidN<false> E{XN, DM, RSS(3 * l + 2)};
              pg8::gemm_phase<pg8::EpiResidN<false>, pg8::PanelOrder, true, true>(F.lds, g, S, E); }
            GRID_BAR();
            PROBE_ACC(3);

            PROBE_MARK(0);
            { pg8::Gemm g{XN, WL + W_GU2 / 2, CH, 2 * DFF, DM}; pg8::StaticOrder S; S.init(CH, 2 * DFF, BXO_G, BXO);
              pg8::EpiSwigluN E{HID, DFF, RSS(3 * l + 2)};
              pg8::gemm_phase<pg8::EpiSwigluN, pg8::StaticOrder, true, true>(F.lds, g, S, E); }
            GRID_BAR();
            PROBE_ACC(0);
            PROBE_MARK(1);
            { pg8::Gemm g{HID, WL + W_D2 / 2, CH, DM, DFF}; pg8::PanelOrder S; S.S.init(CH, DM, BXO_G, BXO);
              pg8::EpiResidN<true> E{XN, DM, RSS(3 * l + 3)};
              pg8::gemm_phase<pg8::EpiResidN<true>, pg8::PanelOrder, true, true>(F.lds, g, S, E); }
            GRID_BAR();
            PROBE_ACC(1);
        }
        PROBE_MARK(9);
        norm_cast_rows(F, XN, RSS(6), AIN(25), (float*)YCH, (c + 1 < NCHUNK) ? XSRC(c + 1) : (const float*)nullptr, (unsigned long long*)(ws + WS_RSS) + (size_t)((c + 1) * 7) * CH);
        if (c + 1 < NCHUNK) GRID_BAR();
        PROBE_ACC(9);
    }
#if defined(PROBE)
    if (blockIdx.x == PROBE_BLK && threadIdx.x == 0) {
        unsigned long long a_ = ((unsigned long long)F.MISC[19] << 32) | F.MISC[18];
        const unsigned long long t0_ = __builtin_amdgcn_s_memrealtime();
        while (__builtin_amdgcn_s_memrealtime() - t0_ < a_) __builtin_amdgcn_s_sleep(8);
    }
#endif
}
#undef AIN
#undef XN
#undef U
#undef HID
#undef MIX
#undef OA
#undef BO
#undef BL
#undef OC
#undef RSS
#undef GQD
#undef GKI
#undef GDEC
#undef pcs
#undef axcs
#undef WL
#undef XSRC
#undef YCH
#undef L
#undef nseq

extern "C" void kernel_launch(void* const* d_in, const int* in_sizes, int n_in, void* d_out, int out_size, void* d_ws, size_t ws_size, hipStream_t stream) {
    static int grid = 0;
    if (grid == 0) {
        if (n_in != 26 || out_size != NTOK * DM || ws_size < WS_END) { fprintf(stderr, "kernel_launch: built for 26 inputs, %d outputs, >= %zu bytes of workspace; got n_in %d, out %d, ws %zu; nothing launched\n", NTOK * DM, (size_t)WS_END, n_in, out_size, ws_size); grid = -1; return; }
        int dev = 0, cus = 0, per_cu = 0;
        if (hipGetDevice(&dev) != hipSuccess || hipDeviceGetAttribute(&cus, hipDeviceAttributeMultiprocessorCount, dev) != hipSuccess) { fprintf(stderr, "kernel_launch: device query failed\n"); grid = -1; return; }
        if (hipFuncSetAttribute((const void*)hybrid_fwd, hipFuncAttributeMaxDynamicSharedMemorySize, LDS_BYTES) != hipSuccess) { fprintf(stderr, "kernel_launch: hipFuncSetAttribute failed\n"); grid = -1; return; }
        if (hipOccupancyMaxActiveBlocksPerMultiprocessor(&per_cu, (const void*)hybrid_fwd, NWAVES * 64, LDS_BYTES) != hipSuccess || per_cu < 1)
            fprintf(stderr, "kernel_launch: note: occupancy query reports %d workgroups per CU\n", per_cu);
        (void)hipGetLastError();
        grid = cus;
    }
    if (grid < 0) return;
    if (hipMemsetAsync((char*)d_ws + WS_CTL, 0, CTL_ZERO_BYTES, stream) != hipSuccess) { fprintf(stderr, "kernel_launch: hipMemsetAsync failed\n"); return; }
    Args a{};
    for (int i = 0; i < 26; ++i) a.in[i] = (const float*)d_in[i];
    a.in[26] = (const float*)d_out; a.in[27] = (const float*)d_ws;
    hipLaunchKernelGGL(hybrid_fwd, dim3(grid), dim3(NWAVES * 64), LDS_BYTES, stream, a);
    const hipError_t le = hipPeekAtLastError();
    if (le != hipSuccess) fprintf(stderr, "kernel_launch: launch failed: %s\n", hipGetErrorName(le));
}
```

```cpp
#include <hip/hip_runtime.h>
#include <hip/hip_bf16.h>
#include <cstdio>
#include <cstdint>
#include <cmath>
namespace pg8 {
#define PG8_LAS __attribute__((address_space(3)))
typedef unsigned short bf16_t;
typedef short bf16x8 __attribute__((ext_vector_type(8)));
typedef float f32x4 __attribute__((ext_vector_type(4)));
typedef unsigned u32x4 __attribute__((ext_vector_type(4)));
constexpr int BM = 256, BK = 64, HALF = 128, HTB = HALF * BK * 2  , STAGE_BYTES = 8 * HTB, NXCD = 8, WGM = 8;

__host__ __device__ __forceinline__ int lds_byte(int r, int c) { const int st = (r >> 4) * 2 + (c >> 5), rr = r & 15, cc = c & 31, ob = rr * 64 + cc * 2; return st * 1024 + (ob ^ (((ob >> 9) & 1) << 5)); }
__host__ __device__ __forceinline__ void stage_rc(int b, int& R, int& C) { const int st = b / 1024, sb = b % 1024, swz = sb ^ (((sb >> 9) & 1) << 5); R = (st >> 1) * 16 + swz / 64; C = (st & 1) * 32 + (swz % 64) / 2; }
__host__ __device__ __forceinline__ int perm32(int rho) { const int n = rho >> 4, i = rho & 15; return 8 * (i >> 2) + 4 * n + (i & 3); }

struct Unit { int pm, pn; };
struct Gemm { const bf16_t* A; const bf16_t* Bt; int M, N, K; };

struct StaticOrder {
    int nM, nN, nwg, G, c;
    __host__ __device__ void init(int M, int N, int G_, int c_) { nM = M / BM; nN = N / BM; nwg = nM * nN; G = G_; c = c_; }
    __host__ __device__ bool next(int i, Unit& u) const {
        const long L = (long)i * G + c; if (L >= nwg) return false;
        int wgid = (int)L; { const int q = nwg / NXCD, r = nwg % NXCD, xcd = wgid % NXCD, off = wgid / NXCD; wgid = (xcd < r ? xcd * (q + 1) : r * (q + 1) + (xcd - r) * q) + off; }
        const int nig = WGM * nN, gid = wgid / nig, fm = gid * WGM, gsz = (nM - fm) < WGM ? (nM - fm) : WGM;
        u.pm = fm + ((wgid % nig) % gsz); u.pn = (wgid % nig) / gsz; return true;
    }
    __device__ __forceinline__ void a_ready(const Unit&) const {}
    __device__ __forceinline__ void done(const Unit&) const {}
};

struct PanelOrder {
    StaticOrder S;
    __device__ bool next(int i, Unit& u) const {
        const long L = (long)i * S.G + S.c; if (L >= S.nwg) return false;
        const int xcd = (int)L % NXCD, off = (int)L / NXCD;
        u.pn = off % S.nN; u.pm = xcd * WGM + off / S.nN; return true;
    }
    __device__ __forceinline__ void a_ready(const Unit&) const {}
    __device__ __forceinline__ void done(const Unit&) const {}
};
struct SkipOrder {
    StaticOrder S;
    __device__ bool next(int i, Unit& u) const { const bool ok = S.next(i, u); if (ok && u.pn >= 27) u.pn += 3; return ok; }
    __device__ __forceinline__ void a_ready(const Unit&) const {}
    __device__ __forceinline__ void done(const Unit&) const {}
};

__device__ __forceinline__ unsigned cvt_pk_bf16(float lo, float hi) { unsigned r; asm volatile("v_cvt_pk_bf16_f32 %0, %1, %2" : "=v"(r) : "v"(lo), "v"(hi)); return r; }
typedef float f32x2 __attribute__((ext_vector_type(2)));
__device__ __forceinline__ float silu_f(float g) { return g * __builtin_amdgcn_rcpf(1.0f + __builtin_amdgcn_exp2f(-1.4426950408889634f * g)); }

__device__ __forceinline__ float xlane(float v, int src_lane) { return __builtin_bit_cast(float, __builtin_amdgcn_ds_bpermute(src_lane << 2, __builtin_bit_cast(int, v))); }
__device__ __forceinline__ void rss_pre_load(const unsigned long long* rss, const Unit& u, int wr, int lane, unsigned long long (&raw)[2]) {
#pragma unroll
    for (int s = 0; s < 2; ++s) raw[s] = __hip_atomic_load((const __attribute__((address_space(1))) unsigned long long*)(rss + u.pm * BM + s * HALF + wr * 64 + lane), __ATOMIC_RELAXED, __HIP_MEMORY_SCOPE_AGENT);
}
__device__ __forceinline__ void row_rstd(const unsigned long long (&raw)[2], int fr, float (&rs)[2][4]) {
    float r[2];
#pragma unroll
    for (int s = 0; s < 2; ++s) r[s] = __builtin_amdgcn_rsqf((float)raw[s] * (1.0f / 16777216.0f) * (1.0f / 2048.0f) + 1e-6f);
#pragma unroll
    for (int ai = 0; ai < 2; ++ai)
#pragma unroll
        for (int m = 0; m < 4; ++m) rs[ai][m] = xlane(r[ai], m * 16 + fr);
}
struct EpiPrepN {
    static constexpr bool PERM = true, AFTER_DRAIN = false, PRE = true;
    bf16_t* O; int ldc; const unsigned long long* rss; int Lmask; const float* pcs; const float* axcs; const float* gq; const float* gk; PG8_LAS float* scr; PG8_LAS unsigned char* tab;
    __device__ __forceinline__ void pre_load(const Unit& u, int wr, int lane, unsigned long long (&raw)[2]) const {
        __builtin_amdgcn_s_barrier();
        rss_pre_load(rss, u, wr, lane, raw);
        int tid_o = threadIdx.x; asm volatile("" : "+v"(tid_o));
        const int pn = u.pn, wid = __builtin_amdgcn_readfirstlane(tid_o >> 6), T0 = (u.pm * BM) & Lmask; lane = tid_o & 63;
        if (pn < 6 || (pn >= 9 && pn < 15)) {
            const char* src = (const char*)(pcs + (size_t)T0 * 16) + lane * 16;
#pragma unroll
            for (int h = 0; h < 2; ++h) __builtin_amdgcn_global_load_lds((const unsigned*)(src + (wid + 8 * h) * 1024), (PG8_LAS unsigned*)(tab + (wid + 8 * h) * 1024), 16, 0, 0);
        } else if (pn >= 30 && pn < 34) {
            __builtin_amdgcn_global_load_lds((const unsigned*)((const char*)axcs + wid * 1024 + lane * 16), (PG8_LAS unsigned*)(tab + wid * 1024), 16, 0, 0);
            if (wid == 0) __builtin_amdgcn_global_load_lds((const unsigned*)((const char*)axcs + (T0 >> 6) * 128 + (lane & 31) * 16), (PG8_LAS unsigned*)(tab + 8192), 16, 0, 0);
        }
    }
    static __device__ __forceinline__ u32x4 pack8(const f32x4& v0, const f32x4& v1) { u32x4 w; w.x = cvt_pk_bf16(v0[0], v0[1]); w.y = cvt_pk_bf16(v0[2], v0[3]); w.z = cvt_pk_bf16(v1[0], v1[1]); w.w = cvt_pk_bf16(v1[2], v1[3]); return w; }
    typedef unsigned u32x2_ __attribute__((ext_vector_type(2)));
    static __device__ __forceinline__ void rot_store(const f32x4& x1, const f32x4& x2, const f32x4& q0, const f32x4& q1, bf16_t* p1, bf16_t* p2) {
        const f32x4 c = {q0[0], q0[2], q1[0], q1[2]}, sn = {q0[1], q0[3], q1[1], q1[3]};
        const f32x4 o1 = x1 * c - x2 * sn, o2 = x2 * c + x1 * sn;
        u32x2_ w1, w2; w1.x = cvt_pk_bf16(o1[0], o1[1]); w1.y = cvt_pk_bf16(o1[2], o1[3]); w2.x = cvt_pk_bf16(o2[0], o2[1]); w2.y = cvt_pk_bf16(o2[2], o2[3]);
        *(u32x2_*)p1 = w1; *(u32x2_*)p2 = w2;
    }
    __device__ __forceinline__ void operator()(const f32x4 (&acc)[2][2][4][2], const Unit& u, int wr, int wc, int fr, int fq, const unsigned long long (&raw)[2]) const {
        asm volatile("" : "+v"(fr), "+v"(fq));
        const int row0 = u.pm * BM + wr * 64 + fr; const int col0 = u.pn * BM + wc * 32 + 8 * fq; const int lane = fq * 16 + fr;
        float rs[2][4]; row_rstd(raw, fr, rs);
        const int pn = u.pn;
        const int mode = (pn < 6 || (pn >= 9 && pn < 15)) ? (((wc & 1) == 0) ? 1 : 0) : ((pn >= 30 && pn < 34) ? 2 : 0);
        if (mode == 0) {
#pragma unroll
            for (int ai = 0; ai < 2; ++ai)
#pragma unroll
                for (int m = 0; m < 4; ++m) { bf16_t* rowp = O + (size_t)(row0 + ai * HALF + m * 16) * ldc + col0; const float r = rs[ai][m];
#pragma unroll
                    for (int bj = 0; bj < 2; ++bj) *(u32x4*)(rowp + bj * HALF) = pack8(acc[ai][bj][m][0] * r, acc[ai][bj][m][1] * r); }
        } else if (mode == 1) {
            const bool rot = fq < 2;
#pragma unroll
            for (int ai = 0; ai < 2; ++ai)
#pragma unroll
                for (int m = 0; m < 4; ++m) { const int row = row0 + ai * HALF + m * 16; bf16_t* rowp = O + (size_t)row * ldc + col0; const float r = rs[ai][m];
                    const PG8_LAS f32x4* cs = (const PG8_LAS f32x4*)(tab + (ai * HALF + wr * 64 + m * 16 + fr) * 64 + 32 * (fq & 1)); const f32x4 q0 = cs[0], q1 = cs[1];
#pragma unroll
                    for (int bj = 0; bj < 2; ++bj) { const f32x4 v0 = acc[ai][bj][m][0] * r, v1 = acc[ai][bj][m][1] * r;
                        if (rot) rot_store(v0, v1, q0, q1, rowp + bj * HALF - 4 * fq, rowp + bj * HALF - 4 * fq + 8);
                        else *(u32x4*)(rowp + bj * HALF) = pack8(v0, v1); }
                    if (m & 1) asm volatile("" ::: "memory"); }
        } else {
#pragma unroll
            for (int ai = 0; ai < 2; ++ai)
#pragma unroll
                for (int m = 0; m < 4; ++m) { const float r = rs[ai][m];
#pragma unroll
                    for (int bj = 0; bj < 2; ++bj) { const f32x4 v0 = acc[ai][bj][m][0] * r, v1 = acc[ai][bj][m][1] * r;
                        float ss = (v0[0] * v0[0] + v0[1] * v0[1]) + (v0[2] * v0[2] + v0[3] * v0[3]) + (v1[0] * v1[0] + v1[1] * v1[1]) + (v1[2] * v1[2] + v1[3] * v1[3]);
                        ss += xlane(ss, lane ^ 16); ss += xlane(ss, lane ^ 32);
                        if (fq == 0) scr[(ai * HALF + wr * 64 + m * 16 + fr) * 8 + bj * 4 + wc] = ss; } }
            asm volatile("s_waitcnt lgkmcnt(0)\n\ts_barrier" ::: "memory");
            const bool isk = pn == 33; const float* gain = (isk ? gk : gq) + 32 * (wc & 1) + 4 * fq; const float qs = isk ? 1.0f : 0.18033688011112042f;
            const f32x4 g0 = *(const f32x4*)gain, g1 = *(const f32x4*)(gain + 16);
#pragma unroll
            for (int ai = 0; ai < 2; ++ai)
#pragma unroll
                for (int m = 0; m < 4; ++m) { const int row = row0 + ai * HALF + m * 16; bf16_t* rowp = O + (size_t)row * ldc + col0 - 4 * fq; const float r = rs[ai][m];
                    const int tl = ai * HALF + wr * 64 + m * 16 + fr;
                    const PG8_LAS f32x4* cs = (const PG8_LAS f32x4*)(tab + ((wc & 1) ? (tl & 63) * 128 : 8192 + (tl >> 6) * 128) + 32 * fq); const f32x4 q0 = cs[0], q1 = cs[1];
#pragma unroll
                    for (int bj = 0; bj < 2; ++bj) { const f32x2 so = *(const PG8_LAS f32x2*)(scr + (ai * HALF + wr * 64 + m * 16 + fr) * 8 + bj * 4 + (wc & 2));
                        const float rh = r * qs * __builtin_amdgcn_rsqf((so[0] + so[1]) * (1.0f / 64.0f) + 1e-6f);
                        rot_store(acc[ai][bj][m][0] * rh * g0, acc[ai][bj][m][1] * rh * g1, q0, q1, rowp + bj * HALF, rowp + bj * HALF + 16); }
                    if (m & 1) asm volatile("" ::: "memory"); }
        }
    }
};
struct EpiSwigluN {
    static constexpr bool PERM = true, AFTER_DRAIN = false, PRE = true;
    bf16_t* O; int ldc; const unsigned long long* rss;
    __device__ __forceinline__ void pre_load(const Unit& u, int wr, int lane, unsigned long long (&raw)[2]) const { rss_pre_load(rss, u, wr, lane, raw); }
    static __device__ __forceinline__ unsigned swiglu2(f32x2 ag, f32x2 au, float nr, float r2) {
        const f32x2 t = ag * nr; f32x2 e = {__builtin_amdgcn_exp2f(t[0]), __builtin_amdgcn_exp2f(t[1])};
        e = e + 1.0f; const f32x2 rc = {__builtin_amdgcn_rcpf(e[0]), __builtin_amdgcn_rcpf(e[1])};
        const f32x2 h = (ag * au) * (rc * r2); return cvt_pk_bf16(h[0], h[1]);
    }
    __device__ __forceinline__ void operator()(const f32x4 (&acc)[2][2][4][2], const Unit& u, int wr, int wc, int fr, int fq, const unsigned long long (&raw)[2]) const {
        const int row0 = u.pm * BM + wr * 64 + fr; const int col0 = u.pn * HALF + wc * 32 + 8 * fq;
        float rs[2][4]; row_rstd(raw, fr, rs);
#pragma unroll
        for (int ai = 0; ai < 2; ++ai)
#pragma unroll
            for (int m = 0; m < 4; ++m) { bf16_t* rowp = O + (size_t)(row0 + ai * HALF + m * 16) * ldc + col0; const float r = rs[ai][m], nr = -1.4426950408889634f * r, r2 = r * r;
                const f32x4 g0 = acc[ai][0][m][0], g1 = acc[ai][0][m][1], u0 = acc[ai][1][m][0], u1 = acc[ai][1][m][1];
                u32x4 w; w.x = swiglu2((f32x2){g0[0], g0[1]}, (f32x2){u0[0], u0[1]}, nr, r2); w.y = swiglu2((f32x2){g0[2], g0[3]}, (f32x2){u0[2], u0[3]}, nr, r2);
                w.z = swiglu2((f32x2){g1[0], g1[1]}, (f32x2){u1[0], u1[1]}, nr, r2); w.w = swiglu2((f32x2){g1[2], g1[3]}, (f32x2){u1[2], u1[3]}, nr, r2);
                *(u32x4*)rowp = w; }
    }
};
__device__ __forceinline__ float bf_lo(unsigned w) { return __builtin_bit_cast(float, w << 16); }
__device__ __forceinline__ float bf_hi(unsigned w) { return __builtin_bit_cast(float, w & 0xffff0000u); }
template <bool HALF_STEP> struct EpiResidN {
    static constexpr bool PERM = true, AFTER_DRAIN = false, PRE = false; static constexpr float alpha = HALF_STEP ? 0.5f : 1.0f;
    bf16_t* xb; int ldc; unsigned long long* rss;
    __device__ __forceinline__ void operator()(const f32x4 (&acc)[2][2][4][2], const Unit& u, int wr, int wc, int fr, int fq) const {
        asm volatile("" : "+v"(fr), "+v"(fq));
        const int row0 = u.pm * BM + wr * 64 + fr; const int col0 = u.pn * BM + wc * 32 + 8 * fq; const int lane = fq * 16 + fr;
        u32x4 b[2][4][2];
#pragma unroll
        for (int ai = 0; ai < 2; ++ai)
#pragma unroll
            for (int m = 0; m < 4; ++m)
#pragma unroll
                for (int bj = 0; bj < 2; ++bj) b[ai][m][bj] = *(const u32x4*)(xb + (size_t)(row0 + ai * HALF + m * 16) * ldc + col0 + bj * HALF);
        asm volatile("" ::: "memory");
#pragma unroll
        for (int ai = 0; ai < 2; ++ai) {
#pragma unroll
            for (int m = 0; m < 4; ++m) { const int row = row0 + ai * HALF + m * 16; const size_t off = (size_t)row * ldc + col0; float ss = 0.f;
#pragma unroll
                for (int bj = 0; bj < 2; ++bj) { const u32x4 bb = b[ai][m][bj];
                    const f32x4 b0 = {bf_lo(bb.x), bf_hi(bb.x), bf_lo(bb.y), bf_hi(bb.y)}, b1 = {bf_lo(bb.z), bf_hi(bb.z), bf_lo(bb.w), bf_hi(bb.w)};
                    const f32x4 o0 = b0 + acc[ai][bj][m][0] * alpha, o1 = b1 + acc[ai][bj][m][1] * alpha;
                    u32x4 w; w.x = cvt_pk_bf16(o0[0], o0[1]); w.y = cvt_pk_bf16(o0[2], o0[3]); w.z = cvt_pk_bf16(o1[0], o1[1]); w.w = cvt_pk_bf16(o1[2], o1[3]);
                    *(u32x4*)(xb + off + bj * HALF) = w;
                    ss += (o0[0] * o0[0] + o0[1] * o0[1]) + (o0[2] * o0[2] + o0[3] * o0[3]) + (o1[0] * o1[0] + o1[1] * o1[1]) + (o1[2] * o1[2] + o1[3] * o1[3]); }
                ss += xlane(ss, lane ^ 16); ss += xlane(ss, lane ^ 32);
                if (fq == 0) __hip_atomic_fetch_add((__attribute__((address_space(1))) unsigned long long*)(rss + row), (unsigned long long)(ss * 16777216.0f), __ATOMIC_RELAXED, __HIP_MEMORY_SCOPE_AGENT);
            }
        }
    }
};

template <class Epi, class Sched, bool ALIGN_EPI = false, bool SP2 = false>
__device__ __forceinline__ void gemm_phase(PG8_LAS unsigned char* lds, const Gemm g, const Sched& S, const Epi& E) {
    int tid_l = threadIdx.x; asm volatile("" : "+v"(tid_l));
    const int tid = tid_l, wid = __builtin_amdgcn_readfirstlane(tid >> 6), lane = tid & 63, wr = wid >> 2, wc = wid & 3, fr = lane & 15, fq = lane >> 4;
    const int K = g.K, nt = K / BK;
    unsigned voffA[2], voffB[2];
#pragma unroll
    for (int i = 0; i < 2; ++i) { int R, C; stage_rc(tid * 16 + i * 8192, R, C); const int Rb = Epi::PERM ? ((R & ~31) + perm32(R & 31)) : R;
        voffA[i] = (unsigned)(R * K + C) * 2u; voffB[i] = (unsigned)(Rb * K + C) * 2u; }
    const size_t kstep = (size_t)(BK * 2);
    const size_t hstep = (size_t)HALF * K * 2;
    const size_t tstep = 2 * hstep;
    const unsigned ldsw = (unsigned)wid * 1024u;
    const int aoff = lds_byte(wr * 64 + fr, fq * 8), boff = lds_byte(wc * 32 + fr, fq * 8);
#define PG8_SA(b, h) (((b) * 2 + (h)) * HTB)
#define PG8_SB(b, h) ((4 + (b) * 2 + (h)) * HTB)
#define PG8_STAGE(bufoff, gbase, voff) do { _Pragma("unroll") for (int _i = 0; _i < 2; ++_i) \
        __builtin_amdgcn_global_load_lds((const unsigned*)((const char*)(gbase) + (voff)[_i]), (PG8_LAS unsigned*)(lds + (bufoff) + ldsw + _i * 8192), 16, 0, 0); } while (0)
#define PG8_LDA(dst, b, h) do { _Pragma("unroll") for (int m = 0; m < 4; ++m) _Pragma("unroll") for (int k = 0; k < 2; ++k) dst[m][k] = *(const PG8_LAS bf16x8*)(lds + PG8_SA(b, h) + aoff + m * 2048 + k * 1024); } while (0)
#define PG8_LDB(dst, b, h) do { _Pragma("unroll") for (int n = 0; n < 2; ++n) _Pragma("unroll") for (int k = 0; k < 2; ++k) dst[n][k] = *(const PG8_LAS bf16x8*)(lds + PG8_SB(b, h) + boff + n * 2048 + k * 1024); } while (0)
#define PG8_MMA(ai, bj, At, Bt) do { __builtin_amdgcn_s_setprio(1); _Pragma("unroll") for (int m = 0; m < 4; ++m) _Pragma("unroll") for (int n = 0; n < 2; ++n) _Pragma("unroll") for (int k = 0; k < 2; ++k) \
        acc[ai][bj][m][n] = __builtin_amdgcn_mfma_f32_16x16x32_bf16(Bt[n][k], At[m][k], acc[ai][bj][m][n], 0, 0, 0); __builtin_amdgcn_s_setprio(0); } while (0)
#define PG8_WAIT_V(n) asm volatile("s_waitcnt vmcnt(" #n ")" ::: "memory")
#define PG8_WAIT_L(n) asm volatile("s_waitcnt lgkmcnt(" #n ")" ::: "memory")
#define PG8_BAR __builtin_amdgcn_s_barrier()
#define PG8_SCHED __builtin_amdgcn_sched_barrier(0)
    Unit cur, nxt; int ui = 0;
    if (!S.next(0, cur)) return;
    f32x4 acc[2][2][4][2];
#pragma unroll
    for (int a = 0; a < 2; ++a)
#pragma unroll
        for (int b = 0; b < 2; ++b)
#pragma unroll
            for (int m = 0; m < 4; ++m)
#pragma unroll
                for (int n = 0; n < 2; ++n) acc[a][b][m][n] = (f32x4){0.f, 0.f, 0.f, 0.f};
    bf16x8 At[4][2], B0[2][2], B1[2][2];
    const char* cA = (const char*)g.A + (size_t)cur.pm * tstep; const char* cB = (const char*)g.Bt + (size_t)cur.pn * tstep;
    S.a_ready(cur);
    unsigned long long praw[2] = {0ull, 0ull};
    if constexpr (Epi::PRE) E.pre_load(cur, wr, lane, praw);
    if constexpr (SP2) {
        PG8_STAGE(PG8_SB(0, 0), cB, voffB); PG8_STAGE(PG8_SB(0, 1), cB + hstep, voffB); PG8_STAGE(PG8_SA(0, 0), cA, voffA); PG8_STAGE(PG8_SA(0, 1), cA + hstep, voffA);
        if (wr == 1) PG8_BAR;
        PG8_WAIT_V(2); PG8_BAR;
        PG8_STAGE(PG8_SB(1, 0), cB + kstep, voffB); PG8_STAGE(PG8_SA(1, 0), cA + kstep, voffA); PG8_STAGE(PG8_SB(1, 1), cB + hstep + kstep, voffB);
        PG8_WAIT_V(6); PG8_BAR;
    } else {
        PG8_STAGE(PG8_SB(0, 0), cB, voffB); PG8_STAGE(PG8_SA(0, 0), cA, voffA); PG8_STAGE(PG8_SB(0, 1), cB + hstep, voffB); PG8_STAGE(PG8_SA(0, 1), cA + hstep, voffA);
        if (wr == 1) PG8_BAR;
        PG8_WAIT_V(4); PG8_BAR;
        PG8_STAGE(PG8_SB(1, 0), cB + kstep, voffB); PG8_STAGE(PG8_SA(1, 0), cA + kstep, voffA); PG8_STAGE(PG8_SB(1, 1), cB + hstep + kstep, voffB);
        PG8_WAIT_V(6); PG8_BAR;
    }
    for (;;) {
        const bool has_next = S.next(ui + 1, nxt);
        const char* nA = has_next ? (const char*)g.A + (size_t)nxt.pm * tstep : cA; const char* nB = has_next ? (const char*)g.Bt + (size_t)nxt.pn * tstep : cB;
        for (int t = 0; t < nt; t += 2) {
            const bool last = (t == nt - 2);
            const char* a1 = cA + (size_t)(t + 1) * kstep;
            const char* a2 = last ? nA : cA + (size_t)(t + 2) * kstep; const char* b2 = last ? nB : cB + (size_t)(t + 2) * kstep;
            const char* a3 = a2 + kstep; const char* b3 = b2 + kstep;
            if (last && has_next) S.a_ready(nxt);
            if constexpr (SP2) {
            PG8_LDB(B0, 0, 0); PG8_LDB(B1, 0, 1); PG8_SCHED; PG8_LDA(At, 0, 0); PG8_STAGE(PG8_SA(1, 1), a1 + hstep, voffA);
            PG8_WAIT_V(8); PG8_WAIT_L(0); PG8_BAR; PG8_MMA(0, 0, At, B0); PG8_MMA(0, 1, At, B1); PG8_BAR; PG8_SCHED;
            PG8_LDA(At, 0, 1); PG8_STAGE(PG8_SB(0, 0), b2, voffB); PG8_STAGE(PG8_SB(0, 1), b2 + hstep, voffB); PG8_STAGE(PG8_SA(0, 0), a2, voffA);
            PG8_WAIT_V(8); PG8_WAIT_L(0); PG8_BAR; PG8_MMA(1, 0, At, B0); PG8_MMA(1, 1, At, B1); PG8_BAR; PG8_SCHED;
            PG8_LDB(B0, 1, 0); PG8_LDB(B1, 1, 1); PG8_SCHED; PG8_LDA(At, 1, 0); PG8_STAGE(PG8_SA(0, 1), a2 + hstep, voffA);
            PG8_WAIT_V(8); PG8_WAIT_L(0); PG8_BAR; PG8_MMA(0, 0, At, B0); PG8_MMA(0, 1, At, B1); PG8_BAR; PG8_SCHED;
            PG8_LDA(At, 1, 1); PG8_STAGE(PG8_SB(1, 0), b3, voffB); PG8_STAGE(PG8_SB(1, 1), b3 + hstep, voffB); PG8_STAGE(PG8_SA(1, 0), a3, voffA);
            PG8_WAIT_V(8); PG8_WAIT_L(0); PG8_BAR; PG8_MMA(1, 0, At, B0); PG8_MMA(1, 1, At, B1); PG8_BAR; PG8_SCHED;
            } else {
            PG8_LDB(B0, 0, 0); PG8_SCHED; PG8_LDA(At, 0, 0); PG8_STAGE(PG8_SA(1, 1), a1 + hstep, voffA);
            PG8_WAIT_L(8); PG8_BAR; PG8_WAIT_L(0); PG8_MMA(0, 0, At, B0); PG8_BAR; PG8_SCHED;
            PG8_LDB(B1, 0, 1); PG8_STAGE(PG8_SB(0, 0), b2, voffB);
            PG8_BAR; PG8_WAIT_L(0); PG8_MMA(0, 1, At, B1); PG8_BAR;
            PG8_LDA(At, 0, 1); PG8_STAGE(PG8_SA(0, 0), a2, voffA);
            PG8_BAR; PG8_WAIT_L(0); PG8_MMA(1, 0, At, B0); PG8_BAR; PG8_SCHED;
            PG8_STAGE(PG8_SB(0, 1), b2 + hstep, voffB);
            PG8_WAIT_V(6); PG8_BAR; PG8_MMA(1, 1, At, B1); PG8_BAR;
            PG8_LDB(B0, 1, 0); PG8_SCHED; PG8_LDA(At, 1, 0); PG8_STAGE(PG8_SA(0, 1), a2 + hstep, voffA);
            PG8_WAIT_L(8); PG8_BAR; PG8_WAIT_L(0); PG8_MMA(0, 0, At, B0); PG8_BAR; PG8_SCHED;
            PG8_LDB(B1, 1, 1); PG8_STAGE(PG8_SB(1, 0), b3, voffB);
            PG8_BAR; PG8_WAIT_L(0); PG8_MMA(0, 1, At, B1); PG8_BAR;
            PG8_LDA(At, 1, 1); PG8_STAGE(PG8_SA(1, 0), a3, voffA);
            PG8_BAR; PG8_WAIT_L(0); PG8_MMA(1, 0, At, B0); PG8_BAR; PG8_SCHED;
            PG8_STAGE(PG8_SB(1, 1), b3 + hstep, voffB);
            PG8_WAIT_V(6); PG8_BAR; PG8_MMA(1, 1, At, B1); PG8_BAR;
            }
        }
        if constexpr (ALIGN_EPI) { if (wr == 0) PG8_BAR; }
        if constexpr (!Epi::AFTER_DRAIN) { if constexpr (Epi::PRE) E(acc, cur, wr, wc, fr, fq, praw); else E(acc, cur, wr, wc, fr, fq); S.done(cur); }
        if (!has_next) break;
#pragma unroll
        for (int a = 0; a < 2; ++a)
#pragma unroll
            for (int b = 0; b < 2; ++b)
#pragma unroll
                for (int m = 0; m < 4; ++m)
#pragma unroll
                    for (int n = 0; n < 2; ++n) acc[a][b][m][n] = (f32x4){0.f, 0.f, 0.f, 0.f};
        cur = nxt; cA = nA; cB = nB; ++ui;
        if constexpr (Epi::PRE) E.pre_load(cur, wr, lane, praw);
        if constexpr (ALIGN_EPI) { if (wr == 1) PG8_BAR; }
    }
    PG8_WAIT_V(0);
    if constexpr (!ALIGN_EPI) { if (wr == 0) PG8_BAR; }
    PG8_BAR;
    if constexpr (Epi::AFTER_DRAIN) { E.fused(acc, cur, wr, wc, fr, fq, lds, wid, lane); S.done(cur); }
#undef PG8_SA
#undef PG8_SB
#undef PG8_STAGE
#undef PG8_LDA
#undef PG8_LDB
#undef PG8_MMA
#undef PG8_WAIT_V
#undef PG8_WAIT_L
#undef PG8_BAR
#undef PG8_SCHED
}
}
#include <hip/hip_bf16.h>
#include <cmath>
namespace attn_body {
using bf16=__hip_bfloat16;
using bf16x8=__attribute__((ext_vector_type(8)))short;
using s16x4=__attribute__((ext_vector_type(4)))short;
using f32x16=__attribute__((ext_vector_type(16)))float;
using u32x4=__attribute__((ext_vector_type(4)))unsigned;
constexpr int D=64,PU=8960;
constexpr int NW=8,QBLK=32,QB=QBLK*NW,KVBLK=64;

__device__ __forceinline__ int crow(int r,int hi){return (r&3)+8*(r>>2)+4*hi;}
#define SBAR() __builtin_amdgcn_sched_barrier(0)


constexpr int NSLOT=3, SLOTB=8192;
constexpr int LDS_K=0, LDS_V=NSLOT*SLOTB, LDS_WS=2*NSLOT*SLOTB, LDS_OST=LDS_WS+NW*64*4, LDS_BYTES=LDS_OST+NW*4096;
constexpr float C2=0.125f*1.4426950408889634f;
__device__ __forceinline__ void glds16(const void*gsrc,unsigned lds_dst){unsigned keep;
  asm volatile("s_mov_b32 %0, m0\n\ts_mov_b32 m0, %2\n\ts_nop 0\n\tglobal_load_lds_dwordx4 %1, off\n\ts_mov_b32 m0, %0":"=&s"(keep):"v"(gsrc),"s"(lds_dst):"memory");}
__device__ __forceinline__ float max3f(float a,float b,float c){float r;asm("v_max3_f32 %0, %1, %2, %3":"=v"(r):"v"(a),"v"(b),"v"(c));return r;}
__device__ __forceinline__ float max2f(float a,float b){float r;asm("v_max_f32_e32 %0, %1, %2":"=v"(r):"v"(a),"v"(b));return r;}
__device__ __forceinline__ float fadd_s(float a,float b){float r;asm("v_add_f32_e32 %0, %1, %2":"=v"(r):"v"(a),"v"(b));return r;}
__device__ __forceinline__ float fsub_s(float a,float b){float r;asm("v_sub_f32_e32 %0, %1, %2":"=v"(r):"v"(a),"v"(b));return r;}
typedef float f32x2_t __attribute__((ext_vector_type(2))); typedef __bf16 bf16x2_t __attribute__((ext_vector_type(2)));
__device__ __forceinline__ unsigned cvtpk_s(float lo,float hi){f32x2_t v={lo,hi};bf16x2_t b=__builtin_convertvector(v,bf16x2_t);return __builtin_bit_cast(unsigned,b);}
#define WAIT_BAR(N) asm volatile("s_waitcnt vmcnt(" #N ") lgkmcnt(0)\n\ts_barrier":::"memory")

__device__ __forceinline__ void qkt(f32x16&p0,f32x16&p1,const char*Kslot,const bf16x8*qr,const f32x16&negm,int r32,int hi){
  const char*kb=Kslot+hi*1024+r32*16;
  #pragma unroll
  for(int d0=0;d0<4;++d0){
    const bf16x8 b0=*reinterpret_cast<const bf16x8*>(kb+d0*2048);
    const bf16x8 b1=*reinterpret_cast<const bf16x8*>(kb+d0*2048+512);
    if(d0==0){p0=__builtin_amdgcn_mfma_f32_32x32x16_bf16(b0,qr[0],negm,0,0,0);p1=__builtin_amdgcn_mfma_f32_32x32x16_bf16(b1,qr[0],negm,0,0,0);}
    else{p0=__builtin_amdgcn_mfma_f32_32x32x16_bf16(b0,qr[d0],p0,0,0,0);p1=__builtin_amdgcn_mfma_f32_32x32x16_bf16(b1,qr[d0],p1,0,0,0);}}
}
typedef __attribute__((address_space(3))) const char* lds_cptr;
typedef short v4i16_t __attribute__((ext_vector_type(4)));
__device__ __forceinline__ void kload8(bf16x8*kf,lds_cptr kp){
  kf[0]=*(const __attribute__((address_space(3))) bf16x8*)(kp);      kf[1]=*(const __attribute__((address_space(3))) bf16x8*)(kp+512);
  kf[2]=*(const __attribute__((address_space(3))) bf16x8*)(kp+2048); kf[3]=*(const __attribute__((address_space(3))) bf16x8*)(kp+2560);
  kf[4]=*(const __attribute__((address_space(3))) bf16x8*)(kp+4096); kf[5]=*(const __attribute__((address_space(3))) bf16x8*)(kp+4608);
  kf[6]=*(const __attribute__((address_space(3))) bf16x8*)(kp+6144); kf[7]=*(const __attribute__((address_space(3))) bf16x8*)(kp+6656);
}
__device__ __forceinline__ void kload2(bf16x8*kf,lds_cptr kp,int j){ kf[2*j]=*(const __attribute__((address_space(3))) bf16x8*)(kp+j*2048); kf[2*j+1]=*(const __attribute__((address_space(3))) bf16x8*)(kp+j*2048+512); }
__device__ __forceinline__ s16x4 vtr(lds_cptr p){ return __builtin_bit_cast(s16x4,__builtin_amdgcn_ds_read_tr16_b64_v4i16((__attribute__((address_space(3))) v4i16_t*)p)); }
__device__ __forceinline__ float rowmax(const f32x16&p0,const f32x16&p1){
  float a=max3f(p0[0],p0[1],p1[0]),b=max3f(p0[2],p0[3],p1[1]);a=max3f(a,p1[2],p1[3]);
  #pragma unroll
  for(int r=4;r<16;r+=4){a=max3f(a,p0[r],p0[r+1]);b=max3f(b,p0[r+2],p0[r+3]);a=max3f(a,p1[r],p1[r+1]);b=max3f(b,p1[r+2],p1[r+3]);}
  const float m=max2f(a,b);
  auto rr=__builtin_amdgcn_permlane32_swap(__float_as_uint(m),__float_as_uint(m),false,false);
  return max2f(__uint_as_float(rr[0]),__uint_as_float(rr[1]));
}
__device__ __forceinline__ void pv(f32x16*o,int vb,bf16x8 pa0,bf16x8 pa1,bf16x8 pa2,bf16x8 pa3){
  #pragma unroll
  for(int d0=0;d0<2;++d0){s16x4 lo[4],hi[4];
    #pragma unroll
    for(int ks=0;ks<4;++ks){
      asm volatile("ds_read_b64_tr_b16 %0,%1 offset:%c2":"=&v"(lo[ks]):"v"(vb),"i"(d0*4096+ks*1024):"memory");
      asm volatile("ds_read_b64_tr_b16 %0,%1 offset:%c2":"=&v"(hi[ks]):"v"(vb),"i"(d0*4096+ks*1024+512):"memory");}
    asm volatile("s_waitcnt lgkmcnt(0)":::"memory");SBAR();
    #define PK(k) (bf16x8){lo[k][0],lo[k][1],lo[k][2],lo[k][3],hi[k][0],hi[k][1],hi[k][2],hi[k][3]}
    o[d0]=__builtin_amdgcn_mfma_f32_32x32x16_bf16(pa0,PK(0),o[d0],0,0,0);
    o[d0]=__builtin_amdgcn_mfma_f32_32x32x16_bf16(pa1,PK(1),o[d0],0,0,0);
    o[d0]=__builtin_amdgcn_mfma_f32_32x32x16_bf16(pa2,PK(2),o[d0],0,0,0);
    o[d0]=__builtin_amdgcn_mfma_f32_32x32x16_bf16(pa3,PK(3),o[d0],0,0,0);
    #undef PK
  }
}

#ifndef ATTN_STORE16
#define ATTN_STORE16(p,v) (*(u32x4*)(p)=(v))
#endif
template<int THRL> __device__ __forceinline__ void attn_unit(const bf16*Qu,const bf16*__restrict__ Kh,const bf16*__restrict__ Vh,bf16*Ou,const long PO,const int NT,char*shm){
  int tid_l=threadIdx.x; asm volatile("":"+v"(tid_l)); const int tid=tid_l,lane=tid&63,r32=lane&31,hi=lane>>5; const int wid=__builtin_amdgcn_readfirstlane(tid>>6);

  const bf16*Qw=Qu+(long)(wid*QBLK)*PU;

  const unsigned lds0=(unsigned)(uintptr_t)shm;
  float*wsf=(float*)(shm+LDS_WS)+wid*64;
  const bf16*ksrc=Kh+(long)lane*PU+wid*8;
  const bf16*vsrc=Vh+(long)(16*(wid&3)+(lane>>2))*PU+(wid>>2)*32+(lane&3)*8;
  const unsigned kdst=lds0+LDS_K+wid*1024, vdst=lds0+LDS_V+wid*1024;
  #define DMA_K(t,slot) glds16(ksrc+(long)(t)*KVBLK*PU,(unsigned)__builtin_amdgcn_readfirstlane(kdst+(slot)))
  #define DMA_V(t,slot) glds16(vsrc+(long)(t)*KVBLK*PU,(unsigned)__builtin_amdgcn_readfirstlane(vdst+(slot)))
  const int vb0=(int)(lds0+LDS_V)+((lane>>4)&1)*32+(lane&3)*8+(4*hi+((lane&15)>>2))*64;
  const char*Kbase=shm+LDS_K; bf16x8 kf[8];
  const lds_cptr shm3=(lds_cptr)shm; const lds_cptr kp0=shm3+LDS_K+hi*1024+r32*16; const lds_cptr vp0=shm3+LDS_V+((lane>>4)&1)*32+(lane&3)*8+(4*hi+((lane&15)>>2))*64;

  DMA_K(0,0);DMA_V(0,0);DMA_K(1,SLOTB);
  bf16x8 qr[4];
  #pragma unroll
  for(int d0=0;d0<4;++d0)qr[d0]=*reinterpret_cast<const bf16x8*>(&Qw[(long)r32*PU+d0*16+hi*8]);
  float mhat=0.f,l_reg=0.f;f32x16 o[2];o[0]=f32x16{};o[1]=f32x16{};f32x16 negm=f32x16{};asm volatile("":"+v"(negm));

  #define CMASK(P0,P1,t) do{}while(0)
  bool resc=false;
  #define START(P0,P1) do{ const float rm=rowmax(P0,P1); resc=false; \
    { const float dl=rm; mhat=fadd_s(mhat,dl); \
      _Pragma("unroll") for(int r=0;r<16;++r){P0[r]=fsub_s(P0[r],dl);P1[r]=fsub_s(P1[r],dl);} \
      _Pragma("unroll") for(int r=0;r<16;++r)negm[r]=-mhat; asm volatile("":"+v"(negm)); } \
    _Pragma("unroll") for(int r=0;r<16;++r)P0[r]=__builtin_amdgcn_exp2f(P0[r]); }while(0)
  #define RESC() do{ if(resc){ asm volatile("s_waitcnt lgkmcnt(0)":::"memory"); \
      _Pragma("unroll") for(int d_=0;d_<2;++d_) _Pragma("unroll") for(int r=0;r<16;++r)o[d_][r]*=wsf[crow(r,hi)]; } }while(0)
  f32x16 pA0,pA1,pB0,pB1;
  int sl_prev=0,sl_cur=0,sl_next=SLOTB;
  #define ROT() do{sl_prev=sl_cur;sl_cur=sl_next;sl_next=(sl_next==(NSLOT-1)*SLOTB)?0:sl_next+SLOTB;}while(0)
  DMA_K(2,2*SLOTB);
  WAIT_BAR(3);
  qkt(pA0,pA1,Kbase,qr,negm,r32,hi);asm volatile("s_nop 15\n\ts_nop 7":"+v"(pA0),"+v"(pA1));CMASK(pA0,pA1,0);
  START(pA0,pA1);
  _Pragma("unroll") for(int r=0;r<16;++r)pA1[r]=__builtin_amdgcn_exp2f(pA1[r]);
  WAIT_BAR(0);
  DMA_K(3,0);DMA_V(1,SLOTB);
  ROT();
  kload8(kf,kp0+sl_cur);
  WAIT_BAR(2);
  s16x4 vlo[8],vhi[8]; u32x4 pw0,pw1,pw2,pw3;
  #define PKW(P,B) cvtpk_s(P[B],P[B+1])
  #define PAF(k) __builtin_bit_cast(bf16x8,pw##k)
  #define VFR(i) (bf16x8){vlo[i][0],vlo[i][1],vlo[i][2],vlo[i][3],vhi[i][0],vhi[i][1],vhi[i][2],vhi[i][3]}
  #define PIN(x) asm volatile("":"+v"(x))
  #define MX3(a,b,c) __builtin_fmaxf(__builtin_fmaxf((a),(b)),(c))
  #define GAPA(MF,A0,A1,A2,A3,W0,W1,PW) do{ MF; sacc+=A0; sacc+=A1; sacc+=A2; sacc+=A3; PIN(sacc); W0; W1; PIN(PW); SBAR(); }while(0)
  #define EX(v) __builtin_amdgcn_exp2f(v)
  #define GAPB(MF,X,B) do{ MF; X[B]=EX(X[B]); X[B+1]=EX(X[B+1]); X[B+2]=EX(X[B+2]); X[B+3]=EX(X[B+3]); PIN(X); SBAR(); }while(0)
  #define VRD(i) do{ vlo[i]=vtr(vp_+(((i)>>2)*4096+((i)&3)*1024)); vhi[i]=vtr(vp_+(((i)>>2)*4096+((i)&3)*1024+512)); }while(0)
  #define KRD(G,j) do{ if(G){ kload2(kf,kp0+sl_next,j); SBAR(); } }while(0)
  #define STEP(C0,C1,P0,P1,t,GK,GV,GL) do{ SBAR(); \
    const lds_cptr vp_=vp0+sl_prev; \
    VRD(0); SBAR(); float sacc=(P0[0]+P0[1]); \
    GAPA(C0=__builtin_amdgcn_mfma_f32_32x32x16_bf16(kf[0],qr[0],negm,0,0,0), P0[2],P0[3],P0[4],P0[5],     pw0[0]=PKW(P0,0), pw0[1]=PKW(P0,2), pw0); \
    VRD(4); SBAR(); GAPA(C1=__builtin_amdgcn_mfma_f32_32x32x16_bf16(kf[1],qr[0],negm,0,0,0), P0[6],P0[7],P0[8],P0[9],     pw0[2]=PKW(P0,4), pw0[3]=PKW(P0,6), pw0); \
    VRD(1); SBAR(); GAPA(C0=__builtin_amdgcn_mfma_f32_32x32x16_bf16(kf[2],qr[1],C0,0,0,0),   P0[10],P0[11],P0[12],P0[13], pw1[0]=PKW(P0,8), pw1[1]=PKW(P0,10), pw1); \
    VRD(5); SBAR(); GAPA(C1=__builtin_amdgcn_mfma_f32_32x32x16_bf16(kf[3],qr[1],C1,0,0,0),   P0[14],P0[15],P1[0],P1[1],   pw1[2]=PKW(P0,12),pw1[3]=PKW(P0,14), pw1); \
    VRD(2); SBAR(); GAPA(C0=__builtin_amdgcn_mfma_f32_32x32x16_bf16(kf[4],qr[2],C0,0,0,0),   P1[2],P1[3],P1[4],P1[5],     pw2[0]=PKW(P1,0), pw2[1]=PKW(P1,2), pw2); \
    VRD(6); SBAR(); GAPA(C1=__builtin_amdgcn_mfma_f32_32x32x16_bf16(kf[5],qr[2],C1,0,0,0),   P1[6],P1[7],P1[8],P1[9],     pw2[2]=PKW(P1,4), pw2[3]=PKW(P1,6), pw2); \
    VRD(3); SBAR(); GAPA(C0=__builtin_amdgcn_mfma_f32_32x32x16_bf16(kf[6],qr[3],C0,0,0,0),   P1[10],P1[11],P1[12],P1[13], pw3[0]=PKW(P1,8), pw3[1]=PKW(P1,10), pw3); \
    VRD(7); SBAR(); GAPA(C1=__builtin_amdgcn_mfma_f32_32x32x16_bf16(kf[7],qr[3],C1,0,0,0),   P1[14],P1[15],0.f,0.f,       pw3[2]=PKW(P1,12),pw3[3]=PKW(P1,14), pw3); \
    l_reg+=sacc; \
    if(GK){DMA_K((t)+3,sl_cur);} if(GV){DMA_V((t)+1,sl_next);} \
    CMASK(C0,C1,t); \
    { float a=MX3(C0[0],C0[1],C1[0]),b=MX3(C0[2],C0[3],C1[1]); a=MX3(a,C1[2],C1[3]); \
      _Pragma("unroll") for(int r=4;r<16;r+=4){a=MX3(a,C0[r],C0[r+1]);b=MX3(b,C0[r+2],C0[r+3]);a=MX3(a,C1[r],C1[r+1]);b=MX3(b,C1[r+2],C1[r+3]);} \
      float rm=__builtin_fmaxf(a,b); { auto rr=__builtin_amdgcn_permlane32_swap(__float_as_uint(rm),__float_as_uint(rm),false,false); rm=__builtin_fmaxf(__uint_as_float(rr[0]),__uint_as_float(rr[1])); } \
      resc=false; \
      if(__builtin_expect(__any(rm>(float)THRL),0)){ const float dl=__builtin_fmaxf(rm,0.f); mhat+=dl; \
        _Pragma("unroll") for(int r=0;r<16;++r){C0[r]-=dl;C1[r]-=dl;} \
        _Pragma("unroll") for(int r=0;r<16;++r)negm[r]=-mhat; asm volatile("":"+v"(negm)); \
        const float f=__builtin_amdgcn_exp2f(-dl); l_reg*=f; if(hi==0)wsf[r32]=f; resc=true; } } \
    SBAR(); \
    GAPB(o[0]=__builtin_amdgcn_mfma_f32_32x32x16_bf16(PAF(0),VFR(0),o[0],0,0,0), C0,0); \
    GAPB(o[1]=__builtin_amdgcn_mfma_f32_32x32x16_bf16(PAF(0),VFR(4),o[1],0,0,0), C0,4); \
    KRD(GL,0); GAPB(o[0]=__builtin_amdgcn_mfma_f32_32x32x16_bf16(PAF(1),VFR(1),o[0],0,0,0), C0,8); \
    KRD(GL,1); GAPB(o[1]=__builtin_amdgcn_mfma_f32_32x32x16_bf16(PAF(1),VFR(5),o[1],0,0,0), C0,12); \
    KRD(GL,2); GAPB(o[0]=__builtin_amdgcn_mfma_f32_32x32x16_bf16(PAF(2),VFR(2),o[0],0,0,0), C1,0); \
    KRD(GL,3); GAPB(o[1]=__builtin_amdgcn_mfma_f32_32x32x16_bf16(PAF(2),VFR(6),o[1],0,0,0), C1,4); \
    GAPB(o[0]=__builtin_amdgcn_mfma_f32_32x32x16_bf16(PAF(3),VFR(3),o[0],0,0,0), C1,8); \
    GAPB(o[1]=__builtin_amdgcn_mfma_f32_32x32x16_bf16(PAF(3),VFR(7),o[1],0,0,0), C1,12); \
    }while(0)
  int t=1;
  #undef CMASK
  #define CMASK(P0,P1,t) do{}while(0)
  for(;t+5<NT;t+=2){
    STEP(pB0,pB1,pA0,pA1,t,true,true,true);     WAIT_BAR(2); RESC(); ROT();
    STEP(pA0,pA1,pB0,pB1,t+1,true,true,true);   WAIT_BAR(2); RESC(); ROT();
  }
  #undef CMASK
  #define CMASK(P0,P1,t) do{}while(0)
  #define ENDW(tt) do{ if((tt)+3<NT){WAIT_BAR(2);} else if((tt)+2<NT){WAIT_BAR(1);} else {WAIT_BAR(0);} }while(0)
  for(;t+1<NT;t+=2){
    STEP(pB0,pB1,pA0,pA1,t,(t+3<NT),(t+1<NT),(t+1<NT));       ENDW(t);   RESC(); ROT();
    STEP(pA0,pA1,pB0,pB1,t+1,(t+4<NT),(t+2<NT),(t+2<NT));     ENDW(t+1); RESC(); ROT();
  }
  STEP(pB0,pB1,pA0,pA1,NT-1,false,false,false); RESC();
  { float sacc=pB0[0]+pB0[1]; _Pragma("unroll") for(int r=2;r<16;++r)sacc+=pB0[r]; _Pragma("unroll") for(int r=0;r<16;++r)sacc+=pB1[r]; l_reg+=sacc;
    pw0=(u32x4){PKW(pB0,0),PKW(pB0,2),PKW(pB0,4),PKW(pB0,6)};pw1=(u32x4){PKW(pB0,8),PKW(pB0,10),PKW(pB0,12),PKW(pB0,14)};pw2=(u32x4){PKW(pB1,0),PKW(pB1,2),PKW(pB1,4),PKW(pB1,6)};pw3=(u32x4){PKW(pB1,8),PKW(pB1,10),PKW(pB1,12),PKW(pB1,14)};
    SBAR(); pv(o,vb0+sl_cur,PAF(0),PAF(1),PAF(2),PAF(3)); }
  #undef PKW
  #undef PAF
  #undef VFR
  #undef PIN
  #undef MX3
  #undef GAPA
  #undef GAPB
  #undef EX
  #undef VRD
  #undef KRD
  #undef STEP
  #undef ENDW
  {auto rr=__builtin_amdgcn_permlane32_swap(__float_as_uint(l_reg),__float_as_uint(l_reg),false,false);l_reg=__uint_as_float(rr[0])+__uint_as_float(rr[1]);}
  if(hi==0)wsf[32+r32]=l_reg;asm volatile("s_waitcnt lgkmcnt(0)":::"memory");
  float rli[16];
  #pragma unroll
  for(int r=0;r<16;++r)rli[r]=__builtin_amdgcn_rcpf(wsf[32+crow(r,hi)]);
  bf16*Ow=Ou+(long)(wid*QBLK)*PO;
  { bf16*stg=(bf16*)(shm+LDS_OST)+wid*2048;
    #pragma unroll
    for(int r=0;r<16;++r){const int orow=crow(r,hi);
      #pragma unroll
      for(int d0=0;d0<2;++d0)stg[orow*64+d0*32+r32]=__float2bfloat16(o[d0][r]*rli[r]);}
    asm volatile("s_waitcnt lgkmcnt(0)":::"memory");
    #pragma unroll
    for(int i=0;i<4;++i){const int row=i*8+(lane>>3),ch=lane&7; const u32x4 v=*(const u32x4*)(stg+row*64+ch*8); ATTN_STORE16(Ow+(long)row*PO+ch*8,v);} }
  asm volatile("s_waitcnt lgkmcnt(0)\n\ts_barrier":::"memory");
  #undef DMA_K
  #undef DMA_V
  #undef CMASK
  #undef START
  #undef RESC
  #undef ROT
}
constexpr int ATTN_LDS_BYTES=LDS_BYTES;
#undef SBAR
#undef WAIT_BAR
}
namespace attn_av {
using namespace attn_body;
#define SBAR() __builtin_amdgcn_sched_barrier(0)
#define WAIT_BAR(N) asm volatile("s_waitcnt vmcnt(" #N ") lgkmcnt(0)\n\ts_barrier":::"memory")
constexpr int KSLOT=8192, VSLOT=16384;
constexpr int AV_K=0, AV_V=NSLOT*KSLOT, AV_WS=AV_V+NSLOT*VSLOT, AV_ST=AV_WS+NW*64*4, AV_LDS_BYTES=AV_ST+NW*8192;
__device__ __forceinline__ void pv4(f32x16*o,int vb,bf16x8 pa0,bf16x8 pa1,bf16x8 pa2,bf16x8 pa3){
  #pragma unroll
  for(int d0=0;d0<4;++d0){s16x4 lo[4],hi[4];
    #pragma unroll
    for(int ks=0;ks<4;++ks){
      asm volatile("ds_read_b64_tr_b16 %0,%1 offset:%c2":"=&v"(lo[ks]):"v"(vb),"i"(d0*4096+ks*1024):"memory");
      asm volatile("ds_read_b64_tr_b16 %0,%1 offset:%c2":"=&v"(hi[ks]):"v"(vb),"i"(d0*4096+ks*1024+512):"memory");}
    asm volatile("s_waitcnt lgkmcnt(0)":::"memory");SBAR();
    #define PK(k) (bf16x8){lo[k][0],lo[k][1],lo[k][2],lo[k][3],hi[k][0],hi[k][1],hi[k][2],hi[k][3]}
    o[d0]=__builtin_amdgcn_mfma_f32_32x32x16_bf16(pa0,PK(0),o[d0],0,0,0);
    o[d0]=__builtin_amdgcn_mfma_f32_32x32x16_bf16(pa1,PK(1),o[d0],0,0,0);
    o[d0]=__builtin_amdgcn_mfma_f32_32x32x16_bf16(pa2,PK(2),o[d0],0,0,0);
    o[d0]=__builtin_amdgcn_mfma_f32_32x32x16_bf16(pa3,PK(3),o[d0],0,0,0);
    #undef PK
  }
}
template<int THRL,int EPI> __device__ __forceinline__ void attn_unit_v(const bf16*Qu,const bf16*__restrict__ Kh,const bf16*__restrict__ Vh,bf16*Ou,const long PO,const int NT,char*shm,const float lam,const float*__restrict__ gain,const float scale){
  int tid_l=threadIdx.x; asm volatile("":"+v"(tid_l)); const int tid=tid_l,lane=tid&63,r32=lane&31,hi=lane>>5; const int wid=__builtin_amdgcn_readfirstlane(tid>>6);
  const bf16*Qw=Qu+(long)(wid*QBLK)*PU;
  const unsigned lds0=(unsigned)(uintptr_t)shm;
  float*wsf=(float*)(shm+AV_WS)+wid*64;
  const bf16*ksrc=Kh+(long)lane*PU+wid*8;
  const bf16*vsrc=Vh+(long)(16*(wid&3)+(lane>>2))*PU+(wid>>2)*32+(lane&3)*8;
  const unsigned kdst=lds0+AV_K+wid*1024, vdst=lds0+AV_V+wid*1024;
  #define DMA_K(t,slot) glds16(ksrc+(long)(t)*KVBLK*PU,(unsigned)__builtin_amdgcn_readfirstlane(kdst+(slot)))
  #define DMA_V(t,slot) do{ glds16(vsrc+(long)(t)*KVBLK*PU,(unsigned)__builtin_amdgcn_readfirstlane(vdst+2*(slot))); glds16(vsrc+64+(long)(t)*KVBLK*PU,(unsigned)__builtin_amdgcn_readfirstlane(vdst+8192+2*(slot))); }while(0)
  const int vb0=(int)(lds0+AV_V)+((lane>>4)&1)*32+(lane&3)*8+(4*hi+((lane&15)>>2))*64;
  const char*Kbase=shm+AV_K; bf16x8 kf[8];
  const lds_cptr shm3=(lds_cptr)shm; const lds_cptr kp0=shm3+AV_K+hi*1024+r32*16; const lds_cptr vp0=shm3+AV_V+((lane>>4)&1)*32+(lane&3)*8+(4*hi+((lane&15)>>2))*64;

  DMA_K(0,0);DMA_V(0,0);DMA_K(1,KSLOT);
  bf16x8 qr[4];
  #pragma unroll
  for(int d0=0;d0<4;++d0)qr[d0]=*reinterpret_cast<const bf16x8*>(&Qw[(long)r32*PU+d0*16+hi*8]);
  float mhat=0.f,l_reg=0.f;f32x16 o[4];o[0]=f32x16{};o[1]=f32x16{};o[2]=f32x16{};o[3]=f32x16{};f32x16 negm=f32x16{};asm volatile("":"+v"(negm));
  bool resc=false;
  #define START(P0,P1) do{ const float rm=rowmax(P0,P1); resc=false; \
    { const float dl=rm; mhat=fadd_s(mhat,dl); \
      _Pragma("unroll") for(int r=0;r<16;++r){P0[r]=fsub_s(P0[r],dl);P1[r]=fsub_s(P1[r],dl);} \
      _Pragma("unroll") for(int r=0;r<16;++r)negm[r]=-mhat; asm volatile("":"+v"(negm)); } \
    _Pragma("unroll") for(int r=0;r<16;++r)P0[r]=__builtin_amdgcn_exp2f(P0[r]); }while(0)
  #define RESC() do{ if(resc){ asm volatile("s_waitcnt lgkmcnt(0)":::"memory"); \
      _Pragma("unroll") for(int d_=0;d_<4;++d_) _Pragma("unroll") for(int r=0;r<16;++r)o[d_][r]*=wsf[crow(r,hi)]; } }while(0)
  f32x16 pA0,pA1,pB0,pB1;
  int sl_prev=0,sl_cur=0,sl_next=KSLOT;
  #define ROT() do{sl_prev=sl_cur;sl_cur=sl_next;sl_next=(sl_next==(NSLOT-1)*KSLOT)?0:sl_next+KSLOT;}while(0)
  DMA_K(2,2*KSLOT);
  WAIT_BAR(3);
  qkt(pA0,pA1,Kbase,qr,negm,r32,hi);asm volatile("s_nop 15\n\ts_nop 7":"+v"(pA0),"+v"(pA1));
  START(pA0,pA1);
  _Pragma("unroll") for(int r=0;r<16;++r)pA1[r]=__builtin_amdgcn_exp2f(pA1[r]);
  WAIT_BAR(0);
  DMA_K(3,0);DMA_V(1,KSLOT);
  ROT();
  kload8(kf,kp0+sl_cur);
  WAIT_BAR(3);
  s16x4 vlo[8],vhi[8]; u32x4 pw0,pw1,pw2,pw3;
  #define PKW(P,B) cvtpk_s(P[B],P[B+1])
  #define PAF(k) __builtin_bit_cast(bf16x8,pw##k)
  #define VFR(i) (bf16x8){vlo[i][0],vlo[i][1],vlo[i][2],vlo[i][3],vhi[i][0],vhi[i][1],vhi[i][2],vhi[i][3]}
  #define PIN(x) asm volatile("":"+v"(x))
  #define MX3(a,b,c) __builtin_fmaxf(__builtin_fmaxf((a),(b)),(c))
  #define GAPA(MF,A0,A1,A2,A3,W0,W1,PW) do{ MF; sacc+=A0; sacc+=A1; sacc+=A2; sacc+=A3; PIN(sacc); W0; W1; PIN(PW); SBAR(); }while(0)
  #define EX(v) __builtin_amdgcn_exp2f(v)
  #define GAPB(MF,X,B) do{ MF; X[B]=EX(X[B]); X[B+1]=EX(X[B+1]); PIN(X); SBAR(); }while(0)
  #define VRD(i) do{ vlo[i]=vtr(vp_+(((i)>>2)*4096+((i)&3)*1024)); vhi[i]=vtr(vp_+(((i)>>2)*4096+((i)&3)*1024+512)); }while(0)
  #define VRD2(i) do{ vlo[i]=vtr(vp_+(8192+((i)>>2)*4096+((i)&3)*1024)); vhi[i]=vtr(vp_+(8192+((i)>>2)*4096+((i)&3)*1024+512)); }while(0)
  #define GAPB1(MF,I,X,B) do{ MF; VRD2(I); X[B]=EX(X[B]); X[B+1]=EX(X[B+1]); PIN(X); SBAR(); }while(0)
  #define KRD(G,j) do{ if(G){ kload2(kf,kp0+sl_next,j); SBAR(); } }while(0)
  #define MF32(a,b,c) __builtin_amdgcn_mfma_f32_32x32x16_bf16(a,b,c,0,0,0)
  #define STEP(C0,C1,P0,P1,t,GK,GV,GL) do{ SBAR(); \
    const lds_cptr vp_=vp0+2*sl_prev; \
    VRD(0); SBAR(); float sacc=(P0[0]+P0[1]); \
    GAPA(C0=MF32(kf[0],qr[0],negm), P0[2],P0[3],P0[4],P0[5],     pw0[0]=PKW(P0,0), pw0[1]=PKW(P0,2), pw0); \
    VRD(4); SBAR(); GAPA(C1=MF32(kf[1],qr[0],negm), P0[6],P0[7],P0[8],P0[9],     pw0[2]=PKW(P0,4), pw0[3]=PKW(P0,6), pw0); \
    VRD(1); SBAR(); GAPA(C0=MF32(kf[2],qr[1],C0),   P0[10],P0[11],P0[12],P0[13], pw1[0]=PKW(P0,8), pw1[1]=PKW(P0,10), pw1); \
    VRD(5); SBAR(); GAPA(C1=MF32(kf[3],qr[1],C1),   P0[14],P0[15],P1[0],P1[1],   pw1[2]=PKW(P0,12),pw1[3]=PKW(P0,14), pw1); \
    VRD(2); SBAR(); GAPA(C0=MF32(kf[4],qr[2],C0),   P1[2],P1[3],P1[4],P1[5],     pw2[0]=PKW(P1,0), pw2[1]=PKW(P1,2), pw2); \
    VRD(6); SBAR(); GAPA(C1=MF32(kf[5],qr[2],C1),   P1[6],P1[7],P1[8],P1[9],     pw2[2]=PKW(P1,4), pw2[3]=PKW(P1,6), pw2); \
    VRD(3); SBAR(); GAPA(C0=MF32(kf[6],qr[3],C0),   P1[10],P1[11],P1[12],P1[13], pw3[0]=PKW(P1,8), pw3[1]=PKW(P1,10), pw3); \
    VRD(7); SBAR(); GAPA(C1=MF32(kf[7],qr[3],C1),   P1[14],P1[15],0.f,0.f,       pw3[2]=PKW(P1,12),pw3[3]=PKW(P1,14), pw3); \
    l_reg+=sacc; \
    if(GK){DMA_K((t)+3,sl_cur);} if(GV){DMA_V((t)+1,sl_next);} \
    { float a=MX3(C0[0],C0[1],C1[0]),b=MX3(C0[2],C0[3],C1[1]); a=MX3(a,C1[2],C1[3]); \
      _Pragma("unroll") for(int r=4;r<16;r+=4){a=MX3(a,C0[r],C0[r+1]);b=MX3(b,C0[r+2],C0[r+3]);a=MX3(a,C1[r],C1[r+1]);b=MX3(b,C1[r+2],C1[r+3]);} \
      float rm=__builtin_fmaxf(a,b); { auto rr=__builtin_amdgcn_permlane32_swap(__float_as_uint(rm),__float_as_uint(rm),false,false); rm=__builtin_fmaxf(__uint_as_float(rr[0]),__uint_as_float(rr[1])); } \
      resc=false; \
      if(__builtin_expect(__any(rm>(float)THRL),0)){ const float dl=__builtin_fmaxf(rm,0.f); mhat+=dl; \
        _Pragma("unroll") for(int r=0;r<16;++r){C0[r]-=dl;C1[r]-=dl;} \
        _Pragma("unroll") for(int r=0;r<16;++r)negm[r]=-mhat; asm volatile("":"+v"(negm)); \
        const float f=__builtin_amdgcn_exp2f(-dl); l_reg*=f; if(hi==0)wsf[r32]=f; resc=true; } } \
    SBAR(); \
    GAPB1(o[0]=MF32(PAF(0),VFR(0),o[0]), 0, C0,0); \
    GAPB1(o[1]=MF32(PAF(0),VFR(4),o[1]), 4, C0,2); \
    GAPB1(o[0]=MF32(PAF(1),VFR(1),o[0]), 1, C0,4); \
    GAPB1(o[1]=MF32(PAF(1),VFR(5),o[1]), 5, C0,6); \
    GAPB1(o[0]=MF32(PAF(2),VFR(2),o[0]), 2, C0,8); \
    GAPB1(o[1]=MF32(PAF(2),VFR(6),o[1]), 6, C0,10); \
    GAPB1(o[0]=MF32(PAF(3),VFR(3),o[0]), 3, C0,12); \
    GAPB1(o[1]=MF32(PAF(3),VFR(7),o[1]), 7, C0,14); \
    GAPB(o[2]=MF32(PAF(0),VFR(0),o[2]), C1,0); \
    GAPB(o[3]=MF32(PAF(0),VFR(4),o[3]), C1,2); \
    KRD(GL,0); GAPB(o[2]=MF32(PAF(1),VFR(1),o[2]), C1,4); \
    KRD(GL,1); GAPB(o[3]=MF32(PAF(1),VFR(5),o[3]), C1,6); \
    KRD(GL,2); GAPB(o[2]=MF32(PAF(2),VFR(2),o[2]), C1,8); \
    KRD(GL,3); GAPB(o[3]=MF32(PAF(2),VFR(6),o[3]), C1,10); \
    GAPB(o[2]=MF32(PAF(3),VFR(3),o[2]), C1,12); \
    GAPB(o[3]=MF32(PAF(3),VFR(7),o[3]), C1,14); \
    }while(0)
  int t=1;
  for(;t+5<NT;t+=2){
    STEP(pB0,pB1,pA0,pA1,t,true,true,true);     WAIT_BAR(3); RESC(); ROT();
    STEP(pA0,pA1,pB0,pB1,t+1,true,true,true);   WAIT_BAR(3); RESC(); ROT();
  }
  #define ENDW(tt) do{ if((tt)+3<NT){WAIT_BAR(3);} else if((tt)+2<NT){WAIT_BAR(2);} else {WAIT_BAR(0);} }while(0)
  for(;t+1<NT;t+=2){
    STEP(pB0,pB1,pA0,pA1,t,(t+3<NT),(t+1<NT),(t+1<NT));       ENDW(t);   RESC(); ROT();
    STEP(pA0,pA1,pB0,pB1,t+1,(t+4<NT),(t+2<NT),(t+2<NT));     ENDW(t+1); RESC(); ROT();
  }
  STEP(pB0,pB1,pA0,pA1,NT-1,false,false,false); RESC();
  { float sacc=pB0[0]+pB0[1]; _Pragma("unroll") for(int r=2;r<16;++r)sacc+=pB0[r]; _Pragma("unroll") for(int r=0;r<16;++r)sacc+=pB1[r]; l_reg+=sacc;
    pw0=(u32x4){PKW(pB0,0),PKW(pB0,2),PKW(pB0,4),PKW(pB0,6)};pw1=(u32x4){PKW(pB0,8),PKW(pB0,10),PKW(pB0,12),PKW(pB0,14)};pw2=(u32x4){PKW(pB1,0),PKW(pB1,2),PKW(pB1,4),PKW(pB1,6)};pw3=(u32x4){PKW(pB1,8),PKW(pB1,10),PKW(pB1,12),PKW(pB1,14)};
    SBAR(); pv4(o,vb0+2*sl_cur,PAF(0),PAF(1),PAF(2),PAF(3)); }
  #undef PKW
  #undef PAF
  #undef VFR
  #undef PIN
  #undef MX3
  #undef GAPA
  #undef GAPB
  #undef GAPB1
  #undef EX
  #undef VRD
  #undef VRD2
  #undef KRD
  #undef MF32
  #undef STEP
  #undef ENDW
  {auto rr=__builtin_amdgcn_permlane32_swap(__float_as_uint(l_reg),__float_as_uint(l_reg),false,false);l_reg=__uint_as_float(rr[0])+__uint_as_float(rr[1]);}
  if(hi==0)wsf[32+r32]=l_reg;asm volatile("s_waitcnt lgkmcnt(0)":::"memory");
  float rli[16];
  #pragma unroll
  for(int r=0;r<16;++r)rli[r]=__builtin_amdgcn_rcpf(wsf[32+crow(r,hi)]);
  unsigned*stw=(unsigned*)(shm+AV_ST)+wid*2048;
  if constexpr(EPI==1){
    #pragma unroll
    for(int d0=0;d0<4;++d0)
      #pragma unroll
      for(int r=0;r<16;r+=2)stw[(d0*8+(r>>1))*64+lane]=cvtpk_s(o[d0][r]*rli[r],o[d0][r+1]*rli[r+1]);
  } else {
    unsigned s1[32];
    #pragma unroll
    for(int j=0;j<32;++j)s1[j]=stw[j*64+lane];
    const float g0=gain[r32],g1=gain[32+r32],g2=gain[64+r32],g3=gain[96+r32];
    asm volatile("s_waitcnt lgkmcnt(0)":::"memory");
    float ss[16];
    #pragma unroll
    for(int r=0;r<16;++r){ float a=0.f;
      #pragma unroll
      for(int d0=0;d0<4;++d0){ const unsigned w=s1[d0*8+(r>>1)]; const float o1=(r&1)?__uint_as_float(w&0xffff0000u):__uint_as_float(w<<16);
        const float d=o1-lam*(o[d0][r]*rli[r]); o[d0][r]=d; a+=d*d; }
      ss[r]=a; }
    #pragma unroll
    for(int r=0;r<16;++r){
      #pragma unroll
      for(int sft=1;sft<32;sft<<=1)ss[r]+=__builtin_bit_cast(float,__builtin_amdgcn_ds_bpermute((lane^sft)<<2,__builtin_bit_cast(int,ss[r])));
      ss[r]=scale*__builtin_amdgcn_rsqf(ss[r]*(1.f/128.f)+1e-6f); }
    bf16*Ow=Ou+(long)(wid*QBLK)*PO;
    bf16*stg=(bf16*)stw;
    #pragma unroll
    for(int hf=0;hf<2;++hf){
      #pragma unroll
      for(int r=0;r<16;++r){const int orow=crow(r,hi);
        stg[orow*64+r32]=__float2bfloat16(o[2*hf][r]*ss[r]*(hf?g2:g0)); stg[orow*64+32+r32]=__float2bfloat16(o[2*hf+1][r]*ss[r]*(hf?g3:g1));}
      asm volatile("s_waitcnt lgkmcnt(0)":::"memory");
      #pragma unroll
      for(int i=0;i<4;++i){const int row=i*8+(lane>>3),ch=lane&7; const u32x4 v=*(const u32x4*)(stg+row*64+ch*8); *(u32x4*)(Ow+(long)row*PO+hf*64+ch*8)=v;}
      asm volatile("s_waitcnt lgkmcnt(0)":::"memory"); } }
  asm volatile("s_waitcnt lgkmcnt(0)\n\ts_barrier":::"memory");
  #undef DMA_K
  #undef DMA_V
  #undef START
  #undef RESC
  #undef ROT
}
#undef SBAR
#undef WAIT_BAR
}
constexpr int NWAVES = 8;
constexpr int DM = 2048, DFF = 5632, NU = 8960, NMIX = 3072, DEPTH = 2;
constexpr int NTOK = 65536, CH = 16384, NCHUNK = 4;
constexpr int NIN_SRC = 8224;
constexpr float EPS = 1e-6f;
constexpr float C2 = 0.18033688011112042f;
constexpr int U_AQ = 0, U_AK = 768, U_AV = 1536, U_BQ = 2304, U_BK = 3072, U_BV = 3840, U_CQ = 4608, U_CK = 4992, U_CV = 5376, U_CG = 6144, U_GF = 6912, U_GB = 7296, U_DQ = 7680, U_DK = 8448, U_DV = 8704;

constexpr size_t MiB = 1u << 20;
constexpr size_t WS_CTL = 0, CTL_ZERO_BYTES = 6 * MiB;
constexpr size_t WS_TAB = 1 * MiB;
constexpr size_t WS_TAB_AX = WS_TAB + 8192 * 8 * 8;
constexpr size_t WS_RSS = 2 * MiB;
constexpr size_t WS_W = 6 * MiB;
constexpr size_t W_GU1 = 0, W_D1 = 44 * MiB, W_IN = 66 * MiB, W_OUT = 101 * MiB, W_GU2 = 113 * MiB, W_D2 = 157 * MiB, W_LAYER = 179 * MiB;
constexpr size_t WS_XN = WS_W + 2 * W_LAYER;
constexpr size_t WS_U = WS_XN + 64 * MiB;
constexpr size_t WS_MIX = WS_U + 280 * MiB;
constexpr size_t WS_OA = WS_MIX + 96 * MiB;
constexpr size_t WS_BO = WS_OA;
constexpr size_t WS_BL = WS_BO + 72 * MiB;
constexpr size_t WS_OC = WS_BL + 3 * MiB;
constexpr size_t WS_END = WS_OC + 96 * MiB;
constexpr int CW_BAR = 4096;
constexpr int CW_Q = 16384;
constexpr int CW_LAM = 32768;

constexpr int RING_BYTES = 131072;
constexpr int MISC_OFF = 163328;
constexpr int LDS_BYTES = 163840;

#define GAS __attribute__((address_space(1)))
#define LAS __attribute__((address_space(3)))
#define DI __device__ __forceinline__
typedef unsigned short bfu;
typedef unsigned u32x4 __attribute__((ext_vector_type(4)));
typedef unsigned u32x2 __attribute__((ext_vector_type(2)));
typedef float f32x4 __attribute__((ext_vector_type(4)));
typedef float f32x2 __attribute__((ext_vector_type(2)));
typedef float f32x16 __attribute__((ext_vector_type(16)));
typedef short bf16x8 __attribute__((ext_vector_type(8)));
typedef short s16x4 __attribute__((ext_vector_type(4)));
typedef GAS unsigned gu32;
#define RLX_AGENT __ATOMIC_RELAXED, __HIP_MEMORY_SCOPE_AGENT
#define LDS_WAIT() asm volatile("s_waitcnt lgkmcnt(0)" ::: "memory")
#define VM_WAIT() asm volatile("s_waitcnt vmcnt(0)" ::: "memory")
DI unsigned f2bf(float f) { unsigned u = __builtin_bit_cast(unsigned, f); return (u + 0x7fffu + ((u >> 16) & 1u)) >> 16; }
DI unsigned pk2(float lo, float hi) { typedef __bf16 bf2_t __attribute__((ext_vector_type(2))); f32x2 v = {lo, hi}; bf2_t b = __builtin_convertvector(v, bf2_t); return __builtin_bit_cast(unsigned, b); }
DI float bflo(unsigned w) { return __builtin_bit_cast(float, w << 16); }
DI float bfhi(unsigned w) { return __builtin_bit_cast(float, w & 0xffff0000u); }
DI float bf2f(bfu b) { return __builtin_bit_cast(float, (unsigned)b << 16); }
DI float lane_get(float v, int src_lane) { return __builtin_bit_cast(float, __builtin_amdgcn_ds_bpermute(src_lane << 2, __builtin_bit_cast(int, v))); }
DI float wave_sum(float v, int lane) {
#pragma unroll
    for (int o = 1; o < 64; o <<= 1) v += lane_get(v, lane ^ o);
    return v;
}
DI int crow(int r, int hi) { return (r & 3) + 8 * (r >> 2) + 4 * hi; }
DI bf16x8 pack8(const f32x16& x, int s) { u32x4 p; p.x = pk2(x[8 * s], x[8 * s + 1]); p.y = pk2(x[8 * s + 2], x[8 * s + 3]); p.z = pk2(x[8 * s + 4], x[8 * s + 5]); p.w = pk2(x[8 * s + 6], x[8 * s + 7]); return __builtin_bit_cast(bf16x8, p); }
typedef short v4i16_t __attribute__((ext_vector_type(4)));
DI s16x4 vtr(const LAS bfu* p) { return __builtin_bit_cast(s16x4, __builtin_amdgcn_ds_read_tr16_b64_v4i16((LAS v4i16_t*)p)); }
DI bf16x8 cat8(s16x4 lo, s16x4 hi) { return (bf16x8){lo[0], lo[1], lo[2], lo[3], hi[0], hi[1], hi[2], hi[3]}; }
#define MFMA32(a, b, c) __builtin_amdgcn_mfma_f32_32x32x16_bf16((a), (b), (c), 0, 0, 0)

#define XB_TMO      128
#define XB_XCNT(j)  (256  + 64 * (j))
#define XB_XSUB(j)  (1280 + 64 * (j))
#define XB_XGEN(j)  (2304 + 64 * (j))
#define XB_TOP      3328
#define XB_TOPGEN   3392
#define XCD_BAR_WORDS 3456
#define XB_SPIN_CAP (1u << 18)

__device__ __forceinline__ unsigned xb_ld(unsigned* p)              { return __hip_atomic_load(p, __ATOMIC_RELAXED, __HIP_MEMORY_SCOPE_AGENT); }
__device__ __forceinline__ unsigned xb_add(unsigned* p, unsigned v) { return __hip_atomic_fetch_add(p, v, __ATOMIC_RELAXED, __HIP_MEMORY_SCOPE_AGENT); }
__device__ __forceinline__ unsigned xb_xcc_id() { return (unsigned)__builtin_amdgcn_s_getreg((3 << 11) | 20) & 0xFu; }
#define XB_SPIN(cond, bar) do { unsigned _sp = 0; while (cond) { __builtin_amdgcn_s_sleep(1); \
    if ((++_sp & 255u) == 0u) { if (xb_ld(&(bar)[XB_TMO])) break; if (_sp > XB_SPIN_CAP) { atomicAdd(&(bar)[XB_TMO], 1u); break; } } } } while (0)

struct XcdBarrier {
    unsigned* bar; unsigned x;
    volatile LAS unsigned* st;
};

__device__ __forceinline__ XcdBarrier xcd_barrier_post(unsigned* bar, volatile LAS unsigned* st) {
    XcdBarrier b; b.bar = bar; b.x = xb_xcc_id(); b.st = st;
    if (threadIdx.x == 0) (void)xb_add(&bar[XB_XCNT(b.x)], 1u);
    return b;
}
__device__ __forceinline__ void xcd_barrier_complete(unsigned* bar, unsigned x, unsigned& nloc, unsigned& nx) {
    const unsigned G = gridDim.x * gridDim.y * gridDim.z;
    unsigned sum, cnt, mine, sp = 0u;
    for (;;) {
        sum = 0u; cnt = 0u; mine = 0u;
#pragma unroll
        for (unsigned j = 0; j < 16; ++j) { const unsigned c = xb_ld(&bar[XB_XCNT(j)]); sum += c; cnt += (c > 0u) ? 1u : 0u; mine = (j == x) ? c : mine; }
        if (sum == G) break;
        __builtin_amdgcn_s_sleep(1);
        if ((++sp & 255u) == 0u) { if (xb_ld(&bar[XB_TMO])) break; if (sp > XB_SPIN_CAP) { atomicAdd(&bar[XB_TMO], 1u); break; } }
    }
    nloc = mine > 0u ? mine : 1u; nx = cnt > 0u ? cnt : 1u;
}

__device__ __forceinline__ void xcd_barrier(const XcdBarrier& b) {
    asm volatile("s_waitcnt vmcnt(0)" ::: "memory");
    __syncthreads();
    if (threadIdx.x == 0) {
        GAS unsigned* gbar_ = (GAS unsigned*)b.bar; asm volatile("" : "+s"(gbar_)); unsigned* bar = (unsigned*)gbar_; unsigned bx_ = b.x; asm volatile("" : "+s"(bx_));
        __builtin_amdgcn_s_waitcnt(0);
        unsigned nloc = b.st[0], nx = b.st[1];
        if (nloc == 0u) { xcd_barrier_complete(bar, bx_, nloc, nx); b.st[0] = nloc; b.st[1] = nx; }
        const unsigned old = xb_add(&bar[XB_XSUB(bx_)], 1u);
        const unsigned gen = old / nloc;
        if (old + 1u == (gen + 1u) * nloc) {
            __builtin_amdgcn_fence(__ATOMIC_RELEASE, "agent");
            asm volatile("s_waitcnt vmcnt(0)" ::: "memory");
            const unsigned og = xb_add(&bar[XB_TOP], 1u);
            const unsigned tg = og / nx;
            if (og + 1u == (tg + 1u) * nx) xb_add(&bar[XB_TOPGEN], 1u);
            else XB_SPIN(xb_ld(&bar[XB_TOPGEN]) == tg, bar);
            __builtin_amdgcn_fence(__ATOMIC_ACQUIRE, "agent");
            xb_add(&bar[XB_XGEN(bx_)], 1u);
            asm volatile("s_waitcnt vmcnt(0)" ::: "memory");
        } else {
            XB_SPIN(xb_ld(&bar[XB_XGEN(bx_)]) == gen, bar);
            __builtin_amdgcn_fence(__ATOMIC_ACQUIRE, "agent");
            asm volatile("s_waitcnt vmcnt(0)" ::: "memory");
        }
    }
    __syncthreads();
}
struct Frame {
    LAS unsigned char* lds;
    volatile LAS unsigned* MISC;
    gu32* ctl;
    int tid, lane, wave;
    int vcu, G;
};
struct Args { const float* in[28]; };

DI int tr_rowmap(int d, int rmap) { return rmap == 1 ? ((d >= 4 && d < 8) ? d + 4 : ((d >= 8 && d < 12) ? d - 4 : d)) : (rmap == 2 ? 8 * ((d >> 2) & 3) + 4 * (d >> 4) + (d & 3) : d); }
DI void tr_item(const float* W, size_t ldw, int k0, int nsrc0, bfu* WT, size_t Kd, int dstrow0, float scale, const float* kgain, LAS float* scr, int lane, int rmap = 0) {
    { float v[32];
      const float* wp = W + (size_t)(k0 + (lane >> 5)) * ldw + nsrc0 + (lane & 31);
#pragma unroll
      for (int i = 0; i < 32; ++i) v[i] = wp[(size_t)(2 * i) * ldw];
      if (kgain) {
#pragma unroll
          for (int i = 0; i < 32; ++i) v[i] *= scale * kgain[k0 + 2 * i + (lane >> 5)];
      } else {
#pragma unroll
          for (int i = 0; i < 32; ++i) v[i] *= scale;
      }
#pragma unroll
      for (int i = 0; i < 32; ++i) scr[(2 * i + (lane >> 5)) * 33 + (lane & 31)] = v[i]; }
    LDS_WAIT(); asm volatile("" ::: "memory");
    const int c = lane & 7;
#pragma unroll
    for (int j = 0; j < 4; ++j) { const int n = (lane >> 3) + 8 * j; const LAS float* s = scr + (8 * c) * 33 + n;
        u32x4 o; o.x = pk2(s[0 * 33], s[1 * 33]); o.y = pk2(s[2 * 33], s[3 * 33]); o.z = pk2(s[4 * 33], s[5 * 33]); o.w = pk2(s[6 * 33], s[7 * 33]);
        *(GAS u32x4*)(WT + (size_t)(dstrow0 + tr_rowmap(n, rmap)) * Kd + k0 + 8 * c) = o; }
    LDS_WAIT(); asm volatile("" ::: "memory");
}
DI void conv_gu(const float* Wg, const float* Wu, const float* kgain, bfu* WT, int r, LAS float* scr, int lane) {
    const int which = r / 5632, it = r % 5632, kb = it / 176, nb = it % 176, n0 = 32 * nb;
    tr_item(which ? Wu : Wg, DFF, 64 * kb, n0, WT, DM, 256 * (n0 / 128) + 128 * which + (n0 % 128), 1.0f, kgain, scr, lane);
}
DI void conv_down(const float* Wd, bfu* WT, int it, LAS float* scr, int lane) {
    const int kb = it / 64, nb = it % 64;
    tr_item(Wd, DM, 64 * kb, 32 * nb, WT, DFF, 32 * nb, 1.0f, nullptr, scr, lane);
}
DI void conv_in(const float* Wi, const float* kgain, bfu* WT, int it, LAS float* scr, int lane) {
    const int kb = it / 257, nb = it % 257, n0 = 32 * nb;
    const int dst = n0 < 6944 ? n0 : n0 + 736;
    const float sc = (n0 < 768 || (n0 >= 2304 && n0 < 3072)) ? C2 : 1.0f;
    const int rmap = ((n0 < 1536 || (n0 >= 2304 && n0 < 3840)) && (n0 & 63) == 0) ? 1 : ((n0 >= 6944 && n0 < 7968) ? 2 : 0);
    tr_item(Wi, NIN_SRC, 64 * kb, n0, WT, DM, dst, sc, kgain, scr, lane, rmap);
}
DI void conv_out(const float* Wo, bfu* WT, int it, LAS float* scr, int lane) {
    const int kb = it / 64, nb = it % 64;
    tr_item(Wo, DM, 64 * kb, 32 * nb, WT, NMIX, 32 * nb, 1.0f, nullptr, scr, lane);
}
DI void conv_gate(const float* Gf, const float* Gb, bfu* WT, int it) {
    const int r = it & 15, n = (it >> 4) % 384, dir = it / (16 * 384);
    (WT + (size_t)6944 * DM)[it] = (bfu)f2bf((dir ? Gb : Gf)[r * 384 + n]);
}
DI void sincos_d(double a, float& c, float& s) {
    const double k = rint(a * 0.15915494309189535);
    double r = fma(-k, 6.283185307179586, a); r = fma(-k, 2.4492935982947064e-16, r);
    const double r2 = r * r; double sv = 1.0, cv = 1.0;
#pragma unroll
    for (int n = 14; n >= 1; --n) { sv = 1.0 - sv * r2 * (1.0 / (double)((2 * n) * (2 * n + 1))); cv = 1.0 - cv * r2 * (1.0 / (double)((2 * n - 1) * (2 * n))); }
    s = (float)(sv * r); c = (float)cv;
}
__device__ const double INV_P[8] = {1.0, 0.19392274474868576, 0.03760603093086393, 0.007292664737217109, 0.001414213562373095, 0.0002742481756762073, 5.318295896944988e-05, 1.031338537721246e-05};
__device__ const double INV_AX[16] = {1.0, 0.5623413251903491, 0.31622776601683794, 0.1778279410038923, 0.1, 0.05623413251903491, 0.03162277660168379, 0.01778279410038923, 0.01, 0.005623413251903491, 0.0031622776601683794, 0.0017782794100389228, 0.001, 0.0005623413251903491, 0.00031622776601683794, 0.00017782794100389227};

DI void p0_prologue(Frame& F0, const Args& A) {
    Frame F = F0; F.tid = threadIdx.x; asm volatile("" : "+v"(F.tid), "+s"(F.wave), "+s"(F.vcu), "+s"(F.G)); F.lane = F.tid & 63;
    LAS float* scr = (LAS float*)(F.lds + F.wave * 16384);
    const int gw = F.vcu * NWAVES + F.wave, NGW = F.G * NWAVES;
    constexpr int I_GU = 2 * 5632, I_D = 5632, I_IN = 8224, I_OUT = 3072, I_LAYER = 2 * I_GU + 2 * I_D + I_IN + I_OUT;
    for (int it = gw; it < DEPTH * I_LAYER; it += NGW) {
        const int l = it / I_LAYER; int r = it % I_LAYER;
        bfu* wl = (bfu*)(((unsigned char*)A.in[27]) + WS_W + (size_t)l * W_LAYER);
        if (r < I_GU) { conv_gu(A.in[3] + (size_t)l * DM * DFF, A.in[4] + (size_t)l * DM * DFF, A.in[2] + l * DM, wl + W_GU1 / 2, r, scr, F.lane); continue; } r -= I_GU;
        if (r < I_D) { conv_down(A.in[5] + (size_t)l * DM * DFF, wl + W_D1 / 2, r, scr, F.lane); continue; } r -= I_D;
        if (r < I_IN) { conv_in(A.in[7] + (size_t)l * DM * NIN_SRC, A.in[6] + l * DM, wl + W_IN / 2, r, scr, F.lane); continue; } r -= I_IN;
        if (r < I_OUT) { conv_out(A.in[8] + (size_t)l * NMIX * DM, wl + W_OUT / 2, r, scr, F.lane); continue; } r -= I_OUT;
        if (r < I_GU) { conv_gu(A.in[22] + (size_t)l * DM * DFF, A.in[23] + (size_t)l * DM * DFF, A.in[21] + l * DM, wl + W_GU2 / 2, r, scr, F.lane); continue; } r -= I_GU;
        conv_down(A.in[24] + (size_t)l * DM * DFF, wl + W_D2 / 2, r, scr, F.lane);
    }
    const int gt = F.vcu * (NWAVES * 64) + F.tid, NGT = F.G * NWAVES * 64;
    for (int it = gt; it < DEPTH * 2 * 384 * 16; it += NGT) { const int l = it / (2 * 384 * 16), r = it % (2 * 384 * 16);
        conv_gate(A.in[14] + (size_t)l * 16 * 384, A.in[16] + (size_t)l * 16 * 384, (bfu*)(((unsigned char*)A.in[27]) + WS_W + (size_t)l * W_LAYER + W_IN), r); }
    f32x2* pcs = (f32x2*)(((unsigned char*)A.in[27]) + WS_TAB); f32x2* axcs = (f32x2*)(((unsigned char*)A.in[27]) + WS_TAB_AX);
    for (int it = gt; it < 8192 * 8 + 128 * 16; it += NGT) {
        float c, s;
        if (it < 8192 * 8) { sincos_d((double)(it >> 3) * INV_P[it & 7], c, s); pcs[it] = (f32x2){c, s}; }
        else { const int j = it - 8192 * 8; sincos_d((double)(j >> 4) * INV_AX[j & 15], c, s); axcs[j] = (f32x2){c, s}; }
    }
    if (blockIdx.x == 0 && F.wave == 0) {
#pragma unroll
        for (int l = 0; l < DEPTH; ++l) {
            const float a = wave_sum(A.in[9][l * 64 + F.lane] * A.in[10][l * 64 + F.lane], F.lane), b = wave_sum(A.in[11][l * 64 + F.lane] * A.in[12][l * 64 + F.lane], F.lane);
            const float lam_init = 0.8f - 0.6f * expf(-0.3f * (float)l);
            if (F.lane == 0) F.ctl[CW_LAM + l] = __builtin_bit_cast(unsigned, expf(a) - expf(b) + lam_init);
        }
    }
}

DI void cast_rows(Frame& F0, const float* x, bfu* xb, unsigned long long* rss) {
    Frame F = F0; F.tid = threadIdx.x; asm volatile("" : "+v"(F.tid), "+s"(F.wave), "+s"(F.vcu), "+s"(F.G)); F.lane = F.tid & 63;
    const int gw = F.vcu * NWAVES + F.wave, NGW = F.G * NWAVES;
    for (int m = gw; m < CH; m += NGW) {
        const f32x4* xr = (const f32x4*)(x + (size_t)m * DM) + F.lane;
        f32x4 v[8]; float s = 0.f;
#pragma unroll
        for (int j = 0; j < 8; ++j) { v[j] = xr[64 * j]; s += (v[j].x * v[j].x + v[j].y * v[j].y) + (v[j].z * v[j].z + v[j].w * v[j].w); }
        s = wave_sum(s, F.lane);
        u32x2* o8 = (u32x2*)(xb + (size_t)m * DM) + F.lane;
#pragma unroll
        for (int j = 0; j < 8; ++j) { u32x2 w; w.x = pk2(v[j].x, v[j].y); w.y = pk2(v[j].z, v[j].w); o8[64 * j] = w; }
        if (F.lane == 0) rss[m] = (unsigned long long)(s * 16777216.0f);
    }
}
DI void norm_cast_rows(Frame& F0, bfu* xb, const unsigned long long* rss_fin, const float* gain, float* yout, const float* xnext, unsigned long long* rss0) {
    Frame F = F0; F.tid = threadIdx.x; asm volatile("" : "+v"(F.tid), "+s"(F.wave), "+s"(F.vcu), "+s"(F.G)); F.lane = F.tid & 63;
    const int gw = F.vcu * NWAVES + F.wave, NGW = F.G * NWAVES;
    for (int m = gw; m < CH; m += NGW) {
        { const u32x4* xr = (const u32x4*)(xb + (size_t)m * DM) + F.lane;
          u32x4 v[4];
#pragma unroll
          for (int j = 0; j < 4; ++j) v[j] = xr[64 * j];
          const unsigned long long raw = __hip_atomic_load((const GAS unsigned long long*)(rss_fin + m), RLX_AGENT);
          const float rstd = 1.0f / sqrtf((float)raw * (1.0f / 16777216.0f) * (1.f / DM) + EPS);
          f32x4* yr = (f32x4*)(yout + (size_t)m * DM) + 2 * F.lane;
#pragma unroll
          for (int j = 0; j < 4; ++j) { const f32x4 g0 = ((const f32x4*)gain)[2 * (F.lane + 64 * j)], g1 = ((const f32x4*)gain)[2 * (F.lane + 64 * j) + 1];
              const f32x4 a = {bflo(v[j].x), bfhi(v[j].x), bflo(v[j].y), bfhi(v[j].y)}, b = {bflo(v[j].z), bfhi(v[j].z), bflo(v[j].w), bfhi(v[j].w)};
              yr[128 * j] = a * rstd * g0; yr[128 * j + 1] = b * rstd * g1; } }
        if (xnext) {
            asm volatile("" ::: "memory");
            const f32x4* xr = (const f32x4*)(xnext + (size_t)m * DM) + F.lane;
            f32x4 v[8]; float s = 0.f;
#pragma unroll
            for (int j = 0; j < 8; ++j) { v[j] = xr[64 * j]; s += (v[j].x * v[j].x + v[j].y * v[j].y) + (v[j].z * v[j].z + v[j].w * v[j].w); }
            s = wave_sum(s, F.lane);
            u32x2* o8 = (u32x2*)(xb + (size_t)m * DM) + F.lane;
#pragma unroll
            for (int j = 0; j < 8; ++j) { u32x2 w; w.x = pk2(v[j].x, v[j].y); w.y = pk2(v[j].z, v[j].w); o8[64 * j] = w; }
            if (F.lane == 0) rss0[m] = (unsigned long long)(s * 16777216.0f);
        }
    }
}

DI void clow_rows(Frame& F0, const bfu* XB, const unsigned long long* rss, const bfu* Wl, const bfu* GT, bfu* Uo, int R0) {
    Frame F = F0; F.tid = threadIdx.x; asm volatile("" : "+v"(F.tid), "+s"(F.wave)); F.lane = F.tid & 63;
    const int lane = F.lane, r32 = lane & 31, hi = lane >> 5, w = F.wave;
    LAS float* red = (LAS float*)F.lds;
    LAS float* cls = (LAS float*)(F.lds + 65536);
    { f32x16 acc[2] = {{}, {}};
      const bfu* a0 = XB + (size_t)(R0 + r32) * DM + 256 * w + 8 * hi; const bfu* a1 = a0 + (size_t)32 * DM; const bfu* bp = Wl + (size_t)r32 * DM + 256 * w + 8 * hi;
#pragma unroll
      for (int sb = 0; sb < 4; ++sb) { bf16x8 fa0[4], fa1[4], fb[4];
#pragma unroll
          for (int s = 0; s < 4; ++s) { const int k = 16 * (4 * sb + s); fa0[s] = *(const bf16x8*)(a0 + k); fa1[s] = *(const bf16x8*)(a1 + k); fb[s] = *(const bf16x8*)(bp + k); }
#pragma unroll
          for (int s = 0; s < 4; ++s) { acc[0] = MFMA32(fa0[s], fb[s], acc[0]); acc[1] = MFMA32(fa1[s], fb[s], acc[1]); } }
#pragma unroll
      for (int rb = 0; rb < 2; ++rb)
#pragma unroll
          for (int r = 0; r < 16; ++r) red[((w * 2 + rb) * 16 + r) * 64 + lane] = acc[rb][r]; }
    __syncthreads();
#pragma unroll
    for (int q = 0; q < 4; ++q) { const int o = F.tid + 512 * q, ol = o & 63, rr = (o >> 6) & 15, rb = o >> 10; float sum = 0.f;
#pragma unroll
        for (int ww = 0; ww < 8; ++ww) sum += red[ww * 2048 + o];
        const int row = 32 * rb + crow(rr, ol >> 5), col = ol & 31;
        const unsigned long long raw = __hip_atomic_load((const GAS unsigned long long*)(rss + R0 + row), RLX_AGENT);
        cls[row * 33 + col] = sum * __builtin_amdgcn_rsqf((float)raw * (1.0f / 16777216.0f) * (1.f / DM) + EPS); }
    __syncthreads();
#pragma unroll
    for (int cc = 0; cc < 3; ++cc) { const int cb = 3 * w + cc, dir = cb / 12, n0 = 32 * (cb % 12);
        const bf16x8 gf = *(const bf16x8*)(GT + (size_t)(dir * 384 + n0 + r32) * 16 + 8 * hi);
#pragma unroll
        for (int rb = 0; rb < 2; ++rb) { const LAS float* cp = cls + (32 * rb + r32) * 33 + 16 * dir + 8 * hi;
            u32x4 yw; yw.x = pk2(cp[0], cp[1]); yw.y = pk2(cp[2], cp[3]); yw.z = pk2(cp[4], cp[5]); yw.w = pk2(cp[6], cp[7]);
            f32x16 d = {}; d = MFMA32(gf, __builtin_bit_cast(bf16x8, yw), d);
            bfu* op = Uo + (size_t)(R0 + 32 * rb + r32) * NU + 6912 + dir * 384 + n0 + 4 * hi;
#pragma unroll
            for (int g = 0; g < 4; ++g) { u32x2 v; v.x = pk2(d[4 * g], d[4 * g + 1]); v.y = pk2(d[4 * g + 2], d[4 * g + 3]); *(u32x2*)(op + 8 * g) = v; } } }
    __syncthreads();
}

#define BW_SWZ(row, col) ((row) * 64 + ((((col) >> 3) ^ ((row) & 7)) << 3) + ((col) & 7))
DI void bwin_task(const bfu* U, int seqrow0, int L, int hb, int dil, int idx, bfu* Bo, float* Bl, LAS unsigned char* wl, LAS float* lsc, int lane) {
    asm volatile("" : "+v"(lane));
    const int N = L / dil, qb = idx / dil, rr = idx % dil;
    const int r32 = lane & 31, hi = lane >> 5, q4 = (lane & 15) >> 2, g16 = (lane >> 4) & 1, p4 = lane & 3, il = lane >> 3, dc = lane & 7;
    const bfu* Qc = U + U_BQ + hb * 64; const bfu* Kc = U + U_BK + hb * 64; const bfu* Vc = U + U_BV + hb * 64 + 8 * (dc ^ il);
    const int kbase = 64 * (qb - 1);
    const unsigned lds0 = (unsigned)(size_t)wl;
#define B_ROW(sub) ((size_t)(seqrow0 + (sub) * dil + rr))
#define B_DMA(g, buf) do { _Pragma("unroll") for (int b_ = 0; b_ < 8; ++b_) { int kp_ = kbase + 64 * (g) + 8 * b_ + il; kp_ = kp_ < 0 ? 0 : (kp_ > N - 1 ? N - 1 : kp_); \
        attn_body::glds16(Vc + B_ROW(kp_) * NU, (unsigned)__builtin_amdgcn_readfirstlane(lds0 + (buf) * 8192 + b_ * 1024)); } } while (0)
    B_DMA(0, 0); B_DMA(1, 1);
    bf16x8 pf[2][5][2];
#define BW_MASK(A, KBI, KB) do { \
          \
        if ((KBI) == 0) { _Pragma("unroll") for (int i = 0; i < 16; ++i) A[i] = (crow(i, hi) >= r32) ? A[i] : -1e30f; } \
        if ((KBI) == 4) { _Pragma("unroll") for (int i = 0; i < 16; ++i) A[i] = (crow(i, hi) <= r32) ? A[i] : -1e30f; } \
        const int kb0_ = kbase + 32 * (KB); \
        if (kb0_ < 0 || kb0_ >= N) { _Pragma("unroll") for (int i = 0; i < 16; ++i) A[i] = -1e30f; } } while (0)
#define BW_SOFTMAX(tb, SC) do { float m = SC[0][0]; \
        _Pragma("unroll") for (int kbi = 0; kbi < 5; ++kbi) _Pragma("unroll") for (int i = 0; i < 16; ++i) m = fmaxf(m, SC[kbi][i]); \
        m = fmaxf(m, lane_get(m, lane ^ 32)); float l = 0.f; \
        _Pragma("unroll") for (int kbi = 0; kbi < 5; ++kbi) _Pragma("unroll") for (int i = 0; i < 16; ++i) { const float p = __builtin_amdgcn_exp2f(SC[kbi][i] - m); SC[kbi][i] = p; l += p; } \
        l += lane_get(l, lane ^ 32); \
        _Pragma("unroll") for (int kbi = 0; kbi < 5; ++kbi) { pf[tb][kbi][0] = pack8(SC[kbi], 0); pf[tb][kbi][1] = pack8(SC[kbi], 1); } \
        if (hi == 0) { lsc[32 * (tb) + r32] = l; Bl[B_ROW(64 * qb + 32 * (tb) + r32) * 12 + hb] = m + __builtin_amdgcn_logf(l); }   } while (0)
    { bf16x8 qf[2][4];
#pragma unroll
      for (int tb = 0; tb < 2; ++tb) { const bfu* qp = Qc + B_ROW(64 * qb + 32 * tb + r32) * NU + 8 * hi;
#pragma unroll
          for (int st = 0; st < 4; ++st) qf[tb][st] = *(const bf16x8*)(qp + 16 * st); }
      f32x16 sc0[5], sc1[5];
#pragma unroll
      for (int kb = 0; kb < 6; ++kb) {
          int kp = kbase + 32 * kb + r32; kp = kp < 0 ? 0 : (kp > N - 1 ? N - 1 : kp);
          const bfu* kr = Kc + B_ROW(kp) * NU + 8 * hi;
          const bf16x8 k0 = *(const bf16x8*)(kr), k1 = *(const bf16x8*)(kr + 16), k2 = *(const bf16x8*)(kr + 32), k3 = *(const bf16x8*)(kr + 48);
          if (kb <= 4) { f32x16 a = {}; a = MFMA32(k0, qf[0][0], a); a = MFMA32(k1, qf[0][1], a); a = MFMA32(k2, qf[0][2], a); a = MFMA32(k3, qf[0][3], a); BW_MASK(a, kb, kb); sc0[kb <= 4 ? kb : 0] = a; }
          if (kb >= 1) { f32x16 a = {}; a = MFMA32(k0, qf[1][0], a); a = MFMA32(k1, qf[1][1], a); a = MFMA32(k2, qf[1][2], a); a = MFMA32(k3, qf[1][3], a); BW_MASK(a, kb - 1, kb); sc1[kb >= 1 ? kb - 1 : 0] = a; }
          if (kb == 4) BW_SOFTMAX(0, sc0);
      }
      BW_SOFTMAX(1, sc1); }
#undef BW_MASK
#undef BW_SOFTMAX
    f32x16 o[2][2] = {{{}, {}}, {{}, {}}};
#pragma unroll
    for (int g = 0; g < 3; ++g) {
        if (g == 1) asm volatile("s_waitcnt vmcnt(8)" ::: "memory"); else asm volatile("s_waitcnt vmcnt(0)" ::: "memory");
        const LAS bfu* vv = (const LAS bfu*)(wl + (g & 1) * 8192);
#pragma unroll
        for (int tb = 0; tb < 2; ++tb)
#pragma unroll
            for (int kbl = 0; kbl < 2; ++kbl) { const int kbi = 2 * g + kbl - tb;
                if (kbi >= 0 && kbi <= 4) {
#pragma unroll
                    for (int s2 = 0; s2 < 2; ++s2)
#pragma unroll
                        for (int db = 0; db < 2; ++db) { const LAS bfu* vp = vv + BW_SWZ(32 * kbl + 16 * s2 + 4 * hi + q4, 32 * db + 16 * g16 + 4 * p4);
                            o[tb][db] = MFMA32(pf[tb][kbi][s2], cat8(vtr(vp), vtr(vp + 8 * 64)), o[tb][db]); }
                } }
        LDS_WAIT();
        if (g == 0) B_DMA(2, 0);
    }
#pragma unroll
    for (int tb = 0; tb < 2; ++tb)
#pragma unroll
        for (int i = 0; i < 16; ++i) { const int ql = crow(i, hi); const float inv = __builtin_amdgcn_rcpf(lsc[32 * tb + ql]);
            bfu* op = Bo + B_ROW(64 * qb + 32 * tb + ql) * 768 + hb * 64 + r32;
            op[0] = (bfu)f2bf(o[tb][0][i] * inv); op[32] = (bfu)f2bf(o[tb][1][i] * inv); }
    LDS_WAIT();
#undef B_ROW
#undef B_DMA
}

DI float logsig16(float x) { const float e = __builtin_amdgcn_exp2f(-1.4426950408889634f * fabsf(x)); return (fminf(x, 0.f) - 0.6931471805599453f * __builtin_amdgcn_logf(1.0f + e)) * 0.0625f; }
#define GLA_SWZ(row, col) ((row) * 64 + ((((col) >> 3) ^ ((row) & 7)) << 3) + ((col) & 7))
DI void gla_pre_item(const bfu* U, int seqrow0, int L, int hc, int dir, int c, const float* gbias, bfu* QDi, bfu* KIi, float* DECi, int lane) {
    const int il = lane >> 3, dc = lane & 7;
    const bfu* Qc = U + U_CQ + hc * 64 + 8 * dc; const bfu* Kc = U + U_CK + hc * 64 + 8 * dc; const bfu* Gc = U + (dir ? U_GB : U_GF) + hc * 64 + 8 * dc;
    const f32x4 b0 = *(const f32x4*)(gbias + hc * 64 + 8 * dc), b1 = *(const f32x4*)(gbias + hc * 64 + 8 * dc + 4);
    const float bias8[8] = {b0.x, b0.y, b0.z, b0.w, b1.x, b1.y, b1.z, b1.w};
#define G_ROW(p) ((size_t)(seqrow0 + (dir ? (L - 1 - (p)) : (p))))
    u32x4 aq[8], ak[8], ag[8];
#pragma unroll
    for (int bt = 0; bt < 8; ++bt) { const size_t rw = G_ROW(64 * c + 8 * bt + il) * NU; aq[bt] = *(const u32x4*)(Qc + rw); ak[bt] = *(const u32x4*)(Kc + rw); ag[bt] = *(const u32x4*)(Gc + rw); }
    float carry[8];
#pragma unroll
    for (int e = 0; e < 8; ++e) carry[e] = 0.f;
#pragma unroll
    for (int bt = 0; bt < 8; ++bt) {
        const u32x4 cq = aq[bt], ck = ak[bt], cg = ag[bt];
        float cum[8];
#pragma unroll
        for (int w = 0; w < 4; ++w) { cum[2 * w] = logsig16(bflo(cg[w]) + bias8[2 * w]); cum[2 * w + 1] = logsig16(bfhi(cg[w]) + bias8[2 * w + 1]); }
#pragma unroll
        for (int e = 0; e < 8; ++e) { float t = cum[e]; float y = lane_get(t, lane - 8); if (il >= 1) t += y; y = lane_get(t, lane - 16); if (il >= 2) t += y; y = lane_get(t, lane - 32); if (il >= 4) t += y; cum[e] = carry[e] + t; }
#pragma unroll
        for (int e = 0; e < 8; ++e) carry[e] = lane_get(cum[e], 56 + dc);
        u32x4 oq, ok;
#pragma unroll
        for (int w = 0; w < 4; ++w) {
            const float e0 = __builtin_amdgcn_exp2f(1.4426950408889634f * cum[2 * w]), e1 = __builtin_amdgcn_exp2f(1.4426950408889634f * cum[2 * w + 1]);
            oq[w] = pk2(bflo(cq[w]) * (0.125f * e0), bfhi(cq[w]) * (0.125f * e1));
            ok[w] = pk2(bflo(ck[w]) * __builtin_amdgcn_rcpf(e0), bfhi(ck[w]) * __builtin_amdgcn_rcpf(e1)); }
        const int off = (8 * bt + il) * 64 + 8 * (dc ^ il);
        *(u32x4*)(QDi + off) = oq; *(u32x4*)(KIi + off) = ok;
    }
    if (il == 0) { f32x4 d0, d1;
#pragma unroll
        for (int e = 0; e < 4; ++e) { d0[e] = __builtin_amdgcn_exp2f(1.4426950408889634f * carry[e]); d1[e] = __builtin_amdgcn_exp2f(1.4426950408889634f * carry[4 + e]); }
        *(f32x4*)(DECi + 8 * dc) = d0; *(f32x4*)(DECi + 8 * dc + 4) = d1; }
#undef G_ROW
}
DI void gla_pre_rows(Frame& F0, const bfu* U, int L, const float* bias_f, const float* bias_b, bfu* QD, bfu* KI, float* DEC) {
    Frame F = F0; F.tid = threadIdx.x; asm volatile("" : "+v"(F.tid), "+s"(F.wave), "+s"(F.vcu), "+s"(F.G)); F.lane = F.tid & 63;
    const int gw = F.vcu * NWAVES + F.wave, NGW = F.G * NWAVES, NC = L >> 6;
    for (int it = gw; it < (CH / 64) * 12; it += NGW) {
        const int c = it % NC, dir = (it / NC) & 1, hc = (it / (2 * NC)) % 6, sq = it / (12 * NC);
        gla_pre_item(U, sq * L, L, hc, dir, c, dir ? bias_b : bias_f, QD + (size_t)it * 4096, KI + (size_t)it * 4096, DEC + (size_t)it * 64, F.lane);
    }
}
DI void gla_task(const bfu* U, int seqrow0, int L, int hc, int dir, int half, const bfu* QD, const bfu* KI, const float* DEC, int item0, bfu* Oc, LAS unsigned char* wl, int lane) {
    asm volatile("" : "+v"(lane));
    const int r32 = lane & 31, hi = lane >> 5, q4 = (lane & 15) >> 2, g16 = (lane >> 4) & 1, p4 = lane & 3, il = lane >> 3, dc = lane & 7;
    LAS float* decl = (LAS float*)(wl + 49152);
    const bfu* Vc = U + U_CV + hc * 128 + half * 64 + 8 * (dc ^ il);
    f32x16 S[2][2] = {{{}, {}}, {{}, {}}};
    const int NC = L >> 6;
#define G_ROW(p) ((size_t)(seqrow0 + (dir ? (L - 1 - (p)) : (p))))
    const unsigned lds0 = (unsigned)(size_t)wl;
#define G_DMA(cc) do { const unsigned lb_ = lds0 + ((cc) & 1) * 24576; const bfu* qs_ = QD + (size_t)(item0 + (cc)) * 4096 + lane * 8; const bfu* ks_ = KI + (size_t)(item0 + (cc)) * 4096 + lane * 8; \
        _Pragma("unroll") for (int b_ = 0; b_ < 8; ++b_) { attn_body::glds16(qs_ + b_ * 512, (unsigned)__builtin_amdgcn_readfirstlane(lb_ + b_ * 1024)); attn_body::glds16(ks_ + b_ * 512, (unsigned)__builtin_amdgcn_readfirstlane(lb_ + 8192 + b_ * 1024)); \
            attn_body::glds16(Vc + G_ROW(64 * (cc) + 8 * b_ + il) * NU, (unsigned)__builtin_amdgcn_readfirstlane(lb_ + 16384 + b_ * 1024)); } } while (0)
    G_DMA(0);
    float dnext = DEC[(size_t)item0 * 64 + lane];
    for (int c = 0; c < NC; ++c) {
        asm volatile("s_waitcnt vmcnt(0)" ::: "memory");
        decl[lane] = dnext;
        if (c + 1 < NC) { G_DMA(c + 1); dnext = DEC[(size_t)(item0 + c + 1) * 64 + lane]; }
        const LAS bfu* qd = (const LAS bfu*)(wl + (c & 1) * 24576); const LAS bfu* ki = qd + 4096; const LAS bfu* vv = qd + 8192;
        LDS_WAIT();
        bf16x8 xf[3][2];
#pragma unroll
        for (int blk = 0; blk < 3; ++blk) { const int sb = blk == 2 ? 1 : 0, tb = blk >= 1 ? 1 : 0;
            f32x16 a = {};
#pragma unroll
            for (int st = 0; st < 4; ++st) { const bf16x8 af = *(const LAS bf16x8*)(ki + GLA_SWZ(32 * sb + r32, 16 * st + 8 * hi)); const bf16x8 bf = *(const LAS bf16x8*)(qd + GLA_SWZ(32 * tb + r32, 16 * st + 8 * hi));
                a = MFMA32(af, bf, a); }
            if (sb == tb) {
#pragma unroll
                for (int i = 0; i < 16; ++i) a[i] = (crow(i, hi) <= r32) ? a[i] : 0.f; }
            xf[blk][0] = pack8(a, 0); xf[blk][1] = pack8(a, 1); }
#pragma unroll
        for (int tb = 0; tb < 2; ++tb)
#pragma unroll
            for (int eb = 0; eb < 2; ++eb) {
                f32x16 o = {};
#pragma unroll
                for (int sb = 0; sb < 2; ++sb) { if (sb <= tb) { const int blk = sb == 0 ? tb : 2;
#pragma unroll
                    for (int s2 = 0; s2 < 2; ++s2) { const LAS bfu* vp = vv + GLA_SWZ(32 * sb + 16 * s2 + 4 * hi + q4, 32 * eb + 16 * g16 + 4 * p4);
                        o = MFMA32(xf[blk][s2], cat8(vtr(vp), vtr(vp + 8 * 64)), o); } } }
#pragma unroll
                for (int db = 0; db < 2; ++db)
#pragma unroll
                    for (int s2 = 0; s2 < 2; ++s2) { const int qrow = 32 * tb + r32, qcol = 32 * db + 16 * s2 + 4 * hi;
                        const bf16x8 af = cat8(*(const LAS s16x4*)(qd + GLA_SWZ(qrow, qcol)), *(const LAS s16x4*)(qd + GLA_SWZ(qrow, qcol + 8)));
                        o = MFMA32(af, pack8(S[db][eb], s2), o); }
#pragma unroll
                for (int i = 0; i < 16; i += 2) { const unsigned w = pk2(o[i], o[i + 1]);
                    Oc[G_ROW(64 * c + 32 * tb + crow(i, hi)) * 768 + hc * 128 + half * 64 + 32 * eb + r32] = (bfu)(w & 0xffffu); Oc[G_ROW(64 * c + 32 * tb + crow(i + 1, hi)) * 768 + hc * 128 + half * 64 + 32 * eb + r32] = (bfu)(w >> 16); }
            }
#pragma unroll
        for (int db = 0; db < 2; ++db)
#pragma unroll
            for (int eb = 0; eb < 2; ++eb) {
#pragma unroll
                for (int st = 0; st < 4; ++st) { const int srow = 16 * st + 8 * hi + q4, kcol = 32 * db + 16 * g16 + 4 * p4, vcol = 32 * eb + 16 * g16 + 4 * p4;
                    S[db][eb] = MFMA32(cat8(vtr(ki + GLA_SWZ(srow, kcol)), vtr(ki + GLA_SWZ(srow + 4, kcol))), cat8(vtr(vv + GLA_SWZ(srow, vcol)), vtr(vv + GLA_SWZ(srow + 4, vcol))), S[db][eb]); }
#pragma unroll
                for (int i = 0; i < 16; ++i) S[db][eb][i] *= decl[32 * db + crow(i, hi)];
            }
        LDS_WAIT();
    }
#undef G_ROW
#undef G_DMA
}

DI void finalize_rows(Frame& F0, const float* gain_a, const float* gain_c, int l, const bfu* U, const bfu* OA, const bfu* BO, const float* BL, const bfu* OC, bfu* MIX) {
    Frame F = F0; F.tid = threadIdx.x; asm volatile("" : "+v"(F.tid), "+s"(F.wave), "+s"(F.vcu), "+s"(F.G)); F.lane = F.tid & 63;
    const int lane = F.lane, hl = lane & 31, rsel = lane >> 5;
    const int gw = F.vcu * NWAVES + F.wave, NGW = F.G * NWAVES;
    const float lam = __builtin_bit_cast(float, (unsigned)F.ctl[CW_LAM + l]);
    const float lam_init = 0.8f - 0.6f * expf(-0.3f * (float)l);
    const f32x4 ga = ((const f32x4*)gain_a)[hl], gc = ((const f32x4*)gain_c)[hl];
#define HALF_SUM(v) do { _Pragma("unroll") for (int o_ = 1; o_ < 32; o_ <<= 1) v += lane_get(v, lane ^ o_); } while (0)
    for (int m2 = gw; m2 < CH / 2; m2 += NGW) {
        const size_t m = (size_t)(2 * m2 + rsel);
        u32x2 fw[6], bw[6], g2[6], b0[6], b1[6], b2[6]; float l0[6], l1[6], l2[6];
#pragma unroll
        for (int h = 0; h < 6; ++h) { fw[h] = *(const u32x2*)(OC + m * 768 + h * 128 + 4 * hl); bw[h] = *(const u32x2*)(OC + (size_t)CH * 768 + m * 768 + h * 128 + 4 * hl); g2[h] = *(const u32x2*)(U + m * NU + U_CG + h * 128 + 4 * hl); }
#pragma unroll
        for (int it = 0; it < 6; ++it) { const int h = 2 * it + (hl >> 4), col = h * 64 + 4 * (hl & 15);
            l0[it] = BL[m * 12 + h]; l1[it] = BL[(size_t)CH * 12 + m * 12 + h]; l2[it] = BL[(size_t)2 * CH * 12 + m * 12 + h];
            b0[it] = *(const u32x2*)(BO + m * 768 + col); b1[it] = *(const u32x2*)(BO + (size_t)CH * 768 + m * 768 + col); b2[it] = *(const u32x2*)(BO + (size_t)2 * CH * 768 + m * 768 + col); }
        asm volatile("" ::: "memory");
#pragma unroll
        for (int h = 0; h < 6; ++h) {
            const f32x4 y = {bflo(fw[h].x) + bflo(bw[h].x), bfhi(fw[h].x) + bfhi(bw[h].x), bflo(fw[h].y) + bflo(bw[h].y), bfhi(fw[h].y) + bfhi(bw[h].y)};
            float ss = (y.x * y.x + y.y * y.y) + (y.z * y.z + y.w * y.w); HALF_SUM(ss);
            const float rstd = 1.0f / sqrtf(ss * (1.f / 128.f) + EPS);
            u32x2 o; o.x = pk2(y.x * rstd * gc.x * pg8::silu_f(bflo(g2[h].x)), y.y * rstd * gc.y * pg8::silu_f(bfhi(g2[h].x))); o.y = pk2(y.z * rstd * gc.z * pg8::silu_f(bflo(g2[h].y)), y.w * rstd * gc.w * pg8::silu_f(bfhi(g2[h].y)));
            *(u32x2*)(MIX + m * NMIX + 1536 + h * 128 + 4 * hl) = o; }
#pragma unroll
        for (int it = 0; it < 6; ++it) { const int h = 2 * it + (hl >> 4), col = h * 64 + 4 * (hl & 15);
            const float mx = fmaxf(l0[it], fmaxf(l1[it], l2[it])); const float w0 = __builtin_amdgcn_exp2f(l0[it] - mx), w1 = __builtin_amdgcn_exp2f(l1[it] - mx), w2 = __builtin_amdgcn_exp2f(l2[it] - mx);
            const float inv = 1.0f / (w0 + w1 + w2);
            u32x2 o; o.x = pk2((w0 * bflo(b0[it].x) + w1 * bflo(b1[it].x) + w2 * bflo(b2[it].x)) * inv, (w0 * bfhi(b0[it].x) + w1 * bfhi(b1[it].x) + w2 * bfhi(b2[it].x)) * inv);
            o.y = pk2((w0 * bflo(b0[it].y) + w1 * bflo(b1[it].y) + w2 * bflo(b2[it].y)) * inv, (w0 * bfhi(b0[it].y) + w1 * bfhi(b1[it].y) + w2 * bfhi(b2[it].y)) * inv);
            *(u32x2*)(MIX + m * NMIX + 768 + col) = o; }
    }
#undef HALF_SUM
}

__global__ void __launch_bounds__(NWAVES * 64, 2) hybrid_fwd(Args args) {
    extern __shared__ __attribute__((aligned(16))) unsigned char lds[];
    Frame F;
    F.lds = (LAS unsigned char*)lds;
    F.MISC = (volatile LAS unsigned*)(F.lds + MISC_OFF);
    F.tid = 0; F.lane = 0; F.wave = __builtin_amdgcn_readfirstlane((int)threadIdx.x >> 6);
    F.G = gridDim.x; { const int bx = blockIdx.x; F.vcu = (F.G % 8 == 0) ? (bx % 8) * (F.G / 8) + bx / 8 : bx; }
    GAS unsigned char* ws = (GAS unsigned char*)args.in[27];
    F.ctl = (gu32*)(ws + WS_CTL);
    for (int u = threadIdx.x; u < (LDS_BYTES - RING_BYTES) / 4; u += NWAVES * 64) ((LAS unsigned*)(F.lds + RING_BYTES))[u] = 0u;
    __syncthreads();
    XcdBarrier bar = xcd_barrier_post((unsigned*)(F.ctl + CW_BAR), F.MISC + 8);
#if defined(PROBE)
#ifndef PROBE_BLK
#define PROBE_BLK 0
#endif
#ifdef PROBE_CYC
#define PROBE_NOW() (__builtin_readcyclecounter() / 20)
#else
#define PROBE_NOW() __builtin_amdgcn_s_memrealtime()
#endif
#define PROBE_MARK(bit) do { if (((PROBE) >> (bit)) & 1) { if (blockIdx.x == PROBE_BLK && threadIdx.x == 0) { const unsigned long long t_ = PROBE_NOW(); F.MISC[16] = (unsigned)t_; F.MISC[17] = (unsigned)(t_ >> 32); } } } while (0)
#define PROBE_ACC(bit) do { if (((PROBE) >> (bit)) & 1) { if (blockIdx.x == PROBE_BLK && threadIdx.x == 0) { const unsigned long long t_ = PROBE_NOW(); const unsigned long long m_ = ((unsigned long long)F.MISC[17] << 32) | F.MISC[16]; \
        unsigned long long a_ = ((unsigned long long)F.MISC[19] << 32) | F.MISC[18]; a_ += t_ - m_; F.MISC[18] = (unsigned)a_; F.MISC[19] = (unsigned)(a_ >> 32); } } } while (0)
#define PROBE_MARK2(bit) do { if (((PROBE) >> (bit)) & 1) { if (blockIdx.x == PROBE_BLK && threadIdx.x == 0) { const unsigned long long t_ = __builtin_amdgcn_s_memrealtime(); F.MISC[20] = (unsigned)t_; F.MISC[21] = (unsigned)(t_ >> 32); } } } while (0)
#define PROBE_ACC2(bit) do { if (((PROBE) >> (bit)) & 1) { if (blockIdx.x == PROBE_BLK && threadIdx.x == 0) { const unsigned long long t_ = __builtin_amdgcn_s_memrealtime(); const unsigned long long m_ = ((unsigned long long)F.MISC[21] << 32) | F.MISC[20]; \
        unsigned long long a_ = ((unsigned long long)F.MISC[19] << 32) | F.MISC[18]; a_ += t_ - m_; F.MISC[18] = (unsigned)a_; F.MISC[19] = (unsigned)(a_ >> 32); } } } while (0)
#else
#define PROBE_MARK(bit) do {} while (0)
#define PROBE_ACC(bit) do {} while (0)
#define PROBE_MARK2(bit) do {} while (0)
#define PROBE_ACC2(bit) do {} while (0)
#endif
    int zz = 0;
#define AIN(i) (args.in[(i) + zz])
#define BXO ({ int b_ = (int)blockIdx.x; asm volatile("" : "+s"(b_)); b_; })
#define BXO_G ({ int g_ = F.G; asm volatile("" : "+s"(g_)); g_; })
#define GRID_BAR() do { PROBE_MARK2(14); xcd_barrier(bar); PROBE_ACC2(14); asm volatile("" : "+s"(ws), "+s"(l), "+s"(c), "+s"(zz)); } while (0)

#define XN ((bfu*)(ws + WS_XN))
#define U ((bfu*)(ws + WS_U))
#define HID ((bfu*)(ws + WS_U))
#define MIX ((bfu*)(ws + WS_MIX))
#define OA ((bfu*)(ws + WS_OA))
#define BO ((bfu*)(ws + WS_BO))
#define BL ((float*)(ws + WS_BL))
#define OC ((bfu*)(ws + WS_OC))
#define RSS(j) ((unsigned long long*)(ws + WS_RSS) + (size_t)(c * 7 + (j)) * CH)
#define YCH ((unsigned char*)AIN(26) + (size_t)c * CH * DM * 4)
#define GQD ((bfu*)YCH)
#define GKI ((bfu*)(YCH + 25165824))
#define GDEC ((float*)(YCH + 50331648))
#define pcs ((const f32x2*)(ws + WS_TAB))
#define axcs ((const f32x2*)(ws + WS_TAB_AX))
#define WL ((const bfu*)(ws + WS_W + (size_t)l * W_LAYER))
#define XSRC(cc) (((cc) < 2) ? AIN(0) + (size_t)(cc) * CH * DM : AIN(1) + (size_t)((cc) - 2) * CH * DM)
#define L ((c < 2) ? 8192 : 2048)
#define nseq (CH / L)

    PROBE_MARK(8);
#ifndef NO_PRO
    p0_prologue(F, args);
#endif
    { int c = 0, l = 0;
      cast_rows(F, XSRC(0), XN, RSS(0));
      GRID_BAR(); }
    PROBE_ACC(8);
    for (int c = 0; c < NCHUNK; ++c) {
        int l = 0;
        for (l = 0; l < DEPTH; ++l) {

            PROBE_MARK(0);
            { pg8::Gemm g{XN, WL + W_GU1 / 2, CH, 2 * DFF, DM}; pg8::StaticOrder S; S.init(CH, 2 * DFF, BXO_G, BXO);
              pg8::EpiSwigluN E{HID, DFF, RSS(3 * l)};
              pg8::gemm_phase<pg8::EpiSwigluN, pg8::StaticOrder, true, true>(F.lds, g, S, E); }
            GRID_BAR();
            PROBE_ACC(0);
            PROBE_MARK(1);
            { pg8::Gemm g{HID, WL + W_D1 / 2, CH, DM, DFF}; pg8::PanelOrder S; S.S.init(CH, DM, BXO_G, BXO);
              pg8::EpiResidN<true> E{XN, DM, RSS(3 * l + 1)};
              pg8::gemm_phase<pg8::EpiResidN<true>, pg8::PanelOrder, true, true>(F.lds, g, S, E); }
            GRID_BAR();
            PROBE_ACC(1);

            PROBE_MARK(2);
            for (int R0 = 64 * BXO; R0 < CH; R0 += 64 * BXO_G) clow_rows(F, XN, RSS(3 * l + 1), WL + W_IN / 2 + (size_t)6912 * DM, WL + W_IN / 2 + (size_t)6944 * DM, U, R0);
            { pg8::Gemm g{XN, WL + W_IN / 2, CH, NU, DM}; pg8::SkipOrder S; S.S.init(CH, NU - 768, BXO_G, BXO);
              pg8::EpiPrepN E{U, NU, RSS(3 * l + 1), L - 1, (const float*)pcs, (const float*)axcs, AIN(19) + l * 64, AIN(20) + l * 64, (LAS float*)(F.lds + 132096), F.lds + 140288};
              pg8::gemm_phase<pg8::EpiPrepN, pg8::SkipOrder, true, true>(F.lds, g, S, E); }
            GRID_BAR();
            PROBE_ACC(2);
            PROBE_MARK(4);
            gla_pre_rows(F, U, L, AIN(15) + l * 384, AIN(17) + l * 384, GQD, GKI, GDEC);
            GRID_BAR();
            PROBE_ACC(4);

            PROBE_MARK(5);
            {
                gu32* qh = F.ctl + CW_Q + 64 * ((l * NCHUNK + c) * 4);
#define DEQUEUE(kind, var) do { if (threadIdx.x == 0) F.MISC[0] = __hip_atomic_fetch_add(qh + 64 * (kind), 1u, RLX_AGENT); __syncthreads(); var = (int)F.MISC[0]; __syncthreads(); } while (0)
#define DEQ_ISSUE(kind) do { if (threadIdx.x == 0) pend = __hip_atomic_fetch_add(qh + 64 * (kind), 1u, RLX_AGENT); } while (0)
#define DEQ_TAKE(var) do { if (threadIdx.x == 0) F.MISC[0] = pend; __syncthreads(); var = (int)F.MISC[0]; __syncthreads(); } while (0)
                const int n_gla = nseq * 24 / 2;
                PROBE_MARK(10);
                {
                for (;;) { int un; DEQUEUE(0, un); if (un >= n_gla) break;

                    if (F.wave < 2) { const int task = un * 2 + F.wave, half = task & 1, dir = (task >> 1) & 1, hc = (task >> 2) % 6, sq = task / 24;
#ifndef NO_GLA
                        gla_task(U, sq * L, L, hc, dir, half, GQD, GKI, GDEC, ((sq * 6 + hc) * 2 + dir) * (L >> 6), OC + (size_t)dir * CH * 768, F.lds + F.wave * 50176, (int)(threadIdx.x & 63));
#endif
 }
                } }
                PROBE_ACC(10); PROBE_MARK(11);
                const int nqb = L / 256, n_aa = nseq * 6 * nqb;
                { const float lam_a = __builtin_bit_cast(float, (unsigned)F.ctl[CW_LAM + l]), sc_a = 1.0f - (0.8f - 0.6f * expf(-0.3f * (float)l));
                for (;;) { int un; DEQUEUE(1, un); if (un >= n_aa) break;
                    const int sq = un / (6 * nqb), rem = un % (6 * nqb), a = rem / nqb, qb = rem % nqb;
                    const size_t r0 = (size_t)sq * L;
#ifndef NO_ATT
                    attn_av::attn_unit_v<8, 1>((const attn_body::bf16*)(U + (r0 + (size_t)qb * 256) * NU + U_AQ + a * 128), (const attn_body::bf16*)(U + r0 * NU + U_AK + a * 128),
                                            (const attn_body::bf16*)(U + r0 * NU + U_AV + a * 128), (attn_body::bf16*)nullptr, 0, L / 64, (char*)lds, 0.f, nullptr, 0.f);
                    attn_av::attn_unit_v<8, 2>((const attn_body::bf16*)(U + (r0 + (size_t)qb * 256) * NU + U_AQ + a * 128 + 64), (const attn_body::bf16*)(U + r0 * NU + U_AK + a * 128 + 64),
                                            (const attn_body::bf16*)(U + r0 * NU + U_AV + a * 128), (attn_body::bf16*)(MIX + (r0 + (size_t)qb * 256) * NMIX + a * 128), NMIX, L / 64, (char*)lds, lam_a, AIN(13) + l * 128, sc_a);
#endif
                } }
                PROBE_ACC(11); PROBE_MARK(12);
                const int n_ad = nseq * 12 * nqb;
                for (;;) { int un; DEQUEUE(3, un); if (un >= n_ad) break;
                    const int sq = un / (12 * nqb), rem = un % (12 * nqb), hq = rem / nqb, qb = rem % nqb;
                    const size_t r0 = (size_t)sq * L;
#ifndef NO_ATT
                    attn_body::attn_unit<8>((const attn_body::bf16*)(U + (r0 + (size_t)qb * 256) * NU + U_DQ + hq * 64), (const attn_body::bf16*)(U + r0 * NU + U_DK + (hq / 3) * 64), (const attn_body::bf16*)(U + r0 * NU + U_DV + (hq / 3) * 64),
                                            (attn_body::bf16*)(MIX + (r0 + (size_t)qb * 256) * NMIX + 2304 + hq * 64), NMIX, L / 64, (char*)lds);
#endif
                }
                PROBE_ACC(12); PROBE_MARK(13);
                const int tps = L / 64, n_b = nseq * 36 * tps / 8;
                { unsigned pend = 0u; DEQ_ISSUE(2);
                for (;;) { int un; DEQ_TAKE(un); if (un >= n_b) break; DEQ_ISSUE(2);
                    const int task = un * 8 + F.wave, idx = task % tps, pat = (task / tps) % 3, hb = (task / (3 * tps)) % 12, sq = task / (36 * tps);
#ifndef NO_B
                    bwin_task(U, sq * L, L, hb, pat == 0 ? 1 : (pat == 1 ? 4 : 16), idx, BO + (size_t)pat * CH * 768, BL + (size_t)pat * CH * 12, F.lds + F.wave * 16384, (LAS float*)(F.lds + 132096) + F.wave * 64, (int)(threadIdx.x & 63));
#endif
                } }
                PROBE_ACC(13);
#undef DEQUEUE
#undef DEQ_ISSUE
#undef DEQ_TAKE
            }
            GRID_BAR();
            PROBE_ACC(5);
            PROBE_MARK(6);
#ifndef NO_FIN
            finalize_rows(F, AIN(13) + l * 128, AIN(18) + l * 128, l, U, OA, BO, BL, OC, MIX);
#endif
            GRID_BAR();
            PROBE_ACC(6);
            PROBE_MARK(3);
            { pg8::Gemm g{MIX, WL + W_OUT / 2, CH, DM, NMIX}; pg8::PanelOrder S; S.S.init(CH, DM, BXO_G, BXO);
              pg8::EpiResidN<false> E{XN, DM, RSS(3 * l + 2)};
              pg8::gemm_phase<pg8::EpiResidN<false>, pg8::PanelOrder, true, true>(F.lds, g, S, E); }
            GRID_BAR();
            PROBE_ACC(3);

            PROBE_MARK(0);
            { pg8::Gemm g{XN, WL + W_GU2 / 2, CH, 2 * DFF, DM}; pg8::StaticOrder S; S.init(CH, 2 * DFF, BXO_G, BXO);
              pg8::EpiSwigluN E{HID, DFF, RSS(3 * l + 2)};
              pg8::gemm_phase<pg8::EpiSwigluN, pg8::StaticOrder, true, true>(F.lds, g, S, E); }
            GRID_BAR();
            PROBE_ACC(0);
            PROBE_MARK(1);
            { pg8::Gemm g{HID, WL + W_D2 / 2, CH, DM, DFF}; pg8::PanelOrder S; S.S.init(CH, DM, BXO_G, BXO);
              pg8::EpiResidN<true> E{XN, DM, RSS(3 * l + 3)};
              pg8::gemm_phase<pg8::EpiResidN<true>, pg8::PanelOrder, true, true>(F.lds, g, S, E); }
            GRID_BAR();
            PROBE_ACC(1);
        }
        PROBE_MARK(9);
        norm_cast_rows(F, XN, RSS(6), AIN(25), (float*)YCH, (c + 1 < NCHUNK) ? XSRC(c + 1) : (const float*)nullptr, (unsigned long long*)(ws + WS_RSS) + (size_t)((c + 1) * 7) * CH);
        if (c + 1 < NCHUNK) GRID_BAR();
        PROBE_ACC(9);
    }
#if defined(PROBE)
    if (blockIdx.x == PROBE_BLK && threadIdx.x == 0) {
        unsigned long long a_ = ((unsigned long long)F.MISC[19] << 32) | F.MISC[18];
        const unsigned long long t0_ = __builtin_amdgcn_s_memrealtime();
        while (__builtin_amdgcn_s_memrealtime() - t0_ < a_) __builtin_amdgcn_s_sleep(8);
    }
#endif
}
#undef AIN
#undef XN
#undef U
#undef HID
#undef MIX
#undef OA
#undef BO
#undef BL
#undef OC
#undef RSS
#undef GQD
#undef GKI
#undef GDEC
#undef pcs
#undef axcs
#undef WL
#undef XSRC
#undef YCH
#undef L
#undef nseq

extern "C" void kernel_launch(void* const* d_in, const int* in_sizes, int n_in, void* d_out, int out_size, void* d_ws, size_t ws_size, hipStream_t stream) {
    static int grid = 0;
    if (grid == 0) {
        if (n_in != 26 || out_size != NTOK * DM || ws_size < WS_END) { fprintf(stderr, "kernel_launch: built for 26 inputs, %d outputs, >= %zu bytes of workspace; got n_in %d, out %d, ws %zu; nothing launched\n", NTOK * DM, (size_t)WS_END, n_in, out_size, ws_size); grid = -1; return; }
        int dev = 0, cus = 0, per_cu = 0;
        if (hipGetDevice(&dev) != hipSuccess || hipDeviceGetAttribute(&cus, hipDeviceAttributeMultiprocessorCount, dev) != hipSuccess) { fprintf(stderr, "kernel_launch: device query failed\n"); grid = -1; return; }
        if (hipFuncSetAttribute((const void*)hybrid_fwd, hipFuncAttributeMaxDynamicSharedMemorySize, LDS_BYTES) != hipSuccess) { fprintf(stderr, "kernel_launch: hipFuncSetAttribute failed\n"); grid = -1; return; }
        if (hipOccupancyMaxActiveBlocksPerMultiprocessor(&per_cu, (const void*)hybrid_fwd, NWAVES * 64, LDS_BYTES) != hipSuccess || per_cu < 1)
            fprintf(stderr, "kernel_launch: note: occupancy query reports %d workgroups per CU\n", per_cu);
        (void)hipGetLastError();
        grid = cus;
    }
    if (grid < 0) return;
    if (hipMemsetAsync((char*)d_ws + WS_CTL, 0, CTL_ZERO_BYTES, stream) != hipSuccess) { fprintf(stderr, "kernel_launch: hipMemsetAsync failed\n"); return; }
    Args a{};
    for (int i = 0; i < 26; ++i) a.in[i] = (const float*)d_in[i];
    a.in[26] = (const float*)d_out; a.in[27] = (const float*)d_ws;
    hipLaunchKernelGGL(hybrid_fwd, dim3(grid), dim3(NWAVES * 64), LDS_BYTES, stream, a);
    const hipError_t le = hipPeekAtLastError();
    if (le != hipSuccess) fprintf(stderr, "kernel_launch: launch failed: %s\n", hipGetErrorName(le));
}
```
